# Optimizing an MI355X kernel written in HIP

```python
import jax
import jax.numpy as jnp
from jax import lax
import numpy as np

D_MODEL = 1024
BATCH = 4
SEQ = 8192
DEPTH = 2

N_META = 16
CHUNK = 128
PAD_FRONT = CHUNK - N_META
ROPE_BASE = 10000.0
NEG_BIG = -1e30

RET_HEADS = 4
RET_DK = 64
RET_DV = 128
MLA_HEADS = 8
MLA_Q_RANK = 256
MLA_KV_RANK = 128
MLA_NOPE = 64
MLA_ROPE = 32
MLA_DV = 64
LRU_WIDTH = 512
LRU_BLOCKS = 8
LRU_BLOCK = LRU_WIDTH // LRU_BLOCKS
CONV_W = 4
LRU_C = 8.0
GLA_HEADS = 4
GLA_DK = 64
GLA_DV = 128
GLA_RANK = 16
GLA_TAU = 16.0
GLA_CHUNK = 16
N_BRANCH = 4
BRANCH_W = 512
N_EXPERTS = 32
TOP_K = 4
D_EXPERT = 1024
SWIGLU_LIMIT = 7.0
SWIGLU_ALPHA = 1.702
DN_ALPHA = (2.0 * DEPTH) ** 0.25
DN_BETA = (8.0 * DEPTH) ** -0.25

IN_SIZES = (RET_HEADS * RET_DK, RET_HEADS * RET_DK, RET_HEADS * RET_DV, RET_HEADS * RET_DV,
            MLA_Q_RANK, MLA_KV_RANK, MLA_ROPE,
            LRU_WIDTH, LRU_WIDTH,
            GLA_HEADS * GLA_DK, GLA_HEADS * GLA_DK, GLA_HEADS * GLA_DV, GLA_RANK,
            GLA_HEADS * GLA_DV)
D_IN = sum(IN_SIZES)
IN_OFFSETS = tuple(sum(IN_SIZES[:i + 1]) for i in range(len(IN_SIZES) - 1))

kernel_name = 'hybrid_gated_ret_mla_rglru_gla_moe'

F32 = jnp.float32


def _layer_norm(x, g, b, eps=1e-5):
    xf = x.astype(F32)
    mu = jnp.mean(xf, -1, keepdims=True)
    var = jnp.mean(jnp.square(xf - mu), -1, keepdims=True)
    return ((xf - mu) * lax.rsqrt(var + eps) * g.astype(F32) + b.astype(F32)).astype(x.dtype)


def _ln_noaffine(x, eps=1e-5):
    xf = x.astype(F32)
    mu = jnp.mean(xf, -1, keepdims=True)
    var = jnp.mean(jnp.square(xf - mu), -1, keepdims=True)
    return (xf - mu) * lax.rsqrt(var + eps)


def _rms_norm(x, g=None, eps=1e-6):
    xf = x.astype(F32)
    y = xf * lax.rsqrt(jnp.mean(xf * xf, -1, keepdims=True) + eps)
    if g is not None:
        y = y * g.astype(F32)
    return y


def _rope(x, pos):
    d = x.shape[-1]
    inv = ROPE_BASE ** (-jnp.arange(0, d, 2, dtype=F32) / d)
    ang = pos.astype(F32)[:, None] * inv[None, :]
    cos = jnp.cos(ang)[None, :, None, :]
    sin = jnp.sin(ang)[None, :, None, :]
    xf = x.astype(F32)
    x1, x2 = xf[..., :d // 2], xf[..., d // 2:]
    return jnp.concatenate([x1 * cos - x2 * sin, x2 * cos + x1 * sin], -1).astype(x.dtype)


def _pad_front(a):
    return jnp.pad(a, [(0, 0), (PAD_FRONT, 0)] + [(0, 0)] * (a.ndim - 2))


def _linear_combine(left, right):
    a_l, b_l = left
    a_r, b_r = right
    return a_l * a_r, a_r * b_l + b_r


def _retention(q, k, v, g):
    B, T = q.shape[:2]
    Tp = T + PAD_FRONT
    nc = Tp // CHUNK

    def chunks(a):
        return _pad_front(a).reshape(B, nc, CHUNK, RET_HEADS, a.shape[-1]).transpose(0, 3, 1, 2, 4).astype(F32)

    qc, kc, vc = chunks(q), chunks(k * (RET_DK ** -0.5)), chunks(v)
    log_gamma = jnp.log1p(-jnp.exp2(-5.0 - jnp.arange(RET_HEADS, dtype=F32)))
    idx = jnp.arange(CHUNK, dtype=F32)
    rel = idx[:, None] - idx[None, :]
    dmat = jnp.where(rel >= 0, jnp.exp(log_gamma[:, None, None] * jnp.maximum(rel, 0.0)), 0.0)
    scores = jnp.einsum('bhnid,bhnjd->bhnij', qc, kc) * dmat[None, :, None]
    o_inner = jnp.einsum('bhnij,bhnje->bhnie', scores, vc)
    k_dec = jnp.exp(log_gamma[:, None] * (CHUNK - 1.0 - idx))
    q_dec = jnp.exp(log_gamma[:, None] * (idx + 1.0))
    chunk_kv = jnp.einsum('bhnjd,bhnje->nbhde', kc * k_dec[None, :, None, :, None], vc)
    q_in = (qc * q_dec[None, :, None, :, None]).transpose(2, 0, 1, 3, 4)
    chunk_dec = jnp.exp(log_gamma * CHUNK)[None, :, None, None]

    def step(S, inp):
        q_n, kv_n = inp
        return S * chunk_dec + kv_n, jnp.einsum('bhid,bhde->bhie', q_n, S)

    S0 = jnp.zeros((B, RET_HEADS, RET_DK, RET_DV), F32)
    _, o_cross = lax.scan(step, S0, (q_in, chunk_kv))
    o = o_inner + o_cross.transpose(1, 2, 0, 3, 4)
    o = o.transpose(0, 2, 3, 1, 4).reshape(B, Tp, RET_HEADS, RET_DV)[:, PAD_FRONT:]
    o = _ln_noaffine(o).reshape(B, T, RET_HEADS * RET_DV)
    return (jax.nn.swish(g.astype(F32)) * o).astype(g.dtype)


def _causal_block_attention(q, k, v):
    B, T, H, _ = q.shape
    qp, kp, vp = _pad_front(q), _pad_front(k), _pad_front(v)
    Tp = T + PAD_FRONT
    nb = Tp // CHUNK
    key_pos = jnp.arange(Tp)
    key_valid = key_pos >= PAD_FRONT
    qb = qp.reshape(B, nb, CHUNK, H, q.shape[-1]).transpose(1, 0, 2, 3, 4)

    def block(args):
        q_blk, start = args
        s = jnp.einsum('bqhd,bkhd->bhqk', q_blk, kp).astype(F32)
        q_pos = start + jnp.arange(CHUNK)
        mask = (key_pos[None, :] <= q_pos[:, None]) & key_valid[None, :]
        p = jax.nn.softmax(jnp.where(mask, s, NEG_BIG), axis=-1).astype(vp.dtype)
        return jnp.einsum('bhqk,bkhd->bqhd', p, vp)

    o = lax.map(block, (qb, jnp.arange(nb) * CHUNK))
    return o.transpose(1, 0, 2, 3, 4).reshape(B, Tp, H, v.shape[-1])[:, PAD_FRONT:]


def _mla(c_q, c_kv, k_r, g_cq, g_ckv, w_uq, w_ukv, pos):
    B, T = c_q.shape[:2]
    dt = c_q.dtype
    q = (_rms_norm(c_q, g_cq).astype(dt) @ w_uq).reshape(B, T, MLA_HEADS, MLA_NOPE + MLA_ROPE)
    kv = (_rms_norm(c_kv, g_ckv).astype(dt) @ w_ukv).reshape(B, T, MLA_HEADS, MLA_NOPE + MLA_DV)
    q = jnp.concatenate([q[..., :MLA_NOPE], _rope(q[..., MLA_NOPE:], pos)], -1) * ((MLA_NOPE + MLA_ROPE) ** -0.5)
    k_rope = jnp.broadcast_to(_rope(k_r[:, :, None, :], pos), (B, T, MLA_HEADS, MLA_ROPE))
    k = jnp.concatenate([kv[..., :MLA_NOPE], k_rope.astype(kv.dtype)], -1)
    v = kv[..., MLA_NOPE:]
    return _causal_block_attention(q, k, v).reshape(B, T, MLA_HEADS * MLA_DV)


def _rglru(xb, gb, conv_w, conv_b, w_a, b_a, w_x, b_x, lam):
    B, T, W = xb.shape
    xc = lax.conv_general_dilated(xb, conv_w.astype(xb.dtype)[:, None, :], (1,), [(CONV_W - 1, 0)],
                                  dimension_numbers=('NWC', 'WIO', 'NWC'), feature_group_count=W) + conv_b
    xblk = xc.reshape(B, T, LRU_BLOCKS, LRU_BLOCK)
    r = jax.nn.sigmoid((jnp.einsum('btnc,ncd->btnd', xblk, w_a).reshape(B, T, W) + b_a).astype(F32))
    i = jax.nn.sigmoid((jnp.einsum('btnc,ncd->btnd', xblk, w_x).reshape(B, T, W) + b_x).astype(F32))
    log_a = -LRU_C * r * jax.nn.softplus(-lam.astype(F32))
    a = jnp.exp(log_a)
    u = jnp.sqrt(-jnp.expm1(2.0 * log_a)) * (i * xc.astype(F32))
    _, hs = lax.associative_scan(_linear_combine, (a, u), axis=1)
    return (hs * jax.nn.gelu(gb.astype(F32))).astype(xb.dtype)


def _gla(q, k, v, a_low, g, w_a2, b_a2):
    B, T = q.shape[:2]
    Tp = T + PAD_FRONT
    nc = Tp // GLA_CHUNK
    log_alpha = jax.nn.log_sigmoid((a_low @ w_a2 + b_a2).astype(F32)) / GLA_TAU
    log_alpha = log_alpha.reshape(B, T, GLA_HEADS, GLA_DK)

    def chunks(a):
        return _pad_front(a).reshape(B, nc, GLA_CHUNK, GLA_HEADS, a.shape[-1]).transpose(0, 3, 1, 2, 4).astype(F32)

    qc, kc, vc, lc = chunks(q), chunks(k * (GLA_DK ** -0.5)), chunks(v), chunks(log_alpha)
    b = jnp.cumsum(lc, axis=3)
    causal = jnp.tril(jnp.ones((GLA_CHUNK, GLA_CHUNK), bool))[:, :, None]
    diff = b[..., :, None, :] - b[..., None, :, :]
    decay = jnp.where(causal, jnp.exp(jnp.minimum(diff, 0.0)), 0.0)
    A = jnp.einsum('bhnid,bhnjd,bhnijd->bhnij', qc, kc, decay)
    o_intra = jnp.einsum('bhnij,bhnje->bhnie', A, vc)
    b_last = b[..., -1:, :]
    q_in = (qc * jnp.exp(b)).transpose(2, 0, 1, 3, 4)
    chunk_kv = jnp.einsum('bhnjd,bhnje->nbhde', kc * jnp.exp(b_last - b), vc)
    chunk_dec = jnp.exp(b_last[..., 0, :]).transpose(2, 0, 1, 3)

    def step(S, inp):
        q_n, kv_n, dec_n = inp
        return S * dec_n[..., None] + kv_n, jnp.einsum('bhid,bhde->bhie', q_n, S)

    S0 = jnp.zeros((B, GLA_HEADS, GLA_DK, GLA_DV), F32)
    _, o_cross = lax.scan(step, S0, (q_in, chunk_kv, chunk_dec))
    o = o_intra + o_cross.transpose(1, 2, 0, 3, 4)
    o = o.transpose(0, 2, 3, 1, 4).reshape(B, Tp, GLA_HEADS, GLA_DV)[:, PAD_FRONT:]
    o = _rms_norm(o).reshape(B, T, GLA_HEADS * GLA_DV)
    return (jax.nn.swish(g.astype(F32)) * o).astype(g.dtype)


def _mixer(h, pos, w_in, w_merge, b_merge, g_cq, g_ckv, w_uq, w_ukv, conv_w, conv_b, w_lru_a, b_lru_a,
           w_lru_x, b_lru_x, lru_lambda, w_gla_a2, b_gla_a2, w_branch, w_out):
    B, T, _ = h.shape
    (rq, rk, rv, rg, cq, ckv, kr, lx, lg, gq, gk, gv, ga, gg) = jnp.split(h @ w_in, IN_OFFSETS, axis=-1)
    y_ret = _retention(_rope(rq.reshape(B, T, RET_HEADS, RET_DK), pos),
                       _rope(rk.reshape(B, T, RET_HEADS, RET_DK), pos),
                       rv.reshape(B, T, RET_HEADS, RET_DV), rg)
    y_mla = _mla(cq, ckv, kr, g_cq, g_ckv, w_uq, w_ukv, pos)
    y_lru = _rglru(lx, lg, conv_w, conv_b, w_lru_a, b_lru_a, w_lru_x, b_lru_x, lru_lambda)
    y_gla = _gla(gq.reshape(B, T, GLA_HEADS, GLA_DK), gk.reshape(B, T, GLA_HEADS, GLA_DK),
                 gv.reshape(B, T, GLA_HEADS, GLA_DV), ga, gg, w_gla_a2, b_gla_a2)
    ys = jnp.stack([y_ret, y_mla, y_lru, y_gla], axis=2)
    branch = jnp.einsum('btnw,nwd->btnd', ys, w_branch)
    gates = jax.nn.sigmoid((h @ w_merge + b_merge).reshape(B, T, N_BRANCH, D_MODEL))
    return jnp.sum(gates * branch, axis=2) @ w_out


def _moe(h, w_router, b_router, w_eg, b_eg, w_eu, b_eu, w_ed, b_ed):
    B, T, D = h.shape
    x = h.reshape(B * T, D)
    logits = (x @ w_router + b_router).astype(F32)
    top_v, top_i = lax.top_k(logits, TOP_K)
    top_w = jax.nn.softmax(top_v, axis=-1)
    combine = jnp.sum(jax.nn.one_hot(top_i, N_EXPERTS, dtype=F32) * top_w[..., None], axis=1)
    y = jnp.zeros((B * T, D), F32)
    for e in range(N_EXPERTS):
        gate = jnp.minimum(x @ w_eg[e] + b_eg[e], SWIGLU_LIMIT)
        up = jnp.clip(x @ w_eu[e] + b_eu[e], -SWIGLU_LIMIT, SWIGLU_LIMIT)
        act = (up + 1.0) * gate * jax.nn.sigmoid(SWIGLU_ALPHA * gate)
        y = y + combine[:, e:e + 1] * (act @ w_ed[e] + b_ed[e]).astype(F32)
    return y.astype(h.dtype).reshape(B, T, D)


def setup_inputs(seed: int = 0) -> dict:
    key = jax.random.key(seed)
    ks = list(jax.random.split(key, 40))
    L, D, E, F = DEPTH, D_MODEL, N_EXPERTS, D_EXPERT

    def nrm(k, shape, scale):
        return jax.random.normal(k, shape, F32) * scale

    u = jax.random.uniform(ks[13], (L, LRU_WIDTH), F32, 0.9, 0.999)
    a = u ** (1.0 / LRU_C)
    lam = jnp.log(a) - jnp.log1p(-a)
    return {
        'x': nrm(ks[0], (BATCH, SEQ, D), 1.0),
        'meta_tokens': nrm(ks[1], (N_META, D), 1.0),
        'ln0_g': 1.0 + nrm(ks[2], (D,), 0.02),
        'ln0_b': nrm(ks[3], (D,), 0.02),
        'w_in': nrm(ks[4], (L, D, D_IN), D ** -0.5),
        'w_merge': nrm(ks[5], (L, D, N_BRANCH * D), D ** -0.5),
        'b_merge': nrm(ks[6], (L, N_BRANCH * D), 0.02),
        'g_cq': 1.0 + nrm(ks[7], (L, MLA_Q_RANK), 0.02),
        'g_ckv': 1.0 + nrm(ks[8], (L, MLA_KV_RANK), 0.02),
        'w_uq': nrm(ks[9], (L, MLA_Q_RANK, MLA_HEADS * (MLA_NOPE + MLA_ROPE)), MLA_Q_RANK ** -0.5),
        'w_ukv': nrm(ks[10], (L, MLA_KV_RANK, MLA_HEADS * (MLA_NOPE + MLA_DV)), MLA_KV_RANK ** -0.5),
        'conv_w': nrm(ks[11], (L, CONV_W, LRU_WIDTH), CONV_W ** -0.5),
        'conv_b': nrm(ks[12], (L, LRU_WIDTH), 0.02),
        'w_lru_a': nrm(ks[14], (L, LRU_BLOCKS, LRU_BLOCK, LRU_BLOCK), LRU_BLOCK ** -0.5),
        'b_lru_a': nrm(ks[15], (L, LRU_WIDTH), 0.02),
        'w_lru_x': nrm(ks[16], (L, LRU_BLOCKS, LRU_BLOCK, LRU_BLOCK), LRU_BLOCK ** -0.5),
        'b_lru_x': nrm(ks[17], (L, LRU_WIDTH), 0.02),
        'lru_lambda': lam,
        'w_gla_a2': nrm(ks[18], (L, GLA_RANK, GLA_HEADS * GLA_DK), GLA_RANK ** -0.5),
        'b_gla_a2': nrm(ks[19], (L, GLA_HEADS * GLA_DK), 0.02),
        'w_branch': nrm(ks[20], (L, N_BRANCH, BRANCH_W, D), BRANCH_W ** -0.5),
        'w_out': nrm(ks[21], (L, D, D), DN_BETA * D ** -0.5),
        'ln1_g': 1.0 + nrm(ks[22], (L, D), 0.02),
        'ln1_b': nrm(ks[23], (L, D), 0.02),
        'w_router': nrm(ks[24], (L, D, E), D ** -0.5),
        'b_router': nrm(ks[25], (L, E), 0.01),
        'w_exp_gate': nrm(ks[26], (L, E, D, F), D ** -0.5),
        'b_exp_gate': nrm(ks[27], (L, E, F), 0.02),
        'w_exp_up': nrm(ks[28], (L, E, D, F), D ** -0.5),
        'b_exp_up': nrm(ks[29], (L, E, F), 0.02),
        'w_exp_down': nrm(ks[30], (L, E, F, D), DN_BETA * F ** -0.5),
        'b_exp_down': nrm(ks[31], (L, E, D), 0.02),
        'ln2_g': 1.0 + nrm(ks[32], (L, D), 0.02),
        'ln2_b': nrm(ks[33], (L, D), 0.02),
    }


def reference(x, meta_tokens, ln0_g, ln0_b, w_in, w_merge, b_merge, g_cq, g_ckv, w_uq, w_ukv, conv_w, conv_b,
              w_lru_a, b_lru_a, w_lru_x, b_lru_x, lru_lambda, w_gla_a2, b_gla_a2, w_branch, w_out, ln1_g, ln1_b,
              w_router, b_router, w_exp_gate, b_exp_gate, w_exp_up, b_exp_up, w_exp_down, b_exp_down,
              ln2_g, ln2_b):
    B = x.shape[0]
    meta = jnp.broadcast_to(meta_tokens[None].astype(x.dtype), (B, N_META, D_MODEL))
    h = _layer_norm(jnp.concatenate([meta, x], axis=1), ln0_g, ln0_b)
    pos = jnp.arange(h.shape[1], dtype=jnp.int32)
    for l in range(DEPTH):
        mix = _mixer(h, pos, w_in[l], w_merge[l], b_merge[l], g_cq[l], g_ckv[l], w_uq[l], w_ukv[l],
                     conv_w[l], conv_b[l], w_lru_a[l], b_lru_a[l], w_lru_x[l], b_lru_x[l], lru_lambda[l],
                     w_gla_a2[l], b_gla_a2[l], w_branch[l], w_out[l])
        h = _layer_norm(DN_ALPHA * h + mix, ln1_g[l], ln1_b[l])
        ffn = _moe(h, w_router[l], b_router[l], w_exp_gate[l], b_exp_gate[l], w_exp_up[l], b_exp_up[l],
                   w_exp_down[l], b_exp_down[l])
        h = _layer_norm(DN_ALPHA * h + ffn, ln2_g[l], ln2_b[l])
    return h[:, N_META:]
```

```cpp
#include <hip/hip_runtime.h>
#include <cstdio>
#include <cstdint>
#include <cmath>

#define LAS __attribute__((address_space(3)))
#define GAS __attribute__((address_space(1)))
typedef unsigned short bf16_t;
typedef short bf16x8 __attribute__((ext_vector_type(8)));
typedef short s16x4 __attribute__((ext_vector_type(4)));
typedef short v4i16_t __attribute__((ext_vector_type(4)));
typedef float f32x2 __attribute__((ext_vector_type(2)));
typedef float f32x4 __attribute__((ext_vector_type(4)));
typedef float f32x16 __attribute__((ext_vector_type(16)));
typedef unsigned u32x2 __attribute__((ext_vector_type(2)));
typedef unsigned u32x4 __attribute__((ext_vector_type(4)));
typedef __bf16 bf16x2_t __attribute__((ext_vector_type(2)));
typedef GAS unsigned gu32;
typedef int i32x8 __attribute__((ext_vector_type(8)));
#define DI __device__ __forceinline__
#define RLX_AGENT __ATOMIC_RELAXED, __HIP_MEMORY_SCOPE_AGENT

constexpr int NB = 4, SEQ = 8192, NMETA = 16, TT = SEQ + NMETA;
constexpr int PADF = 240, TP = PADF + TT;
constexpr int M = NB * TP;
constexpr int D = 1024, DEPTH = 2;
__device__ __forceinline__ size_t gate_addr(size_t r, int c) { return ((r >> 2) << 14) + ((size_t)(c >> 7) << 9) + (size_t)(((c >> 5) & 3) << 7) + ((r & 3) << 5) + (size_t)(c & 31); }
constexpr int NPROJ = 4608;
constexpr int C_RQ = 0, C_RK = 256, C_RV = 512, C_RG = 1024, C_CQ = 1536, C_CKV = 1792, C_KR = 1920, C_GA = 1952, C_LX = 2048, C_LG = 2560,
              C_GQ = 3072, C_GK = 3328, C_GV = 3584, C_GG = 4096;
constexpr int O_RQ = 0, O_RK = 256, O_RV = 512, O_RG = 1024, O_CQ = 1536, O_CKV = 1792, O_KR = 1920, O_LX = 1952, O_LG = 2464, O_GQ = 2976,
              O_GK = 3232, O_GV = 3488, O_GA = 4000, O_GG = 4016, D_IN = 4528;
constexpr int NE = 32, TOPK = 4, DE = 1024;
constexpr int NCH = TP / 64;
constexpr int MAXTILES = 545;
constexpr float DN_ALPHA = 1.4142135623730951f;
constexpr float LOG2E = 1.4426950408889634f;

constexpr size_t MiB = 1u << 20;
constexpr size_t WS_CTL = 0, CTL_ZERO_BYTES = 64 * 1024;
constexpr size_t WS_HB = 1 * MiB;
constexpr size_t WS_R1 = WS_HB + 66 * MiB;
constexpr size_t WS_R2 = WS_R1 + 297 * MiB;
constexpr size_t WS_YS = WS_R2;
constexpr size_t WS_Q = WS_YS + 132 * MiB;
constexpr size_t WS_KV = WS_Q + 50 * MiB;
constexpr size_t WS_MIX = WS_Q;
constexpr size_t WS_X8 = WS_R2;
constexpr size_t WS_YSLOT = WS_R2;
constexpr size_t WS_ST = WS_R2 + 264 * MiB;
constexpr size_t WS_W = WS_ST + 66 * MiB;
constexpr size_t W_IN = WS_W;
constexpr size_t W_MG = W_IN + 9 * MiB;
constexpr size_t W_BR = W_MG + 8 * MiB;
constexpr size_t W_OUT = W_BR + 4 * MiB;
constexpr size_t W_UQ = W_OUT + 2 * MiB;
constexpr size_t W_UKV = W_UQ + 512 * 1024;
constexpr size_t W_GU = W_UKV + 512 * 1024;
constexpr size_t W_DN = W_GU + 64 * MiB;
constexpr size_t WS_MISC = W_DN + 32 * MiB;
constexpr size_t WS_SSQ = WS_MISC;
constexpr size_t WS_TABR = WS_SSQ + 2 * MiB;
constexpr size_t WS_TABM = WS_TABR + 3 * MiB;
constexpr size_t WS_DEC = WS_TABM + 2 * MiB;
constexpr size_t WS_LRUA = WS_DEC + 2 * MiB;
constexpr size_t WS_LRUH = WS_LRUA + 2 * MiB;
constexpr size_t WS_TOPI = WS_LRUH + 2 * MiB;
constexpr size_t WS_TOPW = WS_TOPI + 1 * MiB;
constexpr size_t WS_LIST = WS_TOPW + 1 * MiB;
constexpr size_t WS_H8 = WS_LIST + 5 * MiB;
constexpr size_t WS_END = WS_H8 + 34 * MiB;
static_assert(WS_END <= 1024 * MiB, "workspace map exceeds 1 GiB");
static_assert((size_t)M * NPROJ * 2 <= 297 * MiB && (size_t)MAXTILES * 256 * 1024 * 2 <= 297 * MiB && (size_t)M * 4096 * 2 <= 297 * MiB, "R1");
static_assert((size_t)M * 4 * 1024 * 2 <= 264 * MiB && WS_KV + (size_t)M * 1024 * 2 <= WS_ST, "R2");
constexpr int CW_BAR = 4096;
constexpr int CW_QUEUE = 8192;
constexpr int CW_ECNT = 12288;

constexpr int RING_BYTES = 131072;
constexpr int TAB_OFF = RING_BYTES;
constexpr int MISC_OFF = RING_BYTES + 12288;
constexpr int LDS_BYTES = 147456;
constexpr int NWAVES = 8, NTHREADS = 512;

#define LDS_WAIT() asm volatile("s_waitcnt lgkmcnt(0)" ::: "memory")
#define VM_WAIT() asm volatile("s_waitcnt vmcnt(0)" ::: "memory")
DI unsigned f2bf(float f) { unsigned u = __builtin_bit_cast(unsigned, f); return (u + 0x7fffu + ((u >> 16) & 1u)) >> 16; }
DI unsigned pk2(float lo, float hi) { f32x2 v = {lo, hi}; bf16x2_t b = __builtin_convertvector(v, bf16x2_t); return __builtin_bit_cast(unsigned, b); }
DI float bf2f(unsigned short h) { return __builtin_bit_cast(float, (unsigned)h << 16); }
DI float bflo(unsigned w) { return __builtin_bit_cast(float, w << 16); }
DI float bfhi(unsigned w) { return __builtin_bit_cast(float, w & 0xffff0000u); }
DI unsigned pk4_fp8(float a, float b, float c, float d) {
    a = fminf(fmaxf(a, -448.f), 448.f); b = fminf(fmaxf(b, -448.f), 448.f); c = fminf(fmaxf(c, -448.f), 448.f); d = fminf(fmaxf(d, -448.f), 448.f);
    int w = __builtin_amdgcn_cvt_pk_fp8_f32(a, b, 0, false); w = __builtin_amdgcn_cvt_pk_fp8_f32(c, d, w, true); return (unsigned)w; }
constexpr float X8_SCALE = 16.f, WGU_SCALE = 256.f, ACT_SCALE = 4.f, WDN_SCALE = 512.f, YS_SCALE = 16.f, YB_SCALE = 16.f;
#define DPPF(v, ctrl) __builtin_bit_cast(float, __builtin_amdgcn_update_dpp(0, __builtin_bit_cast(int, (v)), (ctrl), 0xF, 0xF, true))
#define DPP_X1 0xB1
#define DPP_X2 0x4E
#define DPP_QREV 0x1B
#define DPP_HMIR 0x141
#define DPP_MIR 0x140
#define DPP_X8 0x128
DI float rdlane_f(float v, int l) { return __builtin_bit_cast(float, __builtin_amdgcn_readlane(__builtin_bit_cast(int, v), l)); }
DI float xor1_f(float v) { return DPPF(v, DPP_X1); }
DI float xor2_f(float v) { return DPPF(v, DPP_X2); }
DI float xor4_f(float v) { const float t = DPPF(v, DPP_HMIR); return DPPF(t, DPP_QREV); }
DI float xor8_f(float v) { return DPPF(v, DPP_X8); }
#define SWAP32(a_, b_) asm volatile("s_nop 1\n\tv_permlane32_swap_b32 %0, %1" : "+v"(a_), "+v"(b_))
#define SWAP16(a_, b_) asm volatile("s_nop 1\n\tv_permlane16_swap_b32 %0, %1" : "+v"(a_), "+v"(b_))
DI float xor16_f(float v, int lane) { float a_ = v, b_ = v; SWAP16(a_, b_); return (lane & 16) ? a_ : b_; }
DI float xor32_f(float v, int lane) { float a_ = v, b_ = v; SWAP32(a_, b_); return (lane & 32) ? a_ : b_; }
DI float sum_x32(float v) { float a_ = v, b_ = v; SWAP32(a_, b_); return a_ + b_; }
DI float max_x32(float v) { float a_ = v, b_ = v; SWAP32(a_, b_); return fmaxf(a_, b_); }
DI float sum_x16(float v) { float a_ = v, b_ = v; SWAP16(a_, b_); return a_ + b_; }
DI float wave_sum(float v) {
    v += DPPF(v, DPP_X1); v += DPPF(v, DPP_X2); v += DPPF(v, DPP_HMIR); v += DPPF(v, DPP_MIR);
    return (rdlane_f(v, 0) + rdlane_f(v, 16)) + (rdlane_f(v, 32) + rdlane_f(v, 48));
}
DI float wave_max(float v) {
    v = fmaxf(v, DPPF(v, DPP_X1)); v = fmaxf(v, DPPF(v, DPP_X2)); v = fmaxf(v, DPPF(v, DPP_HMIR)); v = fmaxf(v, DPPF(v, DPP_MIR));
    return fmaxf(fmaxf(rdlane_f(v, 0), rdlane_f(v, 16)), fmaxf(rdlane_f(v, 32), rdlane_f(v, 48)));
}
DI float fast_exp(float x) { return __builtin_amdgcn_exp2f(x * LOG2E); }
DI float fast_sigmoid(float x) { return __builtin_amdgcn_rcpf(1.0f + __builtin_amdgcn_exp2f(-x * LOG2E)); }
DI int crow(int r, int hi) { return (r & 3) + 8 * (r >> 2) + 4 * hi; }
#define MFMA32(a, b, c) __builtin_amdgcn_mfma_f32_32x32x16_bf16((a), (b), (c), 0, 0, 0)
DI s16x4 vtr(const LAS unsigned char* p) { return __builtin_bit_cast(s16x4, __builtin_amdgcn_ds_read_tr16_b64_v4i16((LAS v4i16_t*)p)); }
DI bf16x8 frag_row(const LAS unsigned char* p) { return *(const LAS bf16x8*)p; }
DI bf16x8 frag_tr(const LAS unsigned char* base, int pitch, int k0, int f0, int lane) {
    const int hi = lane >> 5, blk = (lane >> 4) & 1, q = (lane & 15) >> 2, p = lane & 3;
    const LAS unsigned char* a = base + (k0 + 8 * hi + q) * pitch + (f0 + 16 * blk + 4 * p) * 2;
    const s16x4 lo = vtr(a), h4 = vtr(a + 4 * pitch);
    return __builtin_shufflevector(lo, h4, 0, 1, 2, 3, 4, 5, 6, 7);
}
DI bf16x8 frag_tr_perm(const LAS unsigned char* base, int pitch, int k0, int f0, int lane) {
    const int hi = lane >> 5, blk = (lane >> 4) & 1, q = (lane & 15) >> 2, p = lane & 3;
    const LAS unsigned char* a = base + (k0 + 4 * hi + q) * pitch + (f0 + 16 * blk + 4 * p) * 2;
    const s16x4 lo = vtr(a), h4 = vtr(a + 8 * pitch);
    return __builtin_shufflevector(lo, h4, 0, 1, 2, 3, 4, 5, 6, 7);
}
DI bf16x8 pack_step(const f32x16& x, int s) {
    u32x4 p;
    p[0] = pk2(x[8 * s + 0], x[8 * s + 1]); p[1] = pk2(x[8 * s + 2], x[8 * s + 3]); p[2] = pk2(x[8 * s + 4], x[8 * s + 5]); p[3] = pk2(x[8 * s + 6], x[8 * s + 7]);
    return __builtin_bit_cast(bf16x8, p);
}

#define XB_TMO      128
#define XB_XCNT(j)  (256  + 64 * (j))
#define XB_XSUB(j)  (1280 + 64 * (j))
#define XB_XGEN(j)  (2304 + 64 * (j))
#define XB_TOP      3328
#define XB_TOPGEN   3392
#define XCD_BAR_WORDS 3456
#define XB_SPIN_CAP (1u << 22)
DI unsigned xb_ld(unsigned* p)              { return __hip_atomic_load(p, __ATOMIC_RELAXED, __HIP_MEMORY_SCOPE_AGENT); }
DI unsigned xb_add(unsigned* p, unsigned v) { return __hip_atomic_fetch_add(p, v, __ATOMIC_RELAXED, __HIP_MEMORY_SCOPE_AGENT); }
DI unsigned xb_xcc_id() { return (unsigned)__builtin_amdgcn_s_getreg((3 << 11) | 20) & 0xFu; }
#define XB_SPIN(cond, bar) do { unsigned _sp = 0; while (cond) { __builtin_amdgcn_s_sleep(1); \
    if ((++_sp & 255u) == 0u) { if (xb_ld(&(bar)[XB_TMO])) break; if (_sp > XB_SPIN_CAP) { atomicAdd(&(bar)[XB_TMO], 1u); break; } } } } while (0)
struct XcdBarrier { unsigned* bar; unsigned x; volatile LAS unsigned* st; };
DI XcdBarrier xcd_barrier_post(unsigned* bar, volatile LAS unsigned* st, int tid) {
    XcdBarrier b; b.bar = bar; b.x = xb_xcc_id(); b.st = st;
    if (tid == 0) (void)xb_add(&bar[XB_XCNT(b.x)], 1u);
    return b;
}
DI void xcd_barrier_complete(unsigned* bar, unsigned x, unsigned& nloc, unsigned& nx) {
    const unsigned G = gridDim.x * gridDim.y * gridDim.z;
    unsigned sum, cnt, mine, sp = 0u;
    for (;;) {
        sum = 0u; cnt = 0u; mine = 0u;
#pragma unroll
        for (unsigned j = 0; j < 16; ++j) { const unsigned c = xb_ld(&bar[XB_XCNT(j)]); sum += c; cnt += (c > 0u) ? 1u : 0u; }
        if (sum == G) { mine = xb_ld(&bar[XB_XCNT(x)]); break; }
        __builtin_amdgcn_s_sleep(1);
        if ((++sp & 255u) == 0u) { if (xb_ld(&bar[XB_TMO])) break; if (sp > XB_SPIN_CAP) { atomicAdd(&bar[XB_TMO], 1u); break; } }
    }
    nloc = mine > 0u ? mine : 1u; nx = cnt > 0u ? cnt : 1u;
}
DI void xcd_barrier(const XcdBarrier& b, int tid) {
    asm volatile("s_waitcnt vmcnt(0)" ::: "memory");
    __syncthreads();
    if (tid == 0) {
        unsigned* bar = b.bar; unsigned bx = b.x;
        asm volatile("" : "+s"(bar), "+s"(bx));
        __builtin_amdgcn_s_waitcnt(0);
        unsigned nloc = b.st[0], nx = b.st[1];
        if (nloc == 0u) { xcd_barrier_complete(bar, bx, nloc, nx); b.st[0] = nloc; b.st[1] = nx; }
        const unsigned old = xb_add(&bar[XB_XSUB(bx)], 1u);
        const unsigned gen = old / nloc;
        if (old + 1u == (gen + 1u) * nloc) {
            __builtin_amdgcn_fence(__ATOMIC_RELEASE, "agent");
            asm volatile("s_waitcnt vmcnt(0)" ::: "memory");
            const unsigned og = xb_add(&bar[XB_TOP], 1u);
            const unsigned tg = og / nx;
            if (og + 1u == (tg + 1u) * nx) xb_add(&bar[XB_TOPGEN], 1u);
            else XB_SPIN(xb_ld(&bar[XB_TOPGEN]) == tg, bar);
            __builtin_amdgcn_fence(__ATOMIC_ACQUIRE, "agent");
            xb_add(&bar[XB_XGEN(bx)], 1u);
            asm volatile("s_waitcnt vmcnt(0)" ::: "memory");
        } else {
            XB_SPIN(xb_ld(&bar[XB_XGEN(bx)]) == gen, bar);
            __builtin_amdgcn_fence(__ATOMIC_ACQUIRE, "agent");
            asm volatile("s_waitcnt vmcnt(0)" ::: "memory");
        }
    }
    __syncthreads();
}

namespace pg8 {
constexpr int BM = 256, BK = 64, HALF = 128, HTB = HALF * BK * 2, STAGE_BYTES = 8 * HTB, NXCD = 8, WGM = 8;
__host__ __device__ __forceinline__ int lds_byte(int r, int c) { const int st = (r >> 4) * 2 + (c >> 5), rr = r & 15, cc = c & 31, ob = rr * 64 + cc * 2; return st * 1024 + (ob ^ (((ob >> 9) & 1) << 5)); }
__host__ __device__ __forceinline__ void stage_rc(int b, int& R, int& C) { const int st = b / 1024, sb = b % 1024, swz = sb ^ (((sb >> 9) & 1) << 5); R = (st >> 1) * 16 + swz / 64; C = (st & 1) * 32 + (swz % 64) / 2; }
__host__ __device__ __forceinline__ int perm32(int rho) { const int n = rho >> 4, i = rho & 15; return 8 * (i >> 2) + 4 * n + (i & 3); }

struct Unit { int pm, pn, pb; };
struct Gemm { const void* A; const void* Bt; int lda, ldb, K; long a_pb, b_pb; int ablk; };

template <bool SKIPMETA> struct StaticOrderT {
    static constexpr bool GATHER = false, KEEP = false;
    int nM, nN, nwg, G, c;
    DI void init(int M_, int N_, int G_, int c_) { nM = SKIPMETA ? NB * (TP / BM - 1) : M_ / BM; nN = N_ / BM; nwg = nM * nN; G = G_; c = c_; }
    DI bool tile(int i, int& pm, int& pn) const {
        const long L = (long)i * G + c; if (L >= nwg) return false;
        int wgid = (int)L; { const int q = nwg / NXCD, r = nwg % NXCD, xcd = wgid % NXCD, off = wgid / NXCD; wgid = (xcd < r ? xcd * (q + 1) : r * (q + 1) + (xcd - r) * q) + off; }
        const int nig = WGM * nN, gid = wgid / nig, fm = gid * WGM, gsz = (nM - fm) < WGM ? (nM - fm) : WGM;
        pm = fm + ((wgid % nig) % gsz); pn = (wgid % nig) / gsz;
        if constexpr (SKIPMETA) pm += pm / (TP / BM - 1) + 1;
        return true;
    }
    DI bool next(int i, Unit& u) const { u.pb = 0; return tile(i, u.pm, u.pn); }
    DI int arow(const Unit& u, int r) const { return u.pm * BM + r; }
};
using StaticOrder = StaticOrderT<false>;
using TokenOrder = StaticOrderT<true>;
template <int NB_, class SO = StaticOrder> struct BatchedOrder {
    static constexpr bool GATHER = false, KEEP = true;
    SO so;
    DI void init(int M_, int N_, int G_, int c_) { so.init(M_, N_, G_, c_); }
    DI bool next(int i, Unit& u) const { u.pb = i % NB_; return so.tile(i / NB_, u.pm, u.pn); }
    DI int arow(const Unit& u, int r) const { return u.pm * BM + r; }
};

template <class Epi, class Sched, bool ALIGN_EPI, bool FP8 = false>
DI void gemm_phase(LAS unsigned char* lds, const int tid, const Gemm g, const Sched& S, const Epi& E) {
    constexpr bool GATHER = Sched::GATHER; constexpr int ESZ = FP8 ? 1 : 2, BKE = 128 / ESZ;
    const int wid = __builtin_amdgcn_readfirstlane(tid >> 6), lane = tid & 63, wr = wid >> 2, wc = wid & 3, fr = lane & 15, fq = lane >> 4;
    const int K = g.K, nt = K / BKE;
    unsigned voffA[2], voffB[2];
#pragma unroll
    for (int i = 0; i < 2; ++i) { int R, C; stage_rc(tid * 16 + i * 8192, R, C); const int Rb = (R & ~31) + perm32(R & 31);
        voffA[i] = g.ablk ? (unsigned)((R >> 2) * (4 * g.lda * ESZ)) + (unsigned)((((2 * C) >> 5) & 3) * 128) + (unsigned)((R & 3) * 32) + (unsigned)((2 * C) & 31)
                          : (unsigned)(R * g.lda) * (unsigned)ESZ + (unsigned)C * 2u;
        voffB[i] = (unsigned)(Rb * g.ldb) * (unsigned)ESZ + (unsigned)C * 2u; }
    const size_t kstep = (size_t)(BK * 2), kstepA = g.ablk ? (size_t)512 : kstep;
    const size_t hstepA = GATHER ? 0 : (size_t)HALF * g.lda * ESZ, tstepA = 2 * hstepA;
    const size_t hstepB = (size_t)HALF * g.ldb * ESZ, tstepB = 2 * hstepB;
    const unsigned ldsw = (unsigned)wid * 1024u;
    const int aoff = lds_byte(wr * 64 + fr, fq * 8), boff = lds_byte(wc * 32 + fr, fq * 8);
#define PG8_SA(b, h) (((b) * 2 + (h)) * HTB)
#define PG8_SB(b, h) ((4 + (b) * 2 + (h)) * HTB)
#define PG8_STAGE(bufoff, gbase, v0, v1) do { \
        __builtin_amdgcn_global_load_lds((const unsigned*)((const char*)(gbase) + (v0)), (LAS unsigned*)(lds + (bufoff) + ldsw), 16, 0, 0); \
        __builtin_amdgcn_global_load_lds((const unsigned*)((const char*)(gbase) + (v1)), (LAS unsigned*)(lds + (bufoff) + ldsw + 8192), 16, 0, 0); } while (0)
#define PG8_CAT(x, y) __builtin_bit_cast(i32x8, __builtin_shufflevector(x, y, 0, 1, 2, 3, 4, 5, 6, 7, 8, 9, 10, 11, 12, 13, 14, 15))
#define PG8_LDA(dst, b, h) do { _Pragma("unroll") for (int m = 0; m < 4; ++m) { _Pragma("unroll") for (int k = 0; k < 2; ++k) dst[m][k] = *(const LAS bf16x8*)(lds + PG8_SA(b, h) + aoff + m * 2048 + k * 1024); \
        if constexpr (FP8) dst##8[m] = PG8_CAT(dst[m][0], dst[m][1]); } } while (0)
#define PG8_LDB(dst, b, h) do { _Pragma("unroll") for (int n = 0; n < 2; ++n) { _Pragma("unroll") for (int k = 0; k < 2; ++k) dst[n][k] = *(const LAS bf16x8*)(lds + PG8_SB(b, h) + boff + n * 2048 + k * 1024); \
        if constexpr (FP8) dst##8[n] = PG8_CAT(dst[n][0], dst[n][1]); } } while (0)
#define PG8_MMA(ai, bj, At, Bt) do { __builtin_amdgcn_s_setprio(1); _Pragma("unroll") for (int m = 0; m < 4; ++m) _Pragma("unroll") for (int n = 0; n < 2; ++n) { \
        if constexpr (FP8) asm volatile("v_mfma_f32_16x16x128_f8f6f4 %0, %1, %2, %0" : "+v"(acc[ai][bj][m][n]) : "v"(Bt##8[n]), "v"(At##8[m])); \
        else { _Pragma("unroll") for (int k = 0; k < 2; ++k) acc[ai][bj][m][n] = __builtin_amdgcn_mfma_f32_16x16x32_bf16(Bt[n][k], At[m][k], acc[ai][bj][m][n], 0, 0, 0); } } \
        __builtin_amdgcn_s_setprio(0); } while (0)
#define PG8_WAIT_V(n) asm volatile("s_waitcnt vmcnt(" #n ")" ::: "memory")
#define PG8_WAIT_L(n) asm volatile("s_waitcnt lgkmcnt(" #n ")" ::: "memory")
#define PG8_BAR __builtin_amdgcn_s_barrier()
#define PG8_SCHED __builtin_amdgcn_sched_barrier(0)
#define PG8_VOFFS(u, v) do { if constexpr (GATHER) { _Pragma("unroll") for (int h_ = 0; h_ < 2; ++h_) _Pragma("unroll") for (int i_ = 0; i_ < 2; ++i_) { int R_, C_; stage_rc(tid * 16 + i_ * 8192, R_, C_); \
        v[h_][i_] = (unsigned)S.arow(u, h_ * HALF + R_) * (unsigned)(g.lda * ESZ) + (unsigned)C_ * 2u; } } } while (0)
#define PG8_ABASE(u) ((const char*)g.A + ((size_t)(u).pb * g.a_pb) * ESZ + (GATHER ? (size_t)0 : (size_t)(u).pm * tstepA))
#define PG8_BBASE(u) ((const char*)g.Bt + ((size_t)(u).pb * g.b_pb) * ESZ + (size_t)(u).pn * tstepB)
    Unit cur, nxt; int ui = 0;
    if (!S.next(0, cur)) return;
    f32x4 acc[2][2][4][2];
#pragma unroll
    for (int a = 0; a < 2; ++a)
#pragma unroll
        for (int b = 0; b < 2; ++b)
#pragma unroll
            for (int m = 0; m < 4; ++m)
#pragma unroll
                for (int n = 0; n < 2; ++n) acc[a][b][m][n] = (f32x4){0.f, 0.f, 0.f, 0.f};
    bf16x8 At[4][2], B0[2][2], B1[2][2];
    i32x8 At8[4], B08[2], B18[2];
    (void)At8; (void)B08; (void)B18;
    unsigned vA[2][2] = {{voffA[0], voffA[1]}, {voffA[0], voffA[1]}};
    PG8_VOFFS(cur, vA);
    const char* cA = PG8_ABASE(cur); const char* cB = PG8_BBASE(cur);
    PG8_STAGE(PG8_SB(0, 0), cB, voffB[0], voffB[1]); PG8_STAGE(PG8_SB(0, 1), cB + hstepB, voffB[0], voffB[1]);
    PG8_STAGE(PG8_SA(0, 0), cA, vA[0][0], vA[0][1]); PG8_STAGE(PG8_SA(0, 1), cA + hstepA, vA[1][0], vA[1][1]);
    if (wr == 1) PG8_BAR;
    PG8_WAIT_V(2); PG8_BAR;
    PG8_STAGE(PG8_SB(1, 0), cB + kstep, voffB[0], voffB[1]); PG8_STAGE(PG8_SA(1, 0), cA + kstepA, vA[0][0], vA[0][1]); PG8_STAGE(PG8_SB(1, 1), cB + hstepB + kstep, voffB[0], voffB[1]);
    PG8_WAIT_V(6); PG8_BAR;
    for (;;) {
        const bool has_next = S.next(ui + 1, nxt);
        const char* nA = cA; const char* nB = cB;
        if (has_next) { nA = PG8_ABASE(nxt); nB = PG8_BBASE(nxt); }
#pragma nounroll
        for (int t = 0; t < nt; t += 2) {
            const bool last = (t == nt - 2);
            const char* a1 = cA + (size_t)(t + 1) * kstepA;
            const char* a2 = last ? nA : cA + (size_t)(t + 2) * kstepA; const char* b2 = last ? nB : cB + (size_t)(t + 2) * kstep;
            const char* a3 = a2 + kstepA; const char* b3 = b2 + kstep;
            const unsigned c10 = vA[1][0], c11 = vA[1][1];
            if (last && has_next) PG8_VOFFS(nxt, vA);
            const unsigned w00 = vA[0][0], w01 = vA[0][1], w10 = vA[1][0], w11 = vA[1][1];
            PG8_LDB(B0, 0, 0); PG8_LDB(B1, 0, 1); PG8_SCHED; PG8_LDA(At, 0, 0); PG8_STAGE(PG8_SA(1, 1), a1 + hstepA, c10, c11);
            PG8_WAIT_V(8); PG8_WAIT_L(0); PG8_BAR; PG8_MMA(0, 0, At, B0); PG8_MMA(0, 1, At, B1); PG8_BAR; PG8_SCHED;
            PG8_LDA(At, 0, 1); PG8_STAGE(PG8_SB(0, 0), b2, voffB[0], voffB[1]); PG8_STAGE(PG8_SB(0, 1), b2 + hstepB, voffB[0], voffB[1]); PG8_STAGE(PG8_SA(0, 0), a2, w00, w01);
            PG8_WAIT_V(8); PG8_WAIT_L(0); PG8_BAR; PG8_MMA(1, 0, At, B0); PG8_MMA(1, 1, At, B1); PG8_BAR; PG8_SCHED;
            PG8_LDB(B0, 1, 0); PG8_LDB(B1, 1, 1); PG8_SCHED; PG8_LDA(At, 1, 0); PG8_STAGE(PG8_SA(0, 1), a2 + hstepA, w10, w11);
            PG8_WAIT_V(8); PG8_WAIT_L(0); PG8_BAR; PG8_MMA(0, 0, At, B0); PG8_MMA(0, 1, At, B1); PG8_BAR; PG8_SCHED;
            PG8_LDA(At, 1, 1); PG8_STAGE(PG8_SB(1, 0), b3, voffB[0], voffB[1]); PG8_STAGE(PG8_SB(1, 1), b3 + hstepB, voffB[0], voffB[1]); PG8_STAGE(PG8_SA(1, 0), a3, w00, w01);
            PG8_WAIT_V(8); PG8_WAIT_L(0); PG8_BAR; PG8_MMA(1, 0, At, B0); PG8_MMA(1, 1, At, B1); PG8_BAR; PG8_SCHED;
        }
        if constexpr (ALIGN_EPI) { if (wr == 0) PG8_BAR; }
        if constexpr (FP8) asm volatile("s_nop 15\n\ts_nop 15" ::: "memory");
        E(acc, cur, wr, wc, fr, fq);
        if (!has_next) break;
        if (!Sched::KEEP || nxt.pb == 0) {
#pragma unroll
        for (int a = 0; a < 2; ++a)
#pragma unroll
            for (int b = 0; b < 2; ++b)
#pragma unroll
                for (int m = 0; m < 4; ++m)
#pragma unroll
                    for (int n = 0; n < 2; ++n) acc[a][b][m][n] = (f32x4){0.f, 0.f, 0.f, 0.f};
        }
        cur = nxt; cA = nA; cB = nB; ++ui;
        if constexpr (ALIGN_EPI) { if (wr == 1) PG8_BAR; }
    }
    PG8_WAIT_V(0);
    if constexpr (!ALIGN_EPI) { if (wr == 0) PG8_BAR; }
    PG8_BAR;
#undef PG8_SA
#undef PG8_SB
#undef PG8_STAGE
#undef PG8_LDA
#undef PG8_LDB
#undef PG8_MMA
#undef PG8_CAT
#undef PG8_WAIT_V
#undef PG8_WAIT_L
#undef PG8_BAR
#undef PG8_SCHED
#undef PG8_VOFFS
#undef PG8_ABASE
#undef PG8_BBASE
}
}
namespace pg8 {
DI void store8(bf16_t* p, f32x4 v0, f32x4 v1) { u32x4 w; w.x = pk2(v0[0], v0[1]); w.y = pk2(v0[2], v0[3]); w.z = pk2(v1[0], v1[1]); w.w = pk2(v1[2], v1[3]); *(u32x4*)p = w; }
DI void load8(const bf16_t* p, f32x4& v0, f32x4& v1) { const u32x4 w = *(const u32x4*)p; v0 = (f32x4){bflo(w.x), bfhi(w.x), bflo(w.y), bfhi(w.y)}; v1 = (f32x4){bflo(w.z), bfhi(w.z), bflo(w.w), bfhi(w.w)}; }
DI void rope8(f32x4& v0, f32x4& v1, const f32x4 c, const f32x4 s) {
    const f32x4 a0 = v0, a1 = v1;
    v0[0] = a0[0] * c[0] - a0[1] * s[0]; v0[1] = a0[1] * c[0] + a0[0] * s[0];
    v0[2] = a0[2] * c[1] - a0[3] * s[1]; v0[3] = a0[3] * c[1] + a0[2] * s[1];
    v1[0] = a1[0] * c[2] - a1[1] * s[2]; v1[1] = a1[1] * c[2] + a1[0] * s[2];
    v1[2] = a1[2] * c[3] - a1[3] * s[3]; v1[3] = a1[3] * c[3] + a1[2] * s[3];
}
DI int row_pos(int row) { const int tp = row % TP; return tp >= PADF ? tp - PADF : 0; }

struct EpiProj {
    bf16_t* O; const float* tabR; const float* tabM; float* ssq;
    DI void operator()(const f32x4 (&acc)[2][2][4][2], const Unit& u, int wr, int wc, int fr, int fq) const {
        const int row0 = u.pm * BM + wr * 64 + fr, colw = u.pn * BM + wc * 32 + 8 * fq;
        const bool ropeR = u.pn < 2, ropeM = (u.pn == 7 && wc == 0);
#pragma unroll
        for (int ai = 0; ai < 2; ++ai) {
            f32x4 tc[4], ts[4];
#pragma unroll
            for (int m = 0; m < 4; ++m) { tc[m] = (f32x4){1.f, 1.f, 1.f, 1.f}; ts[m] = (f32x4){0.f, 0.f, 0.f, 0.f}; }
            if (ropeR || ropeM) {
#pragma unroll
                for (int m = 0; m < 4; ++m) { const int pos = row_pos(row0 + ai * HALF + m * 16);
                    const float* t = ropeR ? tabR + (size_t)pos * 64 + ((colw & 63) >> 1) : tabM + (size_t)pos * 32 + 4 * fq;
                    tc[m] = *(const f32x4*)t; ts[m] = *(const f32x4*)(t + (ropeR ? 32 : 16)); }
            }
#pragma unroll
            for (int m = 0; m < 4; ++m) {
                const int row = row0 + ai * HALF + m * 16;
                float sq = 0.f;
#pragma unroll
                for (int bj = 0; bj < 2; ++bj) {
                    f32x4 v0 = acc[ai][bj][m][0], v1 = acc[ai][bj][m][1]; const int col = colw + bj * HALF;
                    if (ropeR || (ropeM && bj == 1)) rope8(v0, v1, tc[m], ts[m]);
                    if (u.pn == 6 || (u.pn == 7 && bj == 0)) sq += (v0[0] * v0[0] + v0[1] * v0[1]) + (v0[2] * v0[2] + v0[3] * v0[3]) + (v1[0] * v1[0] + v1[1] * v1[1]) + (v1[2] * v1[2] + v1[3] * v1[3]);
                    store8(O + (size_t)row * NPROJ + col, v0, v1);
                }
                if (u.pn == 6 || u.pn == 7) { sq = sum_x16(sq); sq = sum_x32(sq); if (fq == 0) ssq[(size_t)row * 8 + (u.pn == 7 ? 4 : 0) + wc] = sq; }
            }
        }
    }
};
struct EpiQ {
    bf16_t* O; const float* tabM; const float* ssq;
    DI void operator()(const f32x4 (&acc)[2][2][4][2], const Unit& u, int wr, int wc, int fr, int fq) const {
        const int row0 = u.pm * BM + wr * 64 + fr, colw = u.pn * BM + wc * 32 + 8 * fq;
#pragma unroll
        for (int ai = 0; ai < 2; ++ai)
#pragma unroll
        for (int mh = 0; mh < 2; ++mh) {
            f32x4 sp[2], tc[2][2], ts[2][2];
#pragma unroll
            for (int mm = 0; mm < 2; ++mm) { const int row = row0 + ai * HALF + (2 * mh + mm) * 16, pos = row_pos(row);
                sp[mm] = *(const f32x4*)(ssq + (size_t)row * 8);
#pragma unroll
                for (int bj = 0; bj < 2; ++bj) { const int c = (colw + bj * HALF) % 96; const float* t = tabM + (size_t)pos * 32 + (c >= 64 ? ((c - 64) >> 1) : 0);
                    tc[mm][bj] = *(const f32x4*)t; ts[mm][bj] = *(const f32x4*)(t + 16); } }
#pragma unroll
            for (int mm = 0; mm < 2; ++mm) {
                const int m = 2 * mh + mm, row = row0 + ai * HALF + m * 16; const f32x4 s4 = sp[mm];
                const float rstd = 1.0f / sqrtf(((s4[0] + s4[1]) + (s4[2] + s4[3])) * (1.0f / 256.0f) + 1e-6f);
#pragma unroll
                for (int bj = 0; bj < 2; ++bj) {
                    f32x4 v0 = acc[ai][bj][m][0] * rstd, v1 = acc[ai][bj][m][1] * rstd; const int col = colw + bj * HALF;
                    const bool rp = (col % 96) >= 64;
                    f32x4 r0 = v0, r1 = v1; rope8(r0, r1, tc[mm][bj], ts[mm][bj]);
#pragma unroll
                    for (int j = 0; j < 4; ++j) { v0[j] = rp ? r0[j] : v0[j]; v1[j] = rp ? r1[j] : v1[j]; }
                    store8(O + (size_t)row * 768 + col, v0, v1);
                }
            }
        }
    }
};
struct EpiKV {
    bf16_t* O; const float* ssq;
    DI void operator()(const f32x4 (&acc)[2][2][4][2], const Unit& u, int wr, int wc, int fr, int fq) const {
        const int row0 = u.pm * BM + wr * 64 + fr, colw = u.pn * BM + wc * 32 + 8 * fq;
#pragma unroll
        for (int ai = 0; ai < 2; ++ai) {
            f32x4 sp[4];
#pragma unroll
            for (int m = 0; m < 4; ++m) sp[m] = *(const f32x4*)(ssq + (size_t)(row0 + ai * HALF + m * 16) * 8 + 4);
#pragma unroll
            for (int m = 0; m < 4; ++m) {
                const int row = row0 + ai * HALF + m * 16; const f32x4 s4 = sp[m];
                const float rstd = 1.0f / sqrtf(((s4[0] + s4[1]) + (s4[2] + s4[3])) * (1.0f / 128.0f) + 1e-6f);
#pragma unroll
                for (int bj = 0; bj < 2; ++bj) store8(O + (size_t)row * 1024 + colw + bj * HALF, acc[ai][bj][m][0] * rstd, acc[ai][bj][m][1] * rstd);
            }
        }
    }
};
DI unsigned gate_q4(const f32x4 v) { unsigned q[4];
#pragma unroll
    for (int j = 0; j < 4; ++j) q[j] = (unsigned)fmaxf(v[j] * 255.0f + 0.5f, 1.0f);
    return q[0] | (q[1] << 8) | (q[2] << 16) | (q[3] << 24); }
DI f32x4 gate_f4(const unsigned w) { return (f32x4){(float)(w & 0xffu), (float)((w >> 8) & 0xffu), (float)((w >> 16) & 0xffu), (float)(w >> 24)}; }
struct EpiGate {
    unsigned char* O; const float* bias;
    DI void operator()(const f32x4 (&acc)[2][2][4][2], const Unit& u, int wr, int wc, int fr, int fq) const {
        const int row0 = u.pm * BM + wr * 64 + fr, colw = u.pn * BM + wc * 32 + 8 * fq;
#pragma unroll
        for (int bj = 0; bj < 2; ++bj) { const f32x4 b0 = *(const f32x4*)(bias + colw + bj * HALF), b1 = *(const f32x4*)(bias + colw + bj * HALF + 4);
#pragma unroll
        for (int ai = 0; ai < 2; ++ai)
#pragma unroll
            for (int m = 0; m < 4; ++m) {
                const int row = row0 + ai * HALF + m * 16;
                { constexpr float DS = 1.0f / (X8_SCALE * WGU_SCALE); f32x4 v0 = acc[ai][bj][m][0] * DS + b0, v1 = acc[ai][bj][m][1] * DS + b1;
#pragma unroll
                    for (int j = 0; j < 4; ++j) { v0[j] = fast_sigmoid(v0[j]); v1[j] = fast_sigmoid(v1[j]); }
                    *(u32x2*)(O + gate_addr((size_t)row, colw + bj * HALF)) = (u32x2){gate_q4(v0), gate_q4(v1)}; }
            } }
    }
};
struct EpiBranch {
    bf16_t* O; const unsigned char* gates;
    DI void operator()(f32x4 (&acc)[2][2][4][2], const Unit& u, int wr, int wc, int fr, int fq) const {
        const int row0 = u.pm * BM + wr * 64 + fr, colw = u.pn * BM + wc * 32 + 8 * fq;
        const bool fin = u.pb == 3;
        const int gcol = u.pb * 1024 + colw; const int hoff = fin ? 0 : 4096;
        u32x2 G[2][4][2], H[2][4][2];
#pragma unroll
        for (int ai = 0; ai < 2; ++ai)
#pragma unroll
            for (int m = 0; m < 4; ++m)
#pragma unroll
                for (int bj = 0; bj < 2; ++bj) { const unsigned char* gp = gates + gate_addr((size_t)(row0 + ai * HALF + m * 16), gcol + bj * HALF); G[ai][m][bj] = *(const u32x2*)gp; H[ai][m][bj] = *(const u32x2*)(gp + hoff); }
#pragma unroll
        for (int ai = 0; ai < 2; ++ai)
#pragma unroll
            for (int m = 0; m < 4; ++m)
#pragma unroll
                for (int bj = 0; bj < 2; ++bj) {
                    f32x4 g0 = gate_f4(G[ai][m][bj][0]), g1 = gate_f4(G[ai][m][bj][1]); const f32x4 h0 = gate_f4(H[ai][m][bj][0]), h1 = gate_f4(H[ai][m][bj][1]);
#pragma unroll
                    for (int j = 0; j < 4; ++j) { g0[j] *= fin ? (1.0f / (255.0f * YB_SCALE * WDN_SCALE)) : __builtin_amdgcn_rcpf(h0[j]); g1[j] *= fin ? (1.0f / (255.0f * YB_SCALE * WDN_SCALE)) : __builtin_amdgcn_rcpf(h1[j]); }
                    acc[ai][bj][m][0] *= g0; acc[ai][bj][m][1] *= g1;
                    if (fin) store8(O + (size_t)(row0 + ai * HALF + m * 16) * 1024 + colw + bj * HALF, acc[ai][bj][m][0], acc[ai][bj][m][1]); }
    }
};
struct EpiOut {
    bf16_t* H;
    DI void operator()(const f32x4 (&acc)[2][2][4][2], const Unit& u, int wr, int wc, int fr, int fq) const {
        const int row0 = u.pm * BM + wr * 64 + fr, colw = u.pn * BM + wc * 32 + 8 * fq;
#pragma unroll
        for (int ai = 0; ai < 2; ++ai)
#pragma unroll
            for (int m = 0; m < 4; ++m) {
                const int row = row0 + ai * HALF + m * 16;
#pragma unroll
                for (int bj = 0; bj < 2; ++bj) { bf16_t* o = H + (size_t)row * 1024 + colw + bj * HALF; f32x4 p0, p1; load8(o, p0, p1);
                    store8(o, p0 * DN_ALPHA + acc[ai][bj][m][0], p1 * DN_ALPHA + acc[ai][bj][m][1]); }
            }
    }
};

struct MoeTabs { const LAS int* ebase; const LAS int* ecnt; const LAS unsigned char* tile_e; const int* list; int ntiles; };
template <int NN, bool GATHER_> struct MoeOrder {
    static constexpr bool GATHER = GATHER_, KEEP = false;
    MoeTabs T; int G, c;
    DI bool next(int i, Unit& u) const { int t, pn;
        if ((G & 7) == 0 && ((G >> 3) % NN) == 0) { const int x = c & 7, j = c >> 3, tpr = G / NN, tpx = tpr >> 3; pn = j % NN; t = i * tpr + x * tpx + j / NN; }
        else { const long L = (long)i * G + c; t = (int)(L / NN); pn = (int)(L % NN); }
        if (t >= T.ntiles) return false; u.pm = t; u.pn = pn; u.pb = __builtin_amdgcn_readfirstlane((int)T.tile_e[t]); return true; }
    DI int arow(const Unit& u, int r) const {
        const int e = u.pb, idx = (u.pm - T.ebase[e]) * BM + r;
        return idx < T.ecnt[e] ? (T.list[(size_t)e * M + idx] >> 2) : 0;
    }
};
struct EpiSwiglu {
    unsigned char* O; const float* bg; const float* bu;
    DI void operator()(const f32x4 (&acc)[2][2][4][2], const Unit& u, int wr, int wc, int fr, int fq) const {
        const int row0 = u.pm * BM + wr * 64 + fr, cw = u.pn * HALF + wc * 32 + 8 * fq;
        constexpr float DS = 1.0f / (X8_SCALE * WGU_SCALE);
        f32x4 g_b[2], u_b[2];
#pragma unroll
        for (int n = 0; n < 2; ++n) { g_b[n] = *(const f32x4*)(bg + (size_t)u.pb * DE + cw + 4 * n); u_b[n] = *(const f32x4*)(bu + (size_t)u.pb * DE + cw + 4 * n); }
#pragma unroll
        for (int ai = 0; ai < 2; ++ai)
#pragma unroll
            for (int m = 0; m < 4; ++m) {
                const int row = row0 + ai * HALF + m * 16; f32x4 o[2];
#pragma unroll
                for (int n = 0; n < 2; ++n) { const f32x4 gt = acc[ai][0][m][n] * DS + g_b[n], up = acc[ai][1][m][n] * DS + u_b[n];
#pragma unroll
                    for (int j = 0; j < 4; ++j) { const float gg = fminf(gt[j], 7.0f), uu = fminf(fmaxf(up[j], -7.0f), 7.0f); o[n][j] = (uu + 1.0f) * gg * fast_sigmoid(1.702f * gg) * ACT_SCALE; } }
                *(u32x2*)(O + ((size_t)(row >> 2) << 12) + ((size_t)(cw >> 7) << 9) + (size_t)(((cw >> 5) & 3) << 7) + (size_t)((row & 3) << 5) + (size_t)(cw & 31)) = (u32x2){pk4_fp8(o[0][0], o[0][1], o[0][2], o[0][3]), pk4_fp8(o[1][0], o[1][1], o[1][2], o[1][3])};
            }
    }
};
struct EpiDown {
    unsigned char* O; const float* bd; MoeTabs T;
    DI void operator()(const f32x4 (&acc)[2][2][4][2], const Unit& u, int wr, int wc, int fr, int fq) const {
        const int e = u.pb, r0 = wr * 64 + fr, colw = u.pn * BM + wc * 32 + 8 * fq, ibase = (u.pm - T.ebase[e]) * BM, cnt = T.ecnt[e];
        constexpr float DS = 1.0f / (ACT_SCALE * WDN_SCALE);
        f32x4 bv[2][2];
#pragma unroll
        for (int bj = 0; bj < 2; ++bj)
#pragma unroll
            for (int n = 0; n < 2; ++n) bv[bj][n] = *(const f32x4*)(bd + (size_t)e * D + colw + bj * HALF + 4 * n);
        int ents[2][4];
#pragma unroll
        for (int ai = 0; ai < 2; ++ai)
#pragma unroll
            for (int m = 0; m < 4; ++m) { const int idx = ibase + r0 + ai * HALF + m * 16; ents[ai][m] = T.list[(size_t)e * M + (idx < cnt ? idx : 0)]; }
#pragma unroll
        for (int ai = 0; ai < 2; ++ai)
#pragma unroll
            for (int m = 0; m < 4; ++m) {
                const int idx = ibase + r0 + ai * HALF + m * 16;
                if (idx < cnt) { const int ent = ents[ai][m];
#pragma unroll
                    for (int bj = 0; bj < 2; ++bj) { const f32x4 v0 = (acc[ai][bj][m][0] * DS + bv[bj][0]) * YS_SCALE, v1 = (acc[ai][bj][m][1] * DS + bv[bj][1]) * YS_SCALE;
                        *(u32x2*)(O + (size_t)ent * D + colw + bj * HALF) = (u32x2){pk4_fp8(v0[0], v0[1], v0[2], v0[3]), pk4_fp8(v1[0], v1[1], v1[2], v1[3])}; } }
            }
    }
};
}
struct KArgs { const float* in[34]; float* out; unsigned char* ws; int ph_lo, ph_hi; float invR[32]; float invM[16]; };
typedef const __attribute__((address_space(4))) KArgs* kargs_t;
DI kargs_t get_args() { kargs_t p = (kargs_t)__builtin_amdgcn_kernarg_segment_ptr(); asm volatile("" : "+s"(p)); return p; }
struct Frame {
    LAS unsigned char* lds; gu32* ctl; unsigned char* ws;
    int tid, lane, wave, G, bid;
};
enum { I_X = 0, I_META, I_LN0G, I_LN0B, I_WIN, I_WMERGE, I_BMERGE, I_GCQ, I_GCKV, I_WUQ, I_WUKV, I_CONVW, I_CONVB, I_WLA, I_BLA, I_WLX, I_BLX, I_LAM, I_WA2, I_BA2,
       I_WBR, I_WOUT, I_LN1G, I_LN1B, I_WR, I_BR, I_WEG, I_BEG, I_WEU, I_BEU, I_WED, I_BED, I_LN2G, I_LN2B };

struct ColSrc { const float* p; float scale; };
template <class F>
DI void transpose_fill(const Frame& Fr, F colmap, int n0, int k0, int ldsrc, const float* kscale, float post) {
    LAS float* scr = (LAS float*)(Fr.lds + Fr.wave * 16384);
    const int lane = Fr.lane;
    const ColSrc c0 = colmap(n0), c31 = colmap(n0 + 31), cme = colmap(n0 + (lane & 31));
    const bool contig = c0.p && c31.p == c0.p + 31 && cme.p == c0.p + (lane & 31) && c0.scale == c31.scale && (((size_t)c0.p & 15) == 0) && ((ldsrc & 3) == 0);
    if (__all(contig)) {
        const float sc = c0.scale * post; const int kk = lane >> 3, n4 = lane & 7;
        const float* src = c0.p + (size_t)(k0 + kk) * ldsrc + 4 * n4;
        f32x4 v[8];
#pragma unroll
        for (int i = 0; i < 8; ++i) v[i] = *(const f32x4*)(src + (size_t)(8 * i) * ldsrc);
#pragma unroll
        for (int i = 0; i < 8; ++i) { float ks = sc; if (kscale) ks *= kscale[k0 + 8 * i + kk]; LAS float* d = scr + (8 * i + kk) * 33 + 4 * n4; d[0] = v[i][0] * ks; d[1] = v[i][1] * ks; d[2] = v[i][2] * ks; d[3] = v[i][3] * ks; }
    } else {
        const float* src = cme.p ? cme.p : colmap(0).p;
        const float sc = cme.p ? cme.scale * post : 0.f;
        src += (size_t)(k0 + (lane >> 5)) * ldsrc;
        float v[32];
#pragma unroll
        for (int i = 0; i < 32; ++i) v[i] = src[(size_t)(2 * i) * ldsrc];
        if (kscale) {
#pragma unroll
            for (int i = 0; i < 32; ++i) v[i] *= kscale[k0 + 2 * i + (lane >> 5)];
        }
#pragma unroll
        for (int i = 0; i < 32; ++i) scr[(2 * i + (lane >> 5)) * 33 + (lane & 31)] = v[i] * sc;
    }
    LDS_WAIT(); asm volatile("" ::: "memory");
}
template <class F>
DI void transpose_item(const Frame& Fr, F colmap, int item, int ndst, int K, int ldsrc, const float* kscale, bf16_t* WT) {
    LAS float* scr = (LAS float*)(Fr.lds + Fr.wave * 16384);
    const int lane = Fr.lane, nblk = ndst / 32;
    const int kb = item / nblk, nb = item % nblk, k0 = 64 * kb, n0 = 32 * nb;
    transpose_fill(Fr, colmap, n0, k0, ldsrc, kscale, 1.0f);
    const int c = lane & 7;
#pragma unroll
    for (int j = 0; j < 4; ++j) { const int n = (lane >> 3) + 8 * j; const LAS float* s = scr + (8 * c) * 33 + n;
        u32x4 o; o.x = pk2(s[0 * 33], s[1 * 33]); o.y = pk2(s[2 * 33], s[3 * 33]); o.z = pk2(s[4 * 33], s[5 * 33]); o.w = pk2(s[6 * 33], s[7 * 33]);
        *(u32x4*)(WT + (size_t)(n0 + n) * K + k0 + 8 * c) = o; }
    LDS_WAIT(); asm volatile("" ::: "memory");
}
template <class F>
DI void transpose_item_fp8(const Frame& Fr, F colmap, int item, int ndst, int K, int ldsrc, float sc8, unsigned char* WT) {
    LAS float* scr = (LAS float*)(Fr.lds + Fr.wave * 16384);
    const int lane = Fr.lane, nblk = ndst / 32;
    const int kb = item / nblk, nb = item % nblk, k0 = 64 * kb, n0 = 32 * nb;
    transpose_fill(Fr, colmap, n0, k0, ldsrc, nullptr, sc8);
    const int c = lane & 7;
#pragma unroll
    for (int j = 0; j < 4; ++j) { const int n = (lane >> 3) + 8 * j; const LAS float* s = scr + (8 * c) * 33 + n;
        *(u32x2*)(WT + (size_t)(n0 + n) * K + k0 + 8 * c) = (u32x2){pk4_fp8(s[0 * 33], s[1 * 33], s[2 * 33], s[3 * 33]), pk4_fp8(s[4 * 33], s[5 * 33], s[6 * 33], s[7 * 33])}; }
    LDS_WAIT(); asm volatile("" ::: "memory");
}
struct MapIn {
    const float* W;
    DI ColSrc operator()(int n) const {
        int src; float sc = 1.f;
        if (n < 256) { const int h = n >> 6, c = n & 63; src = O_RQ + h * 64 + (c >> 1) + 32 * (c & 1); }
        else if (n < 512) { const int q = n - 256, h = q >> 6, c = q & 63; src = O_RK + h * 64 + (c >> 1) + 32 * (c & 1); sc = 0.125f; }
        else if (n < 1024) src = O_RV + (n - 512);
        else if (n < 1536) src = O_RG + (n - 1024);
        else if (n < 1792) src = O_CQ + (n - 1536);
        else if (n < 1920) src = O_CKV + (n - 1792);
        else if (n < 1952) { const int c = n - 1920; src = O_KR + (c >> 1) + 16 * (c & 1); }
        else if (n < 1968) src = O_GA + (n - 1952);
        else if (n < 2048) return ColSrc{nullptr, 0.f};
        else if (n < 2560) src = O_LX + (n - 2048);
        else if (n < 3072) src = O_LG + (n - 2560);
        else if (n < 3328) src = O_GQ + (n - 3072);
        else if (n < 3584) { src = O_GK + (n - 3328); sc = 0.125f; }
        else if (n < 4096) src = O_GV + (n - 3584);
        else src = O_GG + (n - 4096);
        return ColSrc{W + src, sc};
    }
};
struct MapPlain { const float* W; DI ColSrc operator()(int n) const { return ColSrc{W + n, 1.f}; } };
struct MapUq {
    const float* W;
    DI ColSrc operator()(int n) const { const int h = n / 96, c = n % 96; int src = h * 96 + c; if (c >= 64) { const int cc = c - 64; src = h * 96 + 64 + (cc >> 1) + 16 * (cc & 1); }
        return ColSrc{W + src, 0.10206207261596577f * LOG2E}; }
};
struct MapUkv {
    const float* W;
    DI ColSrc operator()(int n) const { const int q = n & 511, h = q >> 6, d = q & 63; return ColSrc{W + h * 128 + (n >= 512 ? 64 : 0) + d, 1.f}; }
};
struct MapGU {
    const float* Wg; const float* Wu;
    DI ColSrc operator()(int n) const { const int j = n >> 8, r = n & 255; const long dlt = (r < 128) ? 0 : (long)(Wu - Wg); return ColSrc{Wg + dlt + 128 * j + (r & 127), 1.f}; }
};

constexpr int CI_IN = (NPROJ / 32) * (D / 64), CI_MG = (4096 / 32) * (D / 64), CI_BR1 = (D / 32) * (512 / 64), CI_OUT = (D / 32) * (D / 64), CI_UQ = (768 / 32) * (256 / 64),
              CI_UKV = (1024 / 32) * (128 / 64), CI_GU1 = (2048 / 32) * (D / 64), CI_DN1 = (D / 32) * (DE / 64);
constexpr int CO_MG = CI_IN, CO_BR = CO_MG + CI_MG, CO_OUT = CO_BR + 4 * CI_BR1, CO_UQ = CO_OUT + CI_OUT, CO_UKV = CO_UQ + CI_UQ, CO_GU = CO_UKV + CI_UKV, CO_DN = CO_GU + NE * CI_GU1,
              CI_TOTAL = CO_DN + NE * CI_DN1;
struct ConvItem { const float* src; unsigned char* dst; float scale; int ldsrc, K, n0, k0; bool fast, fp8; };
DI ConvItem conv_decode(kargs_t a, unsigned char* ws, int l, int it, int lane) {
    ConvItem c; c.src = nullptr; c.dst = nullptr; c.scale = 1.f; c.ldsrc = 0; c.K = 0; c.n0 = 0; c.k0 = 0; c.fast = false; c.fp8 = false;
    const float* W = nullptr; int ndst = 0, srccol = -1; int r = it;
    if (it >= CO_DN) { r = it - CO_DN; const int e = r / CI_DN1; r %= CI_DN1; W = a->in[I_WED] + ((size_t)l * NE + e) * D * DE; ndst = D; c.K = DE; c.ldsrc = D; c.fp8 = true; c.scale = WDN_SCALE; c.dst = ws + W_DN + (size_t)e * D * DE; srccol = 0; }
    else if (it >= CO_GU) { r = it - CO_GU; const int e = r / CI_GU1; r %= CI_GU1; ndst = 2048; c.K = D; c.ldsrc = DE; c.fp8 = true; c.scale = WGU_SCALE; c.dst = ws + W_GU + (size_t)e * 2048 * D; srccol = -2;
        W = a->in[I_WEG] + ((size_t)l * NE + e) * D * DE; }
    else if (it >= CO_UQ) return c;
    else if (it >= CO_OUT) { r = it - CO_OUT; W = a->in[I_WOUT] + (size_t)l * D * D; ndst = D; c.K = D; c.ldsrc = D; c.dst = ws + W_OUT; srccol = 0; }
    else if (it >= CO_BR) { r = it - CO_BR; const int n = r / CI_BR1; r %= CI_BR1; W = a->in[I_WBR] + ((size_t)l * 4 + n) * 512 * D; ndst = D; c.K = 512; c.ldsrc = D; c.fp8 = true; c.scale = WDN_SCALE; c.dst = ws + W_BR + (size_t)n * D * 512; srccol = 0; }
    else if (it >= CO_MG) { r = it - CO_MG; W = a->in[I_WMERGE] + (size_t)l * D * 4096; ndst = 4096; c.K = D; c.ldsrc = 4096; c.fp8 = true; c.scale = WGU_SCALE; c.dst = ws + W_MG; srccol = 0; }
    else { W = a->in[I_WIN] + (size_t)l * D * D_IN; ndst = NPROJ; c.K = D; c.ldsrc = D_IN; c.dst = ws + W_IN; srccol = -3; }
    const int nblk = ndst / 32; c.k0 = 64 * (r / nblk); c.n0 = 32 * (r % nblk);
    int col;
    if (srccol == 0) col = c.n0;
    else if (srccol == -2) { const int j = c.n0 >> 8, rr = c.n0 & 255; if (rr >= 128) W = a->in[I_WEU] + (W - a->in[I_WEG]); col = 128 * j + (rr & 127); }
    else { if (c.n0 < 512 || (c.n0 >= 1920 && c.n0 < 2048)) return c;
        const ColSrc cs = MapIn{W}(c.n0); col = (int)(cs.p - W); c.scale = cs.scale; }
    const float* p0 = W + col;
    if ((((size_t)p0) & 15) != 0 || (c.ldsrc & 3) != 0) return c;
    c.src = p0 + (size_t)(c.k0 + 8 * (lane >> 3)) * c.ldsrc + 4 * (lane & 7); c.fast = true;
    return c;
}
DI void conv_load(const ConvItem& c, f32x4 (&v)[8]) {
#pragma unroll
    for (int i = 0; i < 8; ++i) v[i] = *(const f32x4*)(c.src + (size_t)i * c.ldsrc);
}
DI void conv_finish(const Frame& Fr, const ConvItem& c, const f32x4 (&v)[8]) {
    const int lane = Fr.lane, kg = lane >> 3, n4 = lane & 7; const float sc = c.scale;
#pragma unroll
    for (int j = 0; j < 4; ++j) { const size_t e = (size_t)(c.n0 + 4 * n4 + j) * c.K + c.k0 + 8 * kg;
        if (c.fp8) *(u32x2*)(c.dst + e) = (u32x2){pk4_fp8(v[0][j] * sc, v[1][j] * sc, v[2][j] * sc, v[3][j] * sc), pk4_fp8(v[4][j] * sc, v[5][j] * sc, v[6][j] * sc, v[7][j] * sc)};
        else *(u32x4*)((bf16_t*)c.dst + e) = (u32x4){pk2(v[0][j] * sc, v[1][j] * sc), pk2(v[2][j] * sc, v[3][j] * sc), pk2(v[4][j] * sc, v[5][j] * sc), pk2(v[6][j] * sc, v[7][j] * sc)}; }
}
DI void conv_slow(const Frame& F, kargs_t a, int l, int it) {
    unsigned char* ws = F.ws;
    if (it >= CO_UKV && it < CO_GU) transpose_item(F, MapUkv{a->in[I_WUKV] + (size_t)l * 128 * 1024}, it - CO_UKV, 1024, 128, 1024, a->in[I_GCKV] + l * 128, (bf16_t*)(ws + W_UKV));
    else if (it >= CO_UQ && it < CO_UKV) transpose_item(F, MapUq{a->in[I_WUQ] + (size_t)l * 256 * 768}, it - CO_UQ, 768, 256, 768, a->in[I_GCQ] + l * 256, (bf16_t*)(ws + W_UQ));
    else transpose_item(F, MapIn{a->in[I_WIN] + (size_t)l * D * D_IN}, it, NPROJ, D, D_IN, nullptr, (bf16_t*)(ws + W_IN));
}
DI void phase_convert(const Frame& F, kargs_t a, int l) {
    const int gw = F.bid * NWAVES + F.wave, NGW = F.G * NWAVES;
    unsigned char* ws = F.ws;
    f32x4 vc[8], vn[8];
#pragma unroll
    for (int i = 0; i < 8; ++i) { vc[i] = (f32x4){0.f, 0.f, 0.f, 0.f}; vn[i] = vc[i]; }
    int it = gw;
    ConvItem cur; cur.fast = false;
    if (it < CI_TOTAL) { cur = conv_decode(a, ws, l, it, F.lane); if (cur.fast) conv_load(cur, vc); }
    for (; it < CI_TOTAL; it += NGW) {
        const int itn = it + NGW; ConvItem nxt; nxt.fast = false;
        if (itn < CI_TOTAL) { nxt = conv_decode(a, ws, l, itn, F.lane); if (nxt.fast) conv_load(nxt, vn); }
        if (cur.fast) conv_finish(F, cur, vc); else conv_slow(F, a, l, it);
        cur = nxt;
#pragma unroll
        for (int i = 0; i < 8; ++i) vc[i] = vn[i];
    }
}


DI f32x4 bf16x4_to_f32(const u32x2 g) { return (f32x4){__uint_as_float(g[0] << 16), __uint_as_float(g[0] & 0xffff0000u), __uint_as_float(g[1] << 16), __uint_as_float(g[1] & 0xffff0000u)}; }
DI void meta_branch(const Frame& F, const unsigned char* gates) {
    unsigned char* ws = F.ws; LAS float* red = (LAS float*)F.lds;
    const int lane = F.lane, w = F.wave, fr = lane & 15, fq = lane >> 4, br = w >> 1, kb = (w & 1) * 256;
    for (int s = F.bid; s < NB * 64; s += F.G) {
        const int b = s >> 6, c0 = (s & 63) * 16;
        const size_t row = (size_t)b * TP + PADF + fr;
        const unsigned char* ap = ws + WS_YS + row * 2048 + br * 512 + kb + 16 * fq;
        const unsigned char* wp = ws + W_BR + ((size_t)br * D + c0 + fr) * 512 + kb + 16 * fq;
        u32x4 av[4], wv[4];
#pragma unroll
        for (int i = 0; i < 4; ++i) { av[i] = *(const u32x4*)(ap + 64 * i); wv[i] = *(const u32x4*)(wp + 64 * i); }
        const unsigned gg = *(const unsigned*)(gates + gate_addr(row, br * 1024 + c0 + 4 * fq));
        f32x4 acc = {0.f, 0.f, 0.f, 0.f};
#pragma unroll
        for (int i = 0; i < 4; ++i) {
            acc = __builtin_amdgcn_mfma_f32_16x16x32_fp8_fp8((long)(((unsigned long long)wv[i].y << 32) | wv[i].x), (long)(((unsigned long long)av[i].y << 32) | av[i].x), acc, 0, 0, 0);
            acc = __builtin_amdgcn_mfma_f32_16x16x32_fp8_fp8((long)(((unsigned long long)wv[i].w << 32) | wv[i].z), (long)(((unsigned long long)av[i].w << 32) | av[i].z), acc, 0, 0, 0); }
        *(LAS f32x4*)(red + w * 256 + fr * 16 + 4 * fq) = acc * (pg8::gate_f4(gg) * (1.0f / (255.0f * YB_SCALE * WDN_SCALE)));
        __syncthreads();
        if (F.tid < 64) { f32x4 sum = *(const LAS f32x4*)(red + F.tid * 4);
#pragma unroll
            for (int k = 1; k < 8; ++k) sum += *(const LAS f32x4*)(red + k * 256 + F.tid * 4);
            *(u32x2*)((bf16_t*)(ws + WS_MIX) + ((size_t)b * TP + PADF + (F.tid >> 2)) * 1024 + c0 + 4 * (F.tid & 3)) = (u32x2){pk2(sum[0], sum[1]), pk2(sum[2], sum[3])}; }
        __syncthreads();
    }
}
DI void meta_gates(const Frame& F, unsigned char* gates, const float* bias) {
    unsigned char* ws = F.ws; LAS float* red = (LAS float*)F.lds;
    const int lane = F.lane, w = F.wave, fr = lane & 15, fq = lane >> 4, cs = w & 3, kb = (w >> 2) * 512;
    for (int s = F.bid; s < NB * 64; s += F.G) {
        const int b = s >> 6, c0 = (s & 63) * 64;
        const size_t row = (size_t)b * TP + PADF + fr;
        const unsigned char* ap = ws + WS_H8 + row * D + kb + 16 * fq;
        const unsigned char* wp = ws + W_MG + (size_t)(c0 + 16 * cs + fr) * D + kb + 16 * fq;
        u32x4 av[8], wv[8];
#pragma unroll
        for (int i = 0; i < 8; ++i) { av[i] = *(const u32x4*)(ap + 64 * i); wv[i] = *(const u32x4*)(wp + 64 * i); }
        f32x4 acc = {0.f, 0.f, 0.f, 0.f};
#pragma unroll
        for (int i = 0; i < 8; ++i) {
            acc = __builtin_amdgcn_mfma_f32_16x16x32_fp8_fp8((long)(((unsigned long long)wv[i].y << 32) | wv[i].x), (long)(((unsigned long long)av[i].y << 32) | av[i].x), acc, 0, 0, 0);
            acc = __builtin_amdgcn_mfma_f32_16x16x32_fp8_fp8((long)(((unsigned long long)wv[i].w << 32) | wv[i].z), (long)(((unsigned long long)av[i].w << 32) | av[i].z), acc, 0, 0, 0); }
        *(LAS f32x4*)(red + w * 256 + fr * 16 + 4 * fq) = acc;
        __syncthreads();
        if (F.tid < 256) { const int r = F.tid >> 4, c4 = F.tid & 15, o = (c4 >> 2) * 256 + r * 16 + 4 * (c4 & 3);
            constexpr float DS = 1.0f / (X8_SCALE * WGU_SCALE);
            f32x4 v = (*(const LAS f32x4*)(red + o) + *(const LAS f32x4*)(red + 1024 + o)) * DS + *(const f32x4*)(bias + c0 + 4 * c4);
#pragma unroll
            for (int j = 0; j < 4; ++j) v[j] = fast_sigmoid(v[j]);
            *(unsigned*)(gates + gate_addr((size_t)b * TP + PADF + r, c0 + 4 * c4)) = pg8::gate_q4(v); }
        __syncthreads();
    }
}
DI void meta_out(const Frame& F, bf16_t* hb) {
    unsigned char* ws = F.ws; LAS float* red = (LAS float*)F.lds;
    const int lane = F.lane, w = F.wave, fr = lane & 15, fq = lane >> 4, kb = w * 128;
    for (int s = F.bid; s < NB * 64; s += F.G) {
        const int b = s >> 6, c0 = (s & 63) * 16;
        const size_t row = (size_t)b * TP + PADF + fr;
        const bf16_t* ap = (const bf16_t*)(ws + WS_MIX) + row * 1024 + kb + 8 * fq;
        const bf16_t* wp = (const bf16_t*)(ws + W_OUT) + (size_t)(c0 + fr) * 1024 + kb + 8 * fq;
        bf16x8 av[4], wv[4];
#pragma unroll
        for (int i = 0; i < 4; ++i) { av[i] = *(const bf16x8*)(ap + 32 * i); wv[i] = *(const bf16x8*)(wp + 32 * i); }
        f32x4 acc = {0.f, 0.f, 0.f, 0.f};
#pragma unroll
        for (int i = 0; i < 4; ++i) acc = __builtin_amdgcn_mfma_f32_16x16x32_bf16(wv[i], av[i], acc, 0, 0, 0);
        *(LAS f32x4*)(red + w * 256 + fr * 16 + 4 * fq) = acc;
        __syncthreads();
        if (F.tid < 64) { f32x4 sum = *(const LAS f32x4*)(red + F.tid * 4);
#pragma unroll
            for (int k = 1; k < 8; ++k) sum += *(const LAS f32x4*)(red + k * 256 + F.tid * 4);
            u32x2* o = (u32x2*)(hb + ((size_t)b * TP + PADF + (F.tid >> 2)) * 1024 + c0 + 4 * (F.tid & 3));
            const f32x4 p = bf16x4_to_f32(*o); sum += p * DN_ALPHA;
            *o = (u32x2){pk2(sum[0], sum[1]), pk2(sum[2], sum[3])}; }
        __syncthreads();
    }
}

DI void ln_stats(const f32x4 (&v)[4], float& mean, float& rstd) {
    float s = 0.f;
#pragma unroll
    for (int j = 0; j < 4; ++j) s += (v[j][0] + v[j][1]) + (v[j][2] + v[j][3]);
    mean = wave_sum(s) * (1.f / D); float s2 = 0.f;
#pragma unroll
    for (int j = 0; j < 4; ++j) { const f32x4 d = v[j] - mean; s2 += (d[0] * d[0] + d[1] * d[1]) + (d[2] * d[2] + d[3] * d[3]); }
    rstd = 1.0f / sqrtf(wave_sum(s2) * (1.f / D) + 1e-5f);
}
DI void row_store_bf16(bf16_t* orow, int lane, const f32x4 (&v)[4]) {
    u32x2* o8 = (u32x2*)orow + lane;
#pragma unroll
    for (int j = 0; j < 4; ++j) o8[64 * j] = (u32x2){pk2(v[j][0], v[j][1]), pk2(v[j][2], v[j][3])};
}
DI void row_load_bf16(const bf16_t* irow, int lane, f32x4 (&v)[4]) {
    const u32x2* i8 = (const u32x2*)irow + lane;
#pragma unroll
    for (int j = 0; j < 4; ++j) { const u32x2 w = i8[64 * j]; v[j] = (f32x4){bflo(w.x), bfhi(w.x), bflo(w.y), bfhi(w.y)}; }
}

DI void phase_ln0(const Frame& F, kargs_t a) {
    const int gw = F.bid * NWAVES + F.wave, NGW = F.G * NWAVES, lane = F.lane;
    bf16_t* hb = (bf16_t*)(F.ws + WS_HB);
    const float* g = a->in[I_LN0G]; const float* bb = a->in[I_LN0B];
    f32x4 gv[4], bv[4];
#pragma unroll
    for (int j = 0; j < 4; ++j) { gv[j] = *((const f32x4*)g + lane + 64 * j); bv[j] = *((const f32x4*)bb + lane + 64 * j); }
    for (int m = gw; m < M; m += NGW) {
        const int b = m / TP, tp = m % TP; f32x4 v[4];
        if (tp < PADF) {
#pragma unroll
            for (int j = 0; j < 4; ++j) v[j] = (f32x4){0.f, 0.f, 0.f, 0.f};
        } else {
            const int pos = tp - PADF; const float* src = pos < NMETA ? a->in[I_META] + (size_t)pos * D : a->in[I_X] + ((size_t)b * SEQ + pos - NMETA) * D;
#pragma unroll
            for (int j = 0; j < 4; ++j) v[j] = *((const f32x4*)src + lane + 64 * j);
            float mean, rstd; ln_stats(v, mean, rstd);
#pragma unroll
            for (int j = 0; j < 4; ++j) v[j] = (v[j] - mean) * rstd * gv[j] + bv[j];
        }
        row_store_bf16(hb + (size_t)m * D, lane, v);
        { unsigned* h8r = (unsigned*)(F.ws + WS_H8 + (size_t)m * D) + lane;
#pragma unroll
          for (int j = 0; j < 4; ++j) h8r[64 * j] = pk4_fp8(v[j][0] * X8_SCALE, v[j][1] * X8_SCALE, v[j][2] * X8_SCALE, v[j][3] * X8_SCALE); }
    }
    float* tabR = (float*)(F.ws + WS_TABR); float* tabM = (float*)(F.ws + WS_TABM);
    const int gt = F.bid * NTHREADS + F.tid, NGT = F.G * NTHREADS;
    for (int i = gt; i < TT * 48; i += NGT) {
        const int pos = i / 48, f = i % 48; const float inv = f < 32 ? a->invR[f] : a->invM[f - 32];
        const float angf = (float)pos * inv; const double ang = (double)angf;
        const double kq = rint(ang * 0.63661977236758134308); double r = fma(-kq, 1.57079632679489655800e+00, ang); r = fma(-kq, 6.12323399573676603587e-17, r);
        const double r2 = r * r;
        const double sn = r * (1.0 + r2 * (-1.0 / 6 + r2 * (1.0 / 120 + r2 * (-1.0 / 5040 + r2 * (1.0 / 362880 + r2 * (-1.0 / 39916800))))));
        const double cs = 1.0 + r2 * (-0.5 + r2 * (1.0 / 24 + r2 * (-1.0 / 720 + r2 * (1.0 / 40320 + r2 * (-1.0 / 3628800 + r2 * (1.0 / 479001600))))));
        const int q = ((int)kq) & 3; double c, s;
        if (q == 0) { c = cs; s = sn; } else if (q == 1) { c = -sn; s = cs; } else if (q == 2) { c = -cs; s = -sn; } else { c = sn; s = -cs; }
        if (f < 32) { tabR[(size_t)pos * 64 + f] = (float)c; tabR[(size_t)pos * 64 + 32 + f] = (float)s; }
        else { tabM[(size_t)pos * 32 + f - 32] = (float)c; tabM[(size_t)pos * 32 + 16 + f - 32] = (float)s; }
    }
}

DI void ln1_row_norm(bf16_t* hb, unsigned char* x8, int m, int lane, const f32x4 (&gv)[4], const f32x4 (&bv)[4], f32x4 (&v)[4], bool& valid) {
    valid = false;
#pragma unroll
    for (int j = 0; j < 4; ++j) v[j] = (f32x4){0.f, 0.f, 0.f, 0.f};
    if (m >= M) return;
    const int tp = m % TP;
    unsigned* x8r = (unsigned*)(x8 + (size_t)m * D) + lane;
    if (tp < PADF) { row_store_bf16(hb + (size_t)m * D, lane, v);
#pragma unroll
        for (int j = 0; j < 4; ++j) x8r[64 * j] = 0u;
        return; }
    valid = true;
    row_load_bf16(hb + (size_t)m * D, lane, v);
    float mean, rstd; ln_stats(v, mean, rstd);
#pragma unroll
    for (int j = 0; j < 4; ++j) v[j] = (v[j] - mean) * rstd * gv[j] + bv[j];
    row_store_bf16(hb + (size_t)m * D, lane, v);
#pragma unroll
    for (int j = 0; j < 4; ++j) x8r[64 * j] = pk4_fp8(v[j][0] * X8_SCALE, v[j][1] * X8_SCALE, v[j][2] * X8_SCALE, v[j][3] * X8_SCALE);
}
DI float butterfly32(float (&p)[NE], int lane) {
#pragma unroll
    for (int i = 0; i < 16; ++i) { const bool up = (lane & 32) != 0; const float send = up ? p[i] : p[i + 16], keep = up ? p[i + 16] : p[i]; p[i] = keep + xor32_f(send, lane); }
#pragma unroll
    for (int i = 0; i < 8; ++i) { const bool up = (lane & 16) != 0; const float send = up ? p[i] : p[i + 8], keep = up ? p[i + 8] : p[i]; p[i] = keep + xor16_f(send, lane); }
#pragma unroll
    for (int i = 0; i < 4; ++i) { const bool up = (lane & 8) != 0; const float send = up ? p[i] : p[i + 4], keep = up ? p[i + 4] : p[i]; p[i] = keep + xor8_f(send); }
#pragma unroll
    for (int i = 0; i < 2; ++i) { const bool up = (lane & 4) != 0; const float send = up ? p[i] : p[i + 2], keep = up ? p[i + 2] : p[i]; p[i] = keep + xor4_f(send); }
    { const bool up = (lane & 2) != 0; const float send = up ? p[0] : p[1], keep = up ? p[1] : p[0]; p[0] = keep + xor2_f(send); }
    return p[0] + xor1_f(p[0]);
}
DI void ln1_route(float logit, int m, int lane, int* topi, float* topw, LAS unsigned* rt) {
    float cand = (lane & 1) ? -3.0e38f : logit; float tv[4]; int ti[4];
#pragma unroll
    for (int r = 0; r < 4; ++r) {
        const float mx = wave_max(cand);
        const int idx = __ffsll((long long)__ballot(cand == mx)) - 1;
        tv[r] = mx; ti[r] = idx >> 1; if (lane == idx) cand = -3.0e38f;
    }
    const float e1 = fast_exp(tv[1] - tv[0]), e2 = fast_exp(tv[2] - tv[0]), e3 = fast_exp(tv[3] - tv[0]); const float inv = 1.0f / (1.0f + e1 + e2 + e3);
    if (lane < 4) {
        const int my_e = lane == 0 ? ti[0] : lane == 1 ? ti[1] : lane == 2 ? ti[2] : ti[3];
        const float my_w = (lane == 0 ? 1.0f : lane == 1 ? e1 : lane == 2 ? e2 : e3) * inv;
        topi[(size_t)m * 4 + lane] = my_e; topw[(size_t)m * 4 + lane] = my_w;
        const unsigned lp = __hip_atomic_fetch_add(rt + my_e, 1u, __ATOMIC_RELAXED, __HIP_MEMORY_SCOPE_WORKGROUP);
        const unsigned slot = __hip_atomic_fetch_add(rt + 64, 1u, __ATOMIC_RELAXED, __HIP_MEMORY_SCOPE_WORKGROUP);
        rt[128 + 2 * slot] = (unsigned)(m * 4 + lane); rt[128 + 2 * slot + 1] = ((unsigned)my_e << 16) | lp;
    }
}
DI void phase_ln1(const Frame& F, kargs_t a, int l) {
    const int gw = F.bid * NWAVES + F.wave, NGW = F.G * NWAVES, lane = F.lane;
    bf16_t* hb = (bf16_t*)(F.ws + WS_HB);
    int* topi = (int*)(F.ws + WS_TOPI); float* topw = (float*)(F.ws + WS_TOPW); int* list = (int*)(F.ws + WS_LIST); unsigned char* x8 = F.ws + WS_X8;
    gu32* ecnt = F.ctl + CW_ECNT + 2048 * l;
    LAS unsigned* rt = (LAS unsigned*)(F.lds + TAB_OFF + 1024);
    if (F.tid < 128) rt[F.tid] = 0u;
    constexpr int WRP = D + 4;
    LAS float* wrt = (LAS float*)F.lds;
    const float* wr = a->in[I_WR] + (size_t)l * D * NE;
    for (int i = F.tid; i < D * NE; i += NTHREADS) { const int k = i >> 5, e = i & 31; wrt[e * WRP + k] = wr[i]; }
    __syncthreads();
    const float* g = a->in[I_LN1G] + l * D; const float* bb = a->in[I_LN1B] + l * D;
    f32x4 gv[4], bv[4];
#pragma unroll
    for (int j = 0; j < 4; ++j) { gv[j] = *((const f32x4*)g + lane + 64 * j); bv[j] = *((const f32x4*)bb + lane + 64 * j); }
    const float brl = a->in[I_BR][l * NE + ((lane >> 1) & 31)];
    for (int m0 = gw; m0 < M; m0 += 2 * NGW) {
        const int m1 = m0 + NGW;
        f32x4 x0[4], x1[4]; bool val0, val1;
        ln1_row_norm(hb, x8, m0, lane, gv, bv, x0, val0);
        ln1_row_norm(hb, x8, m1, lane, gv, bv, x1, val1);
        if (!val0 && !val1) continue;
        float p0[NE], p1[NE];
#pragma unroll
        for (int e = 0; e < NE; ++e) { float s0 = 0.f, s1 = 0.f;
#pragma unroll
            for (int j = 0; j < 4; ++j) { const f32x4 w = *((const LAS f32x4*)(wrt + e * WRP) + lane + 64 * j);
                s0 += (x0[j][0] * w[0] + x0[j][1] * w[1]) + (x0[j][2] * w[2] + x0[j][3] * w[3]); s1 += (x1[j][0] * w[0] + x1[j][1] * w[1]) + (x1[j][2] * w[2] + x1[j][3] * w[3]); }
            p0[e] = s0; p1[e] = s1; }
        const float l0 = butterfly32(p0, lane) + brl, l1 = butterfly32(p1, lane) + brl;
        if (val0) ln1_route(l0, m0, lane, topi, topw, rt);
        if (val1) ln1_route(l1, m1, lane, topi, topw, rt);
    }
    __syncthreads();
    if (F.tid < NE) { const unsigned c = rt[F.tid]; rt[32 + F.tid] = c ? __hip_atomic_fetch_add(ecnt + 64 * F.tid, c, RLX_AGENT) : 0u; }
    __syncthreads();
    const unsigned nent = rt[64];
    for (unsigned i = F.tid; i < nent; i += NTHREADS) { const unsigned val = rt[128 + 2 * i], w = rt[128 + 2 * i + 1], e = w >> 16, lp = w & 0xffffu;
        list[(size_t)e * M + rt[32 + e] + lp] = (int)val; }
    __syncthreads();
}

DI void phase_ln2(const Frame& F, kargs_t a, int l) {
    const int gw = F.bid * NWAVES + F.wave, NGW = F.G * NWAVES, lane = F.lane;
    bf16_t* hb = (bf16_t*)(F.ws + WS_HB); const unsigned char* ys8 = F.ws + WS_YSLOT; const float* topw = (const float*)(F.ws + WS_TOPW);
    const float* g = a->in[I_LN2G] + l * D; const float* bb = a->in[I_LN2B] + l * D;
    f32x4 gv[4], bv[4];
#pragma unroll
    for (int j = 0; j < 4; ++j) { gv[j] = *((const f32x4*)g + lane + 64 * j); bv[j] = *((const f32x4*)bb + lane + 64 * j); }
    for (int m = gw; m < M; m += NGW) {
        const int b = m / TP, tp = m % TP; f32x4 v[4];
        if (tp < PADF) {
#pragma unroll
            for (int j = 0; j < 4; ++j) v[j] = (f32x4){0.f, 0.f, 0.f, 0.f};
            row_store_bf16(hb + (size_t)m * D, lane, v);
            { unsigned* h8r = (unsigned*)(F.ws + WS_H8 + (size_t)m * D) + lane;
#pragma unroll
              for (int j = 0; j < 4; ++j) h8r[64 * j] = 0u; }
            continue;
        }
        row_load_bf16(hb + (size_t)m * D, lane, v);
        const f32x4 w = *(const f32x4*)(topw + (size_t)m * 4);
#pragma unroll
        for (int j = 0; j < 4; ++j) v[j] = v[j] * DN_ALPHA;
#pragma unroll
        for (int k = 0; k < 4; ++k) { const unsigned* y8 = (const unsigned*)(ys8 + ((size_t)m * 4 + k) * D) + lane; const float wk = w[k] * (1.0f / YS_SCALE);
#pragma unroll
            for (int j = 0; j < 4; ++j) { const unsigned q = y8[64 * j]; const f32x2 lo = __builtin_amdgcn_cvt_pk_f32_fp8((int)q, false), hi2 = __builtin_amdgcn_cvt_pk_f32_fp8((int)q, true);
                v[j] += (f32x4){lo[0], lo[1], hi2[0], hi2[1]} * wk; } }
        float mean, rstd; ln_stats(v, mean, rstd);
#pragma unroll
        for (int j = 0; j < 4; ++j) v[j] = (v[j] - mean) * rstd * gv[j] + bv[j];
        if (l == DEPTH - 1) {
            if (tp >= PADF + NMETA) { float* orow = a->out + ((size_t)b * SEQ + (tp - PADF - NMETA)) * D;
#pragma unroll
                for (int j = 0; j < 4; ++j) *((f32x4*)orow + lane + 64 * j) = v[j]; }
        } else { row_store_bf16(hb + (size_t)m * D, lane, v);
            unsigned* h8r = (unsigned*)(F.ws + WS_H8 + (size_t)m * D) + lane;
#pragma unroll
            for (int j = 0; j < 4; ++j) h8r[64 * j] = pk4_fp8(v[j][0] * X8_SCALE, v[j][1] * X8_SCALE, v[j][2] * X8_SCALE, v[j][3] * X8_SCALE); }
    }
}

DI pg8::MoeTabs moe_tables(const Frame& F, int l) {
    LAS int* ebase = (LAS int*)(F.lds + TAB_OFF); LAS int* ecnt = ebase + 64; LAS unsigned char* tile_e = (LAS unsigned char*)(ebase + 128);
    __syncthreads();
    if (F.tid < NE) ecnt[F.tid] = (int)__hip_atomic_load(F.ctl + CW_ECNT + 2048 * l + 64 * F.tid, RLX_AGENT);
    __syncthreads();
    if (F.tid == 0) { int t = 0;
#pragma nounroll
        for (int e = 0; e < NE; ++e) { ebase[e] = t; t += (ecnt[e] + 255) >> 8; }
        ebase[32] = t; }
    __syncthreads();
    for (int t = F.tid; t < ebase[32]; t += NTHREADS) { int e = 0;
#pragma nounroll
        for (int k = 1; k < NE; ++k) e += (ebase[k] <= t) ? 1 : 0;
        tile_e[t] = (unsigned char)e; }
    __syncthreads();
    pg8::MoeTabs T; T.ebase = ebase; T.ecnt = ecnt; T.tile_e = tile_e; T.list = (const int*)(F.ws + WS_LIST); T.ntiles = ebase[32];
    return T;
}

constexpr int LA_QP = 144, LA_VP = 272;
constexpr int LA_HEAD = 64 * LA_QP * 2 + 64 * LA_VP;
constexpr int LA_BT = 2 * LA_HEAD, LA_TOT = LA_BT + 32768, LA_GA = LA_TOT + 2048, LA_ST = LA_GA + 4096, LA_WL = LA_ST + 2048;
#ifndef LA_SEC
#define LA_SEC 0
#endif
template <bool PHASE_C>
DI void linattn_phase(const Frame& F, kargs_t a, int l) {
    const int tid = F.tid, lane = F.lane, wave = F.wave, r32 = lane & 31, hi = lane >> 5;
    const bf16_t* proj = (const bf16_t*)(F.ws + WS_R1);
    LAS unsigned char* L = F.lds;
    LAS float* bT = (LAS float*)(L + LA_BT); LAS float* tot = (LAS float*)(L + LA_TOT); LAS float* gas = (LAS float*)(L + LA_GA); LAS float* stx = (LAS float*)(L + LA_ST);
    const int NU = NB * NCH * 2, USTEP = F.G >> 1;
    int hp_loaded = -1; float lg0 = 0.f, lg1 = 0.f; LAS float* wl = (LAS float*)(L + LA_WL);
    u32x4 pk[2], pq[2], pv[4]; u32x2 pga2 = (u32x2){0, 0};
#pragma unroll
    for (int i = 0; i < 2; ++i) { pk[i] = (u32x4){0, 0, 0, 0}; pq[i] = (u32x4){0, 0, 0, 0}; }
#pragma unroll
    for (int i = 0; i < 4; ++i) pv[i] = (u32x4){0, 0, 0, 0};
#define LA_LOADS(u_) do { const int hp_ = (F.bid & 1) + 2 * ((u_) / (NB * NCH)), bc_ = (u_) % (NB * NCH), c_ = bc_ % NCH, b_ = bc_ / NCH; const bool gl_ = hp_ >= 2; const int m0_ = b_ * TP + 64 * c_; \
        const int qc_ = (gl_ ? C_GQ : C_RQ) + 128 * (hp_ & 1), kc_ = (gl_ ? C_GK : C_RK) + 128 * (hp_ & 1), vc_ = (gl_ ? C_GV : C_RV) + 256 * (hp_ & 1); \
        _Pragma("unroll") for (int i = 0; i < 2; ++i) { const int task = tid + 512 * i, tok = task >> 4, cg = task & 15; pk[i] = *(const u32x4*)(proj + (size_t)(m0_ + tok) * NPROJ + kc_ + 8 * cg); \
            if (PHASE_C) pq[i] = *(const u32x4*)(proj + (size_t)(m0_ + tok) * NPROJ + qc_ + 8 * cg); } \
        _Pragma("unroll") for (int i = 0; i < 4; ++i) { const int ch = tid + 512 * i, tok = ch >> 5, cc = ch & 31; pv[i] = *(const u32x4*)(proj + (size_t)(m0_ + tok) * NPROJ + vc_ + 8 * cc); } \
        if (gl_ && tid < 256) pga2 = *(const u32x2*)(proj + (size_t)(m0_ + (tid >> 2)) * NPROJ + C_GA + 4 * (tid & 3)); } while (0)
    bf16x8 svn[4][2]; u32x2 gwn[2][4];
#define LA_S_LOADS(u_) do { if (PHASE_C) { const int hp_ = (F.bid & 1) + 2 * ((u_) / (NB * NCH)), bc_ = (u_) % (NB * NCH), c_ = bc_ % NCH, b_ = bc_ / NCH; \
        const int hlw_ = wave >> 2, eh_ = wave & 1; \
        const bf16_t* ST_ = (const bf16_t*)(F.ws + WS_ST) + ((size_t)(b_ * 8 + 2 * hp_ + hlw_) * NCH + c_) * 128 * 64; \
        _Pragma("unroll") for (int s = 0; s < 4; ++s) _Pragma("unroll") for (int mm = 0; mm < 2; ++mm) svn[s][mm] = *(const bf16x8*)(ST_ + (size_t)(32 * (2 * eh_ + mm) + r32) * 64 + 16 * s + 8 * hi); } } while (0)
#define LA_G_LOADS(u_) do { if (PHASE_C) { const int hp_ = (F.bid & 1) + 2 * ((u_) / (NB * NCH)), bc_ = (u_) % (NB * NCH), c_ = bc_ % NCH, b_ = bc_ / NCH; const int m0_ = b_ * TP + 64 * c_; \
        const int hlw_ = wave >> 2, nt_ = (wave >> 1) & 1, eh_ = wave & 1, iq_ = 32 * nt_ + r32; \
        const bf16_t* grow_ = proj + (size_t)(m0_ + iq_) * NPROJ + ((hp_ >= 2 ? C_GG : C_RG) + 256 * (hp_ & 1)) + 128 * hlw_; \
        _Pragma("unroll") for (int mm = 0; mm < 2; ++mm) _Pragma("unroll") for (int r4 = 0; r4 < 4; ++r4) gwn[mm][r4] = *(const u32x2*)(grow_ + 32 * (2 * eh_ + mm) + 8 * r4 + 4 * hi); } } while (0)
    int u = F.bid >> 1;
    if (u < NU) { LA_LOADS(u); LA_S_LOADS(u); LA_G_LOADS(u); }
    for (; u < NU; u += USTEP) {
        const int hp = (F.bid & 1) + 2 * (u / (NB * NCH)), bc = u % (NB * NCH), c = bc % NCH, b = bc / NCH;
        const bool isgla = hp >= 2; const int m0 = b * TP + 64 * c;
        const int gc0 = (isgla ? C_GG : C_RG) + 256 * (hp & 1);
        const int hlw = wave >> 2, h8 = 2 * hp + hlw;
        bf16_t* ST = (bf16_t*)(F.ws + WS_ST) + ((size_t)(b * 8 + h8) * NCH + c) * 128 * 64;
        const int nt = (wave >> 1) & 1, eh = wave & 1, iq = 32 * nt + r32;
        if (hp != hp_loaded) {
            hp_loaded = hp;
            if (isgla) { if (tid < 128) { const int gcol = 128 * (hp & 1) + tid;
#pragma unroll
                    for (int j = 0; j < 16; ++j) wl[j * 128 + tid] = a->in[I_WA2][((size_t)l * 16 + j) * 256 + gcol];
                    wl[16 * 128 + tid] = a->in[I_BA2][l * 256 + gcol]; } }
            else { lg0 = log1pf(-exp2f(-5.0f - (float)(2 * (hp & 1)))); lg1 = log1pf(-exp2f(-5.0f - (float)(2 * (hp & 1) + 1))); }
        }
        __syncthreads();
        for (int srep_ = 0; srep_ < ((LA_SEC & 1) && PHASE_C ? 2 : 1); ++srep_)
        if (isgla) {
            if (tid < 256) *(LAS f32x4*)(gas + (tid >> 2) * 16 + 4 * (tid & 3)) = (f32x4){bflo(pga2.x), bfhi(pga2.x), bflo(pga2.y), bfhi(pga2.y)};
            __syncthreads();
            const int col = tid & 127, qt = tid >> 7; float run = 0.f; float wa[16];
#pragma unroll
            for (int j = 0; j < 16; ++j) wa[j] = wl[j * 128 + col];
            const float ba = wl[16 * 128 + col];
#pragma unroll
            for (int t = 0; t < 16; ++t) { const int tok = 16 * qt + t; float x = ba;
#pragma unroll
                for (int j4 = 0; j4 < 4; ++j4) { const f32x4 gq = *(const LAS f32x4*)(gas + tok * 16 + 4 * j4); x += (gq[0] * wa[4 * j4] + gq[1] * wa[4 * j4 + 1]) + (gq[2] * wa[4 * j4 + 2] + gq[3] * wa[4 * j4 + 3]); }
                const float la = (fminf(x, 0.f) - __logf(1.0f + __expf(-fabsf(x)))) * (1.0f / 16.0f);
                run += la; bT[tok * 128 + col] = run; }
            tot[qt * 128 + col] = run;
            __syncthreads();
        }
        for (int srep_ = 0; srep_ < ((LA_SEC & 2) && PHASE_C ? 2 : 1); ++srep_)
#pragma unroll
        for (int i = 0; i < 2; ++i) {
            const int task = tid + 512 * i, tok = task >> 4, cg = task & 15, hl = cg >> 3, d0 = (8 * cg) & 63;
            float bv[8], bl[8];
            if (isgla) {
#pragma unroll
                for (int j = 0; j < 8; ++j) { const int cc = 8 * cg + j; const float t0 = tot[cc], t1 = tot[128 + cc], t2 = tot[256 + cc], t3 = tot[384 + cc]; const int qq = tok >> 4;
                    bv[j] = bT[tok * 128 + cc] + (qq > 0 ? t0 : 0.f) + (qq > 1 ? t1 : 0.f) + (qq > 2 ? t2 : 0.f); bl[j] = (t0 + t1) + (t2 + t3); }
            } else {
                const float lg = hl ? lg1 : lg0;
#pragma unroll
                for (int j = 0; j < 8; ++j) { bv[j] = (float)(tok + 1) * lg; bl[j] = 64.0f * lg; }
            }
            const u32x4 kw = pk[i];
            float kf[8] = {bflo(kw.x), bfhi(kw.x), bflo(kw.y), bfhi(kw.y), bflo(kw.z), bfhi(kw.z), bflo(kw.w), bfhi(kw.w)};
            LAS unsigned char* hb_ = L + hl * LA_HEAD;
            if (PHASE_C) {
                const u32x4 qw = pq[i];
                float qf_[8] = {bflo(qw.x), bfhi(qw.x), bflo(qw.y), bfhi(qw.y), bflo(qw.z), bfhi(qw.z), bflo(qw.w), bfhi(qw.w)};
                u32x4 qo, ko;
#pragma unroll
                for (int j = 0; j < 4; ++j) { const float e0 = fast_exp(bv[2 * j]), e1 = fast_exp(bv[2 * j + 1]);
                    qo[j] = pk2(qf_[2 * j] * e0, qf_[2 * j + 1] * e1); ko[j] = pk2(kf[2 * j] * __builtin_amdgcn_rcpf(e0), kf[2 * j + 1] * __builtin_amdgcn_rcpf(e1)); }
                *(LAS u32x4*)(hb_ + tok * LA_QP + d0 * 2) = qo; *(LAS u32x4*)(hb_ + 64 * LA_QP + tok * LA_QP + d0 * 2) = ko;
            } else {
                u32x4 ko;
#pragma unroll
                for (int j = 0; j < 4; ++j) ko[j] = pk2(kf[2 * j] * fast_exp(bl[2 * j] - bv[2 * j]), kf[2 * j + 1] * fast_exp(bl[2 * j + 1] - bv[2 * j + 1]));
                *(LAS u32x4*)(hb_ + 64 * LA_QP + tok * LA_QP + d0 * 2) = ko;
                if (tok == 63) { float* dec = (float*)(F.ws + WS_DEC) + ((size_t)(b * 8 + 2 * hp + hl) * NCH + c) * 64 + d0;
#pragma unroll
                    for (int j = 0; j < 8; ++j) dec[j] = fast_exp(bl[j]); }
            }
        }
#pragma unroll
        for (int i = 0; i < 4; ++i) { const int ch = tid + 512 * i, tok = ch >> 5, cc = ch & 31, hl = cc >> 4, e0 = (8 * cc) & 127;
            *(LAS u32x4*)(L + hl * LA_HEAD + 128 * LA_QP + tok * LA_VP + e0 * 2) = pv[i]; }
        { const int un = u + USTEP; if (un < NU) LA_LOADS(un); }
        __syncthreads();
        const LAS unsigned char* Qs = L + hlw * LA_HEAD; const LAS unsigned char* Ks = Qs + 64 * LA_QP; const LAS unsigned char* Vs = Qs + 128 * LA_QP;
        if (!PHASE_C) {
            const int mt = wave & 3; f32x16 acc[2]; acc[0] = f32x16{}; acc[1] = f32x16{};
#pragma unroll
            for (int s = 0; s < 4; ++s) { const bf16x8 av = frag_tr(Vs, LA_VP, 16 * s, 32 * mt, lane);
#pragma unroll
                for (int n2 = 0; n2 < 2; ++n2) acc[n2] = MFMA32(av, frag_tr(Ks, LA_QP, 16 * s, 32 * n2, lane), acc[n2]); }
            { LAS bf16_t* TT = (LAS bf16_t*)(L + LA_BT) + hlw * 8192;
#pragma unroll
              for (int n2 = 0; n2 < 2; ++n2)
#pragma unroll
                  for (int r = 0; r < 16; ++r) TT[(32 * mt + crow(r, hi)) * 64 + 32 * n2 + r32] = (bf16_t)f2bf(acc[n2][r]); }
            __syncthreads();
            { bf16_t* ST0 = (bf16_t*)(F.ws + WS_ST) + ((size_t)(b * 8 + 2 * hp) * NCH + c) * 128 * 64;
#pragma unroll
              for (int i = 0; i < 4; ++i) { const int ch = tid + 512 * i, hl2 = ch >> 10, off = (ch & 1023) * 8;
                  *(u32x4*)(ST0 + (size_t)hl2 * NCH * 8192 + off) = *(const LAS u32x4*)(L + LA_BT + hl2 * 16384 + off * 2); } }
        } else {
            bf16x8 qf[4]; f32x16 o[2]; f32x16 sT[2];
            for (int srep_ = 0; srep_ < ((LA_SEC & 4) ? 2 : 1); ++srep_) {
#pragma unroll
            for (int s = 0; s < 4; ++s) qf[s] = frag_row(Qs + iq * LA_QP + (16 * s + 8 * hi) * 2);
            sT[0] = f32x16{}; sT[1] = f32x16{};
#pragma unroll
            for (int jt = 0; jt < 2; ++jt) {
                if (jt <= nt) {
#pragma unroll
                    for (int s = 0; s < 4; ++s) sT[jt] = MFMA32(frag_row(Ks + (32 * jt + r32) * LA_QP + (16 * s + 8 * hi) * 2), qf[s], sT[jt]);
#pragma unroll
                    for (int r = 0; r < 16; ++r) if (32 * jt + crow(r, hi) > iq) sT[jt][r] = 0.f;
                }
            }
            o[0] = f32x16{}; o[1] = f32x16{};
#pragma unroll
            for (int jt = 0; jt < 2; ++jt)
#pragma unroll
                for (int s2 = 0; s2 < 2; ++s2) { const bf16x8 pf = pack_step(sT[jt], s2);
#pragma unroll
                    for (int mm = 0; mm < 2; ++mm) o[mm] = MFMA32(frag_tr_perm(Vs, LA_VP, 32 * jt + 16 * s2, 32 * (2 * eh + mm), lane), pf, o[mm]); }
#pragma unroll
            for (int s = 0; s < 4; ++s)
#pragma unroll
                for (int mm = 0; mm < 2; ++mm) o[mm] = MFMA32(svn[s][mm], qf[s], o[mm]);
            }
            { const int un = u + USTEP; if (un < NU) LA_S_LOADS(un); }
            float s1 = 0.f, s2 = 0.f;
#pragma unroll
            for (int mm = 0; mm < 2; ++mm)
#pragma unroll
                for (int r = 0; r < 16; ++r) { s1 += o[mm][r]; s2 += o[mm][r] * o[mm][r]; }
            s1 = sum_x32(s1); s2 = sum_x32(s2);
            LAS float* sx = stx + ((hlw * 2 + nt) * 2) * 64;
            if (hi == 0) { sx[eh * 64 + r32 * 2] = s1; sx[eh * 64 + r32 * 2 + 1] = s2; }
            __syncthreads();
            const float t1 = sx[r32 * 2] + sx[64 + r32 * 2], t2 = sx[r32 * 2 + 1] + sx[64 + r32 * 2 + 1];
            float mean = 0.f, rstd;
            if (isgla) rstd = 1.0f / sqrtf(t2 * (1.0f / 128.0f) + 1e-6f);
            else { mean = t1 * (1.0f / 128.0f); rstd = 1.0f / sqrtf(fmaxf(t2 * (1.0f / 128.0f) - mean * mean, 0.f) + 1e-5f); }
            unsigned char* yrow = F.ws + WS_YS + (size_t)(m0 + iq) * 2048 + (isgla ? 1536 : 0) + 256 * (hp & 1) + 128 * hlw;
            for (int srep_ = 0; srep_ < ((LA_SEC & 8) ? 2 : 1); ++srep_)
#pragma unroll
            for (int mm = 0; mm < 2; ++mm)
#pragma unroll
                for (int r4 = 0; r4 < 4; ++r4) { const int e = 32 * (2 * eh + mm) + 8 * r4 + 4 * hi;
                    const u32x2 gw_ = gwn[mm][r4]; const float gf[4] = {bflo(gw_.x), bfhi(gw_.x), bflo(gw_.y), bfhi(gw_.y)}; float y[4];
#pragma unroll
                    for (int j = 0; j < 4; ++j) { const float gsw = gf[j] * fast_sigmoid(gf[j]); y[j] = (o[mm][4 * r4 + j] - mean) * rstd * gsw; }
                    *(unsigned*)(yrow + e) = pk4_fp8(y[0] * YB_SCALE, y[1] * YB_SCALE, y[2] * YB_SCALE, y[3] * YB_SCALE); }
            { const int un = u + USTEP; if (un < NU) LA_G_LOADS(un); }
        }
    }
#undef LA_LOADS
#undef LA_S_LOADS
#undef LA_G_LOADS
    __syncthreads();
}

DI void linattn_scan_unit(const Frame& F, int unit) {
    const int eg = unit & 3, bh = unit >> 2; const int e = 32 * eg + (F.tid >> 4), d = 4 * (F.tid & 15);
    bf16_t* ST = (bf16_t*)(F.ws + WS_ST) + (size_t)bh * NCH * 128 * 64 + (size_t)e * 64 + d; const float* dec = (const float*)(F.ws + WS_DEC) + (size_t)bh * NCH * 64 + d;
    float s[4] = {0.f, 0.f, 0.f, 0.f};
    constexpr int SD = 12; static_assert(NCH % SD == 0, "scan depth");
    for (int c0 = 0; c0 < NCH; c0 += SD) {
        u32x2 kv[SD]; f32x4 dc[SD];
#pragma unroll
        for (int i = 0; i < SD; ++i) { kv[i] = *(const u32x2*)(ST + (size_t)(c0 + i) * 8192); dc[i] = *(const f32x4*)(dec + (size_t)(c0 + i) * 64); }
#pragma unroll
        for (int i = 0; i < SD; ++i) {
            *(u32x2*)(ST + (size_t)(c0 + i) * 8192) = (u32x2){pk2(s[0], s[1]), pk2(s[2], s[3])};
            s[0] = dc[i][0] * s[0] + bflo(kv[i].x); s[1] = dc[i][1] * s[1] + bfhi(kv[i].x); s[2] = dc[i][2] * s[2] + bflo(kv[i].y); s[3] = dc[i][3] * s[3] + bfhi(kv[i].y); }
    }
}

DI float gelu_tanh(float x) { const float z = 0.7978845608028654f * (x + 0.044715f * x * x * x); const float t = 1.0f - 2.0f * __builtin_amdgcn_rcpf(__builtin_amdgcn_exp2f(2.0f * LOG2E * z) + 1.0f); return 0.5f * x * (1.0f + t); }
constexpr int LRU_XP = 144;
constexpr int LRU_G = 64 * LRU_XP, LRU_EX = LRU_G + 32768, LRU_IN = LRU_EX + 4096, LRU_INB = 67 * 128 + 64 * 128, LRU_Y = LRU_IN + 2 * LRU_INB;
template <bool PHASE_C>
DI void lru_phase(const Frame& F, kargs_t a, int l) {
    const int tid = F.tid, lane = F.lane, wave = F.wave, r32 = lane & 31, hi = lane >> 5;
    const bf16_t* proj = (const bf16_t*)(F.ws + WS_R1);
    LAS unsigned char* Xs = F.lds; LAS float* G = (LAS float*)(F.lds + LRU_G); LAS float* ex = (LAS float*)(F.lds + LRU_EX);
    const int d = tid & 63, g = tid >> 6;
    const int NU = NB * NCH * 8;
    int n_loaded = -1;
    bf16x8 bw[4] = {}; float gbias = 0.f, w0 = 0.f, w1 = 0.f, w2 = 0.f, w3 = 0.f, cb = 0.f, sp = 0.f;
    const int mt = wave >> 2, ntile = wave & 3, type = ntile >> 1, dcol = 32 * (ntile & 1) + r32;
    const int crow_ = tid >> 3, ccol = tid & 7;
    u32x4 px0 = (u32x4){0, 0, 0, 0}, px1 = (u32x4){0, 0, 0, 0}, pg = (u32x4){0, 0, 0, 0}; float hpre = 0.f;
#define LRU_LOADS(u_) do { const int n_ = (u_) & 7, bc_ = (u_) >> 3, c_ = bc_ % NCH, b_ = bc_ / NCH; const int m0_ = b_ * TP + 64 * c_; \
        { const int t_ = crow_ - 3; px0 = (64 * c_ + t_ >= 0) ? *(const u32x4*)(proj + (size_t)(m0_ + t_) * NPROJ + C_LX + 64 * n_ + 8 * ccol) : (u32x4){0, 0, 0, 0}; } \
        if (tid < 24) px1 = *(const u32x4*)(proj + (size_t)(m0_ + 61 + crow_) * NPROJ + C_LX + 64 * n_ + 8 * ccol); \
        if (PHASE_C) { pg = *(const u32x4*)(proj + (size_t)(m0_ + crow_) * NPROJ + C_LG + 64 * n_ + 8 * ccol); \
            hpre = ((const float*)(F.ws + WS_LRUH))[((size_t)b_ * NCH + c_) * 512 + 64 * n_ + d]; } } while (0)
#define LRU_PUT(buf_) do { LAS unsigned char* T_ = F.lds + LRU_IN + (buf_) * LRU_INB; *(LAS u32x4*)(T_ + crow_ * 128 + ccol * 16) = px0; if (tid < 24) *(LAS u32x4*)(T_ + (64 + crow_) * 128 + ccol * 16) = px1; \
        if (PHASE_C) *(LAS u32x4*)(T_ + 67 * 128 + crow_ * 128 + ccol * 16) = pg; } while (0)
    int u = F.bid, buf = 0;
    __syncthreads();
    if (u < NU) { LRU_LOADS(u); LRU_PUT(0); }
    float hin = hpre;
    __syncthreads();
    for (; u < NU; u += F.G) {
        const int n = u & 7, bc = u >> 3, c = bc % NCH, b = bc / NCH; const int m0 = b * TP + 64 * c, ch0 = 64 * n, ch = ch0 + d;
        const int un = u + F.G;
        if (un < NU) LRU_LOADS(un);
        if (n != n_loaded) {
            n_loaded = n;
            const float* cw = a->in[I_CONVW] + (size_t)l * 4 * 512 + ch; w0 = cw[0]; w1 = cw[512]; w2 = cw[1024]; w3 = cw[1536]; cb = a->in[I_CONVB][l * 512 + ch];
            const float lam = a->in[I_LAM][l * 512 + ch]; sp = fmaxf(-lam, 0.f) + __logf(1.0f + __expf(-fabsf(lam)));
            const float* W = (type ? a->in[I_WLX] : a->in[I_WLA]) + ((size_t)(l * 8 + n) * 64) * 64 + dcol; gbias = (type ? a->in[I_BLX] : a->in[I_BLA])[l * 512 + ch0 + dcol];
#pragma unroll
            for (int s = 0; s < 4; ++s) { u32x4 p;
#pragma unroll
                for (int j = 0; j < 4; ++j) p[j] = pk2(W[(size_t)(16 * s + 8 * hi + 2 * j) * 64], W[(size_t)(16 * s + 8 * hi + 2 * j + 1) * 64]);
                bw[s] = __builtin_bit_cast(bf16x8, p); }
        }
        const LAS bf16_t* XT = (const LAS bf16_t*)(F.lds + LRU_IN + buf * LRU_INB); const LAS bf16_t* GT = XT + 67 * 64;
        float xv[8], gb[8];
        { float x[11];
#pragma unroll
          for (int i = 0; i < 11; ++i) x[i] = bf2f(XT[(8 * g + i) * 64 + d]);
#pragma unroll
          for (int i = 0; i < 8; ++i) { xv[i] = cb + (w0 * x[i] + w1 * x[i + 1]) + (w2 * x[i + 2] + w3 * x[i + 3]);
              *(LAS bf16_t*)(Xs + (8 * g + i) * LRU_XP + d * 2) = (bf16_t)f2bf(xv[i]); }
          if (PHASE_C) {
#pragma unroll
              for (int i = 0; i < 8; ++i) gb[i] = bf2f(GT[(8 * g + i) * 64 + d]); }
        }
        __syncthreads();
        { f32x16 acc = f32x16{};
#pragma unroll
          for (int s = 0; s < 4; ++s) acc = MFMA32(frag_row(Xs + (32 * mt + r32) * LRU_XP + (16 * s + 8 * hi) * 2), bw[s], acc);
#pragma unroll
          for (int r = 0; r < 16; ++r) G[(type * 64 + 32 * mt + crow(r, hi)) * 64 + dcol] = fast_sigmoid(acc[r] + gbias); }
        __syncthreads();
        float av[8], uv[8]; float Aloc = 1.f, hloc = 0.f;
#pragma unroll
        for (int i = 0; i < 8; ++i) { const int t = 8 * g + i; const float r = G[t * 64 + d], ig = G[(64 + t) * 64 + d];
            const float la = -8.0f * r * sp; float av_ = fast_exp(la); float uv_ = sqrtf(fmaxf(1.0f - av_ * av_, 0.f)) * ig * xv[i];
            if (64 * c + t < PADF) { av_ = 1.f; uv_ = 0.f; }
            av[i] = av_; uv[i] = uv_; Aloc *= av_; hloc = av_ * hloc + uv_; }
        ex[(g * 64 + d) * 2] = Aloc; ex[(g * 64 + d) * 2 + 1] = hloc;
        if (un < NU) LRU_PUT(buf ^ 1);
        __syncthreads();
        float h = PHASE_C ? hin : 0.f; float Ap = 1.f;
#pragma unroll
        for (int gg = 0; gg < 8; ++gg) if (gg < g) { const float A_ = ex[(gg * 64 + d) * 2], H_ = ex[(gg * 64 + d) * 2 + 1]; h = A_ * h + H_; Ap *= A_; }
        if (!PHASE_C) { if (g == 7) { ((float*)(F.ws + WS_LRUA))[((size_t)b * NCH + c) * 512 + ch] = Ap * Aloc; ((float*)(F.ws + WS_LRUH))[((size_t)b * NCH + c) * 512 + ch] = Aloc * h + hloc; } }
        else {
            LAS unsigned char* YT = F.lds + LRU_Y;
#pragma unroll
            for (int i = 0; i < 8; ++i) { const int t = 8 * g + i; h = av[i] * h + uv[i]; YT[t * 64 + d] = (unsigned char)(pk4_fp8(h * gelu_tanh(gb[i]) * YB_SCALE, 0.f, 0.f, 0.f) & 0xffu); }
            __syncthreads();
            *(u32x2*)(F.ws + WS_YS + (size_t)(m0 + crow_) * 2048 + 1024 + ch0 + 8 * ccol) = *(const LAS u32x2*)(F.lds + LRU_Y + crow_ * 64 + ccol * 8);
        }
        hin = hpre; buf ^= 1;
    }
#undef LRU_LOADS
#undef LRU_PUT
    __syncthreads();
}
DI void lru_scan_unit(const Frame& F, int b) {
    float* LA = (float*)(F.ws + WS_LRUA) + (size_t)b * NCH * 512 + F.tid; float* LH = (float*)(F.ws + WS_LRUH) + (size_t)b * NCH * 512 + F.tid;
    float h = 0.f;
    constexpr int SD = 12;
    for (int c0 = 0; c0 < NCH; c0 += SD) { float A_[SD], H_[SD];
#pragma unroll
        for (int i = 0; i < SD; ++i) { A_[i] = LA[(size_t)(c0 + i) * 512]; H_[i] = LH[(size_t)(c0 + i) * 512]; }
#pragma unroll
        for (int i = 0; i < SD; ++i) { LH[(size_t)(c0 + i) * 512] = h; h = A_[i] * h + H_[i]; } }
}

constexpr int AT_KP = 208, AT_VP = 144;
constexpr int AT_KB = 64 * AT_KP, AT_VB = 64 * AT_VP, AT_VOFF = 2 * AT_KB;
DI void attn_unit(const Frame& F, int b, int hd, int qb) {
    const int tid = F.tid, lane = F.lane, wave = F.wave, r32 = lane & 31, hi = lane >> 5;
    const bf16_t* proj = (const bf16_t*)(F.ws + WS_R1); const bf16_t* qg = (const bf16_t*)(F.ws + WS_Q); const bf16_t* kvg = (const bf16_t*)(F.ws + WS_KV);
    LAS unsigned char* L = F.lds;
    const int tq = 256 * qb + 32 * wave + r32; const size_t mq = (size_t)b * TP + tq;
    bf16x8 qf[6];
#pragma unroll
    for (int s = 0; s < 6; ++s) qf[s] = *(const bf16x8*)(qg + mq * 768 + hd * 96 + 16 * s + 8 * hi);
    const bf16_t* src[3]; int dst[3];
#pragma unroll
    for (int i = 0; i < 3; ++i) { const int id = tid + 512 * i;
        if (id < 768) { const int key = id / 12, cc = id % 12; src[i] = cc < 8 ? kvg + (size_t)key * 1024 + hd * 64 + 8 * cc : proj + (size_t)key * NPROJ + C_KR + 8 * (cc - 8); dst[i] = key * AT_KP + cc * 16; }
        else { const int v = id - 768, key = v >> 3, cc = v & 7; src[i] = kvg + (size_t)key * 1024 + 512 + hd * 64 + 8 * cc; dst[i] = AT_VOFF + key * AT_VP + cc * 16; } }
    const bool third = tid < 256;
    const bool rope0 = (tid < 768) && ((tid % 12) >= 8), rope1 = (tid + 512 < 768) && (((tid + 512) % 12) >= 8);
#define AT_GL(i, kt, isrope) (*(const u32x4*)(src[i] + ((size_t)b * TP + 64 * (kt)) * ((isrope) ? (size_t)NPROJ : (size_t)1024)))
    const int kt0 = 3, kt1 = 4 * qb + 3;
    __syncthreads();
    u32x4 st0 = AT_GL(0, kt0, rope0), st1 = AT_GL(1, kt0, rope1), st2 = third ? AT_GL(2, kt0, false) : (u32x4){0, 0, 0, 0};
    *(LAS u32x4*)(L + dst[0]) = st0; *(LAS u32x4*)(L + dst[1]) = st1; if (third) *(LAS u32x4*)(L + dst[2]) = st2;
    __syncthreads();
    f32x16 o[2]; o[0] = f32x16{}; o[1] = f32x16{};
    constexpr float ATT_THR = 8.0f;
    float mref = 0.f, lrun = 0.f; f32x16 negm = f32x16{};
    for (int kt = kt0; kt <= kt1; ++kt) {
        const int cur = (kt - kt0) & 1; const bool more = kt < kt1;
        if (more) { st0 = AT_GL(0, kt + 1, rope0); st1 = AT_GL(1, kt + 1, rope1); if (third) st2 = AT_GL(2, kt + 1, false); }
        const LAS unsigned char* Kb = L + cur * AT_KB; const LAS unsigned char* Vb = L + AT_VOFF + cur * AT_VB;
        f32x16 p[2];
#pragma unroll
        for (int sub = 0; sub < 2; ++sub) { p[sub] = MFMA32(frag_row(Kb + (32 * sub + r32) * AT_KP + (8 * hi) * 2), qf[0], negm);
#pragma unroll
            for (int s = 1; s < 6; ++s) p[sub] = MFMA32(frag_row(Kb + (32 * sub + r32) * AT_KP + (16 * s + 8 * hi) * 2), qf[s], p[sub]); }
        if (kt == kt0 || kt >= 4 * qb) {
#pragma unroll
            for (int sub = 0; sub < 2; ++sub)
#pragma unroll
                for (int r = 0; r < 16; ++r) { const int key = 64 * kt + 32 * sub + crow(r, hi); if (key > tq || key < PADF) p[sub][r] = -1.0e30f; }
        }
        float mx = fmaxf(p[0][0], p[1][0]);
#pragma unroll
        for (int r = 1; r < 16; ++r) mx = fmaxf(fmaxf(mx, p[0][r]), p[1][r]);
        mx = max_x32(mx);
        if (kt == kt0 || __any(mx > ATT_THR)) {
            const float delta = (kt == kt0) ? mx : fmaxf(mx, 0.f);
            const float fac = (kt == kt0) ? 0.f : __builtin_amdgcn_exp2f(-delta);
            mref += delta; lrun *= fac;
#pragma unroll
            for (int dv = 0; dv < 2; ++dv) o[dv] = o[dv] * fac;
#pragma unroll
            for (int sub = 0; sub < 2; ++sub)
#pragma unroll
                for (int r = 0; r < 16; ++r) p[sub][r] -= delta;
#pragma unroll
            for (int r = 0; r < 16; ++r) negm[r] = -mref;
        }
        float ps = 0.f;
#pragma unroll
        for (int sub = 0; sub < 2; ++sub)
#pragma unroll
            for (int r = 0; r < 16; ++r) { p[sub][r] = __builtin_amdgcn_exp2f(p[sub][r]); ps += p[sub][r]; }
        lrun += ps;
#pragma unroll
        for (int sub = 0; sub < 2; ++sub)
#pragma unroll
            for (int s2 = 0; s2 < 2; ++s2) { const bf16x8 pf = pack_step(p[sub], s2);
#pragma unroll
                for (int dv = 0; dv < 2; ++dv) o[dv] = MFMA32(frag_tr_perm(Vb, AT_VP, 32 * sub + 16 * s2, 32 * dv, lane), pf, o[dv]); }
        if (more) { const int nb = cur ^ 1;
            const int d0 = dst[0] + (dst[0] >= AT_VOFF ? nb * AT_VB : nb * AT_KB), d1 = dst[1] + (dst[1] >= AT_VOFF ? nb * AT_VB : nb * AT_KB), d2 = dst[2] + (dst[2] >= AT_VOFF ? nb * AT_VB : nb * AT_KB);
            *(LAS u32x4*)(L + d0) = st0; *(LAS u32x4*)(L + d1) = st1; if (third) *(LAS u32x4*)(L + d2) = st2; }
        __syncthreads();
    }
    lrun = sum_x32(lrun);
    const float inv = 1.0f / lrun;
    unsigned char* yrow = F.ws + WS_YS + mq * 2048 + 512 + hd * 64;
#pragma unroll
    for (int dv = 0; dv < 2; ++dv)
#pragma unroll
        for (int r4 = 0; r4 < 4; ++r4) { const int e = 32 * dv + 8 * r4 + 4 * hi;
            const float iv = inv * YB_SCALE; *(unsigned*)(yrow + e) = pk4_fp8(o[dv][4 * r4] * iv, o[dv][4 * r4 + 1] * iv, o[dv][4 * r4 + 2] * iv, o[dv][4 * r4 + 3] * iv); }
}
#ifdef CONV_TWICE
#define CONV_AGAIN(l_) { asm volatile("" ::: "memory"); phase_convert(F, get_args(), l_); }
#else
#define CONV_AGAIN(l_)
#endif
#ifndef MK_PER_PHASE
#define MK_PER_PHASE 0
#endif
constexpr int NPH_L = 12, NPHASES = 1 + DEPTH * NPH_L;
constexpr int ATT_UNITS = (TP / 256) * NB * 8;

DI int lane_id_volatile() { int r; asm volatile("v_mbcnt_lo_u32_b32 %0, -1, 0\n\tv_mbcnt_hi_u32_b32 %0, -1, %0" : "=v"(r)); return r; }
__global__ void __launch_bounds__(NTHREADS, 2) trunk_fwd(KArgs args) {
    extern __shared__ __attribute__((aligned(16))) unsigned char lds_raw[];
    Frame F;
    F.lds = (LAS unsigned char*)lds_raw; F.ws = nullptr; F.ctl = nullptr;
    const int wave0 = __builtin_amdgcn_readfirstlane((int)threadIdx.x >> 6);
#define MYTID() (wave0 * 64 + lane_id_volatile())
    F.tid = MYTID(); F.lane = F.tid & 63; F.wave = wave0; F.G = gridDim.x; F.bid = blockIdx.x;
    volatile LAS unsigned* MISC = (volatile LAS unsigned*)(F.lds + MISC_OFF);
    if (F.tid < 64) MISC[F.tid] = 0u;
    __syncthreads();
    XcdBarrier bar; bar.bar = (unsigned*)(args.ws + WS_CTL) + CW_BAR; bar.x = 0; bar.st = nullptr;
    const int lo = args.ph_lo, hi = args.ph_hi;
    if (hi - lo > 1) bar = xcd_barrier_post((unsigned*)(args.ws + WS_CTL) + CW_BAR, MISC + 8, F.tid);
#ifndef PH_MASK
#define PH_MASK 0xFFFFFFFFu
#endif
#define EN(kk) (((PH_MASK) >> (kk)) & 1u)
#define IN(k) (lo <= (k) && (k) < hi)
#define SEAM(k) do { if (IN(k) && IN((k) + 1)) xcd_barrier(bar, MYTID()); } while (0)
#define PHASE_BEGIN kargs_t A = get_args(); unsigned char* ws = A->ws; F.ws = ws; F.ctl = (gu32*)(ws + WS_CTL); \
    { int t_ = MYTID(); asm volatile("" : "+v"(t_)); F.tid = t_; F.lane = t_ & 63; F.wave = __builtin_amdgcn_readfirstlane(t_ >> 6); int b_ = blockIdx.x, g_ = gridDim.x; asm volatile("" : "+s"(b_), "+s"(g_)); F.bid = b_; F.G = g_; } \
    bf16_t* hb = (bf16_t*)(ws + WS_HB); bf16_t* proj = (bf16_t*)(ws + WS_R1); \
    const float* tabR = (const float*)(ws + WS_TABR); const float* tabM = (const float*)(ws + WS_TABM); float* ssq = (float*)(ws + WS_SSQ); \
    (void)hb; (void)proj; (void)tabR; (void)tabM; (void)ssq;

    if (EN(12) && IN(0)) { PHASE_BEGIN phase_convert(F, A, 0); CONV_AGAIN(0) phase_ln0(F, A); }
    SEAM(0);
#define PH0(l, P, QSEL) \
        if (EN(0) && IN(P + 0)) { }
#define PH1(l, P, QSEL) \
        if (EN(1) && IN(P + 1)) { PHASE_BEGIN \
            pg8::Gemm g{hb, (const bf16_t*)(ws + W_IN), D, D, D, 0, 0}; pg8::StaticOrder S; S.init(M, NPROJ, F.G, F.bid); \
            pg8::EpiProj E{proj, tabR, tabM, ssq}; \
            pg8::gemm_phase<pg8::EpiProj, pg8::StaticOrder, true>(F.lds, F.tid, g, S, E); \
        }
#define PH2(l, P, QSEL) \
        if (EN(2) && IN(P + 2)) { PHASE_BEGIN \
            if (EN(13)) { pg8::Gemm g{proj + C_CQ, (const bf16_t*)(ws + W_UQ), NPROJ, 256, 256, 0, 0}; pg8::StaticOrder S; S.init(M, 768, F.G, F.bid); \
              pg8::EpiQ E{(bf16_t*)(ws + WS_Q), tabM, ssq}; \
              pg8::gemm_phase<pg8::EpiQ, pg8::StaticOrder, true>(F.lds, F.tid, g, S, E); } \
            if (EN(14)) { pg8::Gemm g{proj + C_CKV, (const bf16_t*)(ws + W_UKV), NPROJ, 128, 128, 0, 0}; pg8::StaticOrder S; S.init(M, 1024, F.G, (F.bid + 140) % F.G); \
              pg8::EpiKV E{(bf16_t*)(ws + WS_KV), ssq}; \
              pg8::gemm_phase<pg8::EpiKV, pg8::StaticOrder, true>(F.lds, F.tid, g, S, E); } \
            { Frame F2 = F; F2.bid = (F.bid + 156) % F.G; if (EN(15)) linattn_phase<false>(F2, A, l); if constexpr (REP(15)) linattn_phase<false>(F2, A, l); } \
            { Frame F2 = F; F2.bid = (F.bid + 220) % F.G; if (EN(16)) lru_phase<false>(F2, A, l); if constexpr (REP(16)) lru_phase<false>(F2, A, l); } \
        }
#define PH3(l, P, QSEL) \
        if (EN(3) && IN(P + 3)) { PHASE_BEGIN \
            if (QSEL == 0) for (int u = F.bid; u < 128 + NB; u += F.G) { if (u < 128) linattn_scan_unit(F, u); else lru_scan_unit(F, u - 128); } \
            for (;;) { \
                __syncthreads(); \
                if (F.tid == 0) MISC[0] = __hip_atomic_fetch_add(F.ctl + CW_QUEUE + 64 * (l + 2 * QSEL), 1u, RLX_AGENT); \
                __syncthreads(); \
                const int u = (int)MISC[0]; \
                if (u >= ATT_UNITS) break; \
                const int qb = (TP / 256 - 1) - u / 32, bh = u % 32; \
                attn_unit(F, bh >> 3, bh & 7, qb); \
            } \
        }
#define PH4(l, P, QSEL) \
        if (EN(4) && IN(P + 4)) { PHASE_BEGIN \
            linattn_phase<true>(F, A, l); if constexpr (REP(17)) linattn_phase<true>(F, A, l); \
            { Frame F2 = F; F2.bid = (F.bid + 128) % F.G; lru_phase<true>(F2, A, l); if constexpr (REP(18)) lru_phase<true>(F2, A, l); } \
        }
#define PH5(l, P, QSEL) \
        if (EN(5) && IN(P + 5)) { PHASE_BEGIN \
            pg8::Gemm g{ws + WS_H8, ws + W_MG, D, D, D, 0, 0}; pg8::TokenOrder S; S.init(M, 4096, F.G, F.bid); \
            pg8::EpiGate E{(unsigned char*)proj, A->in[I_BMERGE] + (size_t)l * 4096}; \
            meta_gates(F, (unsigned char*)proj, A->in[I_BMERGE] + (size_t)l * 4096); \
            pg8::gemm_phase<pg8::EpiGate, pg8::TokenOrder, true, true>(F.lds, F.tid, g, S, E); \
        }
#define PH6(l, P, QSEL) \
        if (EN(6) && IN(P + 6)) { PHASE_BEGIN \
            pg8::Gemm g{ws + WS_YS, ws + W_BR, 2048, 512, 512, 512, (long)D * 512}; pg8::BatchedOrder<4, pg8::TokenOrder> S; S.init(M, D, F.G, F.bid); \
            pg8::EpiBranch E{(bf16_t*)(ws + WS_MIX), (const unsigned char*)proj}; \
            meta_branch(F, (const unsigned char*)proj); \
            pg8::gemm_phase<pg8::EpiBranch, pg8::BatchedOrder<4, pg8::TokenOrder>, true, true>(F.lds, F.tid, g, S, E); \
        }
#define PH7(l, P, QSEL) \
        if (EN(7) && IN(P + 7)) { PHASE_BEGIN \
            pg8::Gemm g{(const bf16_t*)(ws + WS_MIX), (const bf16_t*)(ws + W_OUT), D, D, D, 0, 0}; pg8::TokenOrder S; S.init(M, D, F.G, F.bid); \
            pg8::EpiOut E{hb}; \
            meta_out(F, hb); \
            pg8::gemm_phase<pg8::EpiOut, pg8::TokenOrder, true>(F.lds, F.tid, g, S, E); \
        }
#define PH8(l, P, QSEL) \
        if (EN(8) && IN(P + 8)) { PHASE_BEGIN phase_ln1(F, A, l); }
#define PH9(l, P, QSEL) \
        if (EN(9) && IN(P + 9)) { PHASE_BEGIN \
            const pg8::MoeTabs T = moe_tables(F, l); \
            pg8::Gemm g{ws + WS_X8, ws + W_GU, D, D, D, 0, (long)2048 * D}; pg8::MoeOrder<8, true> S{T, F.G, F.bid}; \
            pg8::EpiSwiglu E{ws + WS_R1, A->in[I_BEG] + (size_t)l * NE * DE, A->in[I_BEU] + (size_t)l * NE * DE}; \
            pg8::gemm_phase<pg8::EpiSwiglu, pg8::MoeOrder<8, true>, true, true>(F.lds, F.tid, g, S, E); \
        }
#define PH10(l, P, QSEL) \
        if (EN(10) && IN(P + 10)) { PHASE_BEGIN \
            const pg8::MoeTabs T = moe_tables(F, l); \
            pg8::Gemm g{ws + WS_R1, ws + W_DN, DE, DE, DE, 0, (long)D * DE, 1}; pg8::MoeOrder<4, false> S{T, F.G, F.bid}; \
            pg8::EpiDown E{ws + WS_YSLOT, A->in[I_BED] + (size_t)l * NE * D, T}; \
            pg8::gemm_phase<pg8::EpiDown, pg8::MoeOrder<4, false>, true, true>(F.lds, F.tid, g, S, E); \
        }
#define PH11(l, P, QSEL) \
        if (EN(11) && IN(P + 11)) { PHASE_BEGIN if (l + 1 < DEPTH) { phase_convert(F, A, l + 1); CONV_AGAIN(l + 1) } phase_ln2(F, A, l); }
#ifndef REP_MASK
#define REP_MASK 0u
#endif
#define REP(k) (((REP_MASK) >> (k)) & 1u)
#define LAYER_BODY(l) { constexpr int P = 1 + (l) * NPH_L; \
    PH0(l, P, 0) if constexpr (REP(0)) { PH0(l, P, 1) } \
    PH1(l, P, 0) if constexpr (REP(1)) { PH1(l, P, 1) } \
    SEAM(P + 1); \
    PH2(l, P, 0) if constexpr (REP(2)) { PH2(l, P, 1) } \
    SEAM(P + 2); \
    PH3(l, P, 0) if constexpr (REP(3)) { PH3(l, P, 1) } \
    SEAM(P + 3); \
    PH4(l, P, 0) if constexpr (REP(4)) { PH4(l, P, 1) } \
    SEAM(P + 4); \
    PH5(l, P, 0) if constexpr (REP(5)) { PH5(l, P, 1) } \
    SEAM(P + 5); \
    PH6(l, P, 0) if constexpr (REP(6)) { PH6(l, P, 1) } \
    SEAM(P + 6); \
    PH7(l, P, 0) if constexpr (REP(7)) { PH7(l, P, 1) } \
    SEAM(P + 7); \
    PH8(l, P, 0) if constexpr (REP(8)) { PH8(l, P, 1) } \
    SEAM(P + 8); \
    PH9(l, P, 0) if constexpr (REP(9)) { PH9(l, P, 1) } \
    SEAM(P + 9); \
    PH10(l, P, 0) if constexpr (REP(10)) { PH10(l, P, 1) } \
    SEAM(P + 10); \
    PH11(l, P, 0) if constexpr (REP(11)) { PH11(l, P, 1) } \
    SEAM(P + 11); \
}
    { constexpr int l = 0; LAYER_BODY(l) }
    { constexpr int l = 1; LAYER_BODY(l) }
#undef LAYER_BODY
#undef IN
#undef SEAM
}

extern "C" void kernel_launch(void* const* d_in, const int* in_sizes, int n_in, void* d_out, int out_size, void* d_ws, size_t ws_size, hipStream_t stream) {
    static int grid = 0;
    if (grid == 0) {
        if (n_in != 34 || ws_size < WS_END) { fprintf(stderr, "kernel_launch: expected 34 inputs and >= %zu bytes of workspace; got %d, %zu\n", (size_t)WS_END, n_in, ws_size); grid = -1; return; }
        int dev = 0, cus = 0;
        if (hipGetDevice(&dev) != hipSuccess || hipDeviceGetAttribute(&cus, hipDeviceAttributeMultiprocessorCount, dev) != hipSuccess) { grid = -1; return; }
        if (hipFuncSetAttribute((const void*)trunk_fwd, hipFuncAttributeMaxDynamicSharedMemorySize, LDS_BYTES) != hipSuccess) { fprintf(stderr, "kernel_launch: hipFuncSetAttribute failed\n"); grid = -1; return; }
        int per_cu = 0;
        if (hipOccupancyMaxActiveBlocksPerMultiprocessor(&per_cu, (const void*)trunk_fwd, NTHREADS, LDS_BYTES) != hipSuccess || per_cu < 1) fprintf(stderr, "kernel_launch: occupancy query reports %d\n", per_cu);
        (void)hipGetLastError();
        grid = cus >= 256 ? 256 : (cus & ~7);
        if (grid < 8) { fprintf(stderr, "kernel_launch: %d CUs: too few\n", cus); grid = -1; return; }
    }
    if (grid < 0) return;
    (void)hipMemsetAsync((char*)d_ws + WS_CTL, 0, CTL_ZERO_BYTES, stream);
    KArgs a{};
    for (int i = 0; i < 34; ++i) a.in[i] = (const float*)d_in[i];
    a.out = (float*)d_out; a.ws = (unsigned char*)d_ws;
    for (int i = 0; i < 32; ++i) a.invR[i] = (float)pow(10000.0, -(double)(2 * i) / 64.0);
    for (int i = 0; i < 16; ++i) a.invM[i] = (float)pow(10000.0, -(double)(2 * i) / 32.0);
#if MK_PER_PHASE
    for (int p = 0; p < NPHASES; ++p) { a.ph_lo = p; a.ph_hi = p + 1; hipLaunchKernelGGL(trunk_fwd, dim3(grid), dim3(NTHREADS), LDS_BYTES, stream, a); }
#else
    a.ph_lo = 0; a.ph_hi = NPHASES;
    hipLaunchKernelGGL(trunk_fwd, dim3(grid), dim3(NTHREADS), LDS_BYTES, stream, a);
#endif
}
```

```cpp
#include <hip/hip_runtime.h>
#include <cstdio>
#include <cstdint>
#include <cmath>

#define LAS __attribute__((address_space(3)))
#define GAS __attribute__((address_space(1)))
typedef unsigned short bf16_t;
typedef short bf16x8 __attribute__((ext_vector_type(8)));
typedef short s16x4 __attribute__((ext_vector_type(4)));
typedef short v4i16_t __attribute__((ext_vector_type(4)));
typedef float f32x2 __attribute__((ext_vector_type(2)));
typedef float f32x4 __attribute__((ext_vector_type(4)));
typedef float f32x16 __attribute__((ext_vector_type(16)));
typedef unsigned u32x2 __attribute__((ext_vector_type(2)));
typedef unsigned u32x4 __attribute__((ext_vector_type(4)));
typedef __bf16 bf16x2_t __attribute__((ext_vector_type(2)));
typedef GAS unsigned gu32;
typedef int i32x8 __attribute__((ext_vector_type(8)));
#define DI __device__ __forceinline__
#define RLX_AGENT __ATOMIC_RELAXED, __HIP_MEMORY_SCOPE_AGENT

constexpr int NB = 4, SEQ = 8192, NMETA = 16, TT = SEQ + NMETA;
constexpr int PADF = 240, TP = PADF + TT;
constexpr int M = NB * TP;
constexpr int D = 1024, DEPTH = 2;
__device__ __forceinline__ size_t gate_addr(size_t r, int c) { return ((r >> 2) << 14) + ((size_t)(c >> 7) << 9) + (size_t)(((c >> 5) & 3) << 7) + ((r & 3) << 5) + (size_t)(c & 31); }
constexpr int NPROJ = 4608;
constexpr int C_RQ = 0, C_RK = 256, C_RV = 512, C_RG = 1024, C_CQ = 1536, C_CKV = 1792, C_KR = 1920, C_GA = 1952, C_LX = 2048, C_LG = 2560,
              C_GQ = 3072, C_GK = 3328, C_GV = 3584, C_GG = 4096;
constexpr int O_RQ = 0, O_RK = 256, O_RV = 512, O_RG = 1024, O_CQ = 1536, O_CKV = 1792, O_KR = 1920, O_LX = 1952, O_LG = 2464, O_GQ = 2976,
              O_GK = 3232, O_GV = 3488, O_GA = 4000, O_GG = 4016, D_IN = 4528;
constexpr int NE = 32, TOPK = 4, DE = 1024;
constexpr int NCH = TP / 64;
constexpr int MAXTILES = 545;
constexpr float DN_ALPHA = 1.4142135623730951f;
constexpr float LOG2E = 1.4426950408889634f;

constexpr size_t MiB = 1u << 20;
constexpr size_t WS_CTL = 0, CTL_ZERO_BYTES = 64 * 1024;
constexpr size_t WS_HB = 1 * MiB;
constexpr size_t WS_R1 = WS_HB + 66 * MiB;
constexpr size_t WS_R2 = WS_R1 + 297 * MiB;
constexpr size_t WS_YS = WS_R2;
constexpr size_t WS_Q = WS_YS + 132 * MiB;
constexpr size_t WS_KV = WS_Q + 50 * MiB;
constexpr size_t WS_MIX = WS_Q;
constexpr size_t WS_X8 = WS_R2;
constexpr size_t WS_YSLOT = WS_R2;
constexpr size_t WS_ST = WS_R2 + 264 * MiB;
constexpr size_t WS_W = WS_ST + 66 * MiB;
constexpr size_t W_IN = WS_W;
constexpr size_t W_MG = W_IN + 9 * MiB;
constexpr size_t W_BR = W_MG + 8 * MiB;
constexpr size_t W_OUT = W_BR + 4 * MiB;
constexpr size_t W_UQ = W_OUT + 2 * MiB;
constexpr size_t W_UKV = W_UQ + 512 * 1024;
constexpr size_t W_GU = W_UKV + 512 * 1024;
constexpr size_t W_DN = W_GU + 64 * MiB;
constexpr size_t WS_MISC = W_DN + 32 * MiB;
constexpr size_t WS_SSQ = WS_MISC;
constexpr size_t WS_TABR = WS_SSQ + 2 * MiB;
constexpr size_t WS_TABM = WS_TABR + 3 * MiB;
constexpr size_t WS_DEC = WS_TABM + 2 * MiB;
constexpr size_t WS_LRUA = WS_DEC + 2 * MiB;
constexpr size_t WS_LRUH = WS_LRUA + 2 * MiB;
constexpr size_t WS_TOPI = WS_LRUH + 2 * MiB;
constexpr size_t WS_TOPW = WS_TOPI + 1 * MiB;
constexpr size_t WS_LIST = WS_TOPW + 1 * MiB;
constexpr size_t WS_H8 = WS_LIST + 5 * MiB;
constexpr size_t WS_END = WS_H8 + 34 * MiB;
static_assert(WS_END <= 1024 * MiB, "workspace map exceeds 1 GiB");
static_assert((size_t)M * NPROJ * 2 <= 297 * MiB && (size_t)MAXTILES * 256 * 1024 * 2 <= 297 * MiB && (size_t)M * 4096 * 2 <= 297 * MiB, "R1");
static_assert((size_t)M * 4 * 1024 * 2 <= 264 * MiB && WS_KV + (size_t)M * 1024 * 2 <= WS_ST, "R2");
constexpr int CW_BAR = 4096;
constexpr int CW_QUEUE = 8192;
constexpr int CW_ECNT = 12288;

constexpr int RING_BYTES = 131072;
constexpr int TAB_OFF = RING_BYTES;
constexpr int MISC_OFF = RING_BYTES + 12288;
constexpr int LDS_BYTES = 147456;
constexpr int NWAVES = 8, NTHREADS = 512;

#define LDS_WAIT() asm volatile("s_waitcnt lgkmcnt(0)" ::: "memory")
#define VM_WAIT() asm volatile("s_waitcnt vmcnt(0)" ::: "memory")
DI unsigned f2bf(float f) { unsigned u = __builtin_bit_cast(unsigned, f); return (u + 0x7fffu + ((u >> 16) & 1u)) >> 16; }
DI unsigned pk2(float lo, float hi) { f32x2 v = {lo, hi}; bf16x2_t b = __builtin_convertvector(v, bf16x2_t); return __builtin_bit_cast(unsigned, b); }
DI float bf2f(unsigned short h) { return __builtin_bit_cast(float, (unsigned)h << 16); }
DI float bflo(unsigned w) { return __builtin_bit_cast(float, w << 16); }
DI float bfhi(unsigned w) { return __builtin_bit_cast(float, w & 0xffff0000u); }
DI unsigned pk4_fp8(float a, float b, float c, float d) {
    a = fminf(fmaxf(a, -448.f), 448.f); b = fminf(fmaxf(b, -448.f), 448.f); c = fminf(fmaxf(c, -448.f), 448.f); d = fminf(fmaxf(d, -448.f), 448.f);
    int w = __builtin_amdgcn_cvt_pk_fp8_f32(a, b, 0, false); w = __builtin_amdgcn_cvt_pk_fp8_f32(c, d, w, true); return (unsigned)w; }
constexpr float X8_SCALE = 16.f, WGU_SCALE = 256.f, ACT_SCALE = 4.f, WDN_SCALE = 512.f, YS_SCALE = 16.f, YB_SCALE = 16.f;
#define DPPF(v, ctrl) __builtin_bit_cast(float, __builtin_amdgcn_update_dpp(0, __builtin_bit_cast(int, (v)), (ctrl), 0xF, 0xF, true))
#define DPP_X1 0xB1
#define DPP_X2 0x4E
#define DPP_QREV 0x1B
#define DPP_HMIR 0x141
#define DPP_MIR 0x140
#define DPP_X8 0x128
DI float rdlane_f(float v, int l) { return __builtin_bit_cast(float, __builtin_amdgcn_readlane(__builtin_bit_cast(int, v), l)); }
DI float xor1_f(float v) { return DPPF(v, DPP_X1); }
DI float xor2_f(float v) { return DPPF(v, DPP_X2); }
DI float xor4_f(float v) { const float t = DPPF(v, DPP_HMIR); return DPPF(t, DPP_QREV); }
DI float xor8_f(float v) { return DPPF(v, DPP_X8); }
#define SWAP32(a_, b_) asm volatile("s_nop 1\n\tv_permlane32_swap_b32 %0, %1" : "+v"(a_), "+v"(b_))
#define SWAP16(a_, b_) asm volatile("s_nop 1\n\tv_permlane16_swap_b32 %0, %1" : "+v"(a_), "+v"(b_))
DI float xor16_f(float v, int lane) { float a_ = v, b_ = v; SWAP16(a_, b_); return (lane & 16) ? a_ : b_; }
DI float xor32_f(float v, int lane) { float a_ = v, b_ = v; SWAP32(a_, b_); return (lane & 32) ? a_ : b_; }
DI float sum_x32(float v) { float a_ = v, b_ = v; SWAP32(a_, b_); return a_ + b_; }
DI float max_x32(float v) { float a_ = v, b_ = v; SWAP32(a_, b_); return fmaxf(a_, b_); }
DI float sum_x16(float v) { float a_ = v, b_ = v; SWAP16(a_, b_); return a_ + b_; }
DI float wave_sum(float v) {
    v += DPPF(v, DPP_X1); v += DPPF(v, DPP_X2); v += DPPF(v, DPP_HMIR); v += DPPF(v, DPP_MIR);
    return (rdlane_f(v, 0) + rdlane_f(v, 16)) + (rdlane_f(v, 32) + rdlane_f(v, 48));
}
DI float wave_max(float v) {
    v = fmaxf(v, DPPF(v, DPP_X1)); v = fmaxf(v, DPPF(v, DPP_X2)); v = fmaxf(v, DPPF(v, DPP_HMIR)); v = fmaxf(v, DPPF(v, DPP_MIR));
    return fmaxf(fmaxf(rdlane_f(v, 0), rdlane_f(v, 16)), fmaxf(rdlane_f(v, 32), rdlane_f(v, 48)));
}
DI float fast_exp(float x) { return __builtin_amdgcn_exp2f(x * LOG2E); }
DI float fast_sigmoid(float x) { return __builtin_amdgcn_rcpf(1.0f + __builtin_amdgcn_exp2f(-x * LOG2E)); }
DI int crow(int r, int hi) { return (r & 3) + 8 * (r >> 2) + 4 * hi; }
#define MFMA32(a, b, c) __builtin_amdgcn_mfma_f32_32x32x16_bf16((a), (b), (c), 0, 0, 0)
DI s16x4 vtr(const LAS unsigned char* p) { return __builtin_bit_cast(s16x4, __builtin_amdgcn_ds_read_tr16_b64_v4i16((LAS v4i16_t*)p)); }
DI bf16x8 frag_row(const LAS unsigned char* p) { return *(const LAS bf16x8*)p; }
DI bf16x8 frag_tr(const LAS unsigned char* base, int pitch, int k0, int f0, int lane) {
    const int hi = lane >> 5, blk = (lane >> 4) & 1, q = (lane & 15) >> 2, p = lane & 3;
    const LAS unsigned char* a = base + (k0 + 8 * hi + q) * pitch + (f0 + 16 * blk + 4 * p) * 2;
    const s16x4 lo = vtr(a), h4 = vtr(a + 4 * pitch);
    return __builtin_shufflevector(lo, h4, 0, 1, 2, 3, 4, 5, 6, 7);
}
DI bf16x8 frag_tr_perm(const LAS unsigned char* base, int pitch, int k0, int f0, int lane) {
    const int hi = lane >> 5, blk = (lane >> 4) & 1, q = (lane & 15) >> 2, p = lane & 3;
    const LAS unsigned char* a = base + (k0 + 4 * hi + q) * pitch + (f0 + 16 * blk + 4 * p) * 2;
    const s16x4 lo = vtr(a), h4 = vtr(a + 8 * pitch);
    return __builtin_shufflevector(lo, h4, 0, 1, 2, 3, 4, 5, 6, 7);
}
DI bf16x8 pack_step(const f32x16& x, int s) {
    u32x4 p;
    p[0] = pk2(x[8 * s + 0], x[8 * s + 1]); p[1] = pk2(x[8 * s + 2], x[8 * s + 3]); p[2] = pk2(x[8 * s + 4], x[8 * s + 5]); p[3] = pk2(x[8 * s + 6], x[8 * s + 7]);
    return __builtin_bit_cast(bf16x8, p);
}

#define XB_TMO      128
#define XB_XCNT(j)  (256  + 64 * (j))
#define XB_XSUB(j)  (1280 + 64 * (j))
#define XB_XGEN(j)  (2304 + 64 * (j))
#define XB_TOP      3328
#define XB_TOPGEN   3392
#define XCD_BAR_WORDS 3456
#define XB_SPIN_CAP (1u << 22)
DI unsigned xb_ld(unsigned* p)              { return __hip_atomic_load(p, __ATOMIC_RELAXED, __HIP_MEMORY_SCOPE_AGENT); }
DI unsigned xb_add(unsigned* p, unsigned v) { return __hip_atomic_fetch_add(p, v, __ATOMIC_RELAXED, __HIP_MEMORY_SCOPE_AGENT); }
DI unsigned xb_xcc_id() { return (unsigned)__builtin_amdgcn_s_getreg((3 << 11) | 20) & 0xFu; }
#define XB_SPIN(cond, bar) do { unsigned _sp = 0; while (cond) { __builtin_amdgcn_s_sleep(1); \
    if ((++_sp & 255u) == 0u) { if (xb_ld(&(bar)[XB_TMO])) break; if (_sp > XB_SPIN_CAP) { atomicAdd(&(bar)[XB_TMO], 1u); break; } } } } while (0)
struct XcdBarrier { unsigned* bar; unsigned x; volatile LAS unsigned* st; };
DI XcdBarrier xcd_barrier_post(unsigned* bar, volatile LAS unsigned* st, int tid) {
    XcdBarrier b; b.bar = bar; b.x = xb_xcc_id(); b.st = st;
    if (tid == 0) (void)xb_add(&bar[XB_XCNT(b.x)], 1u);
    return b;
}
DI void xcd_barrier_complete(unsigned* bar, unsigned x, unsigned& nloc, unsigned& nx) {
    const unsigned G = gridDim.x * gridDim.y * gridDim.z;
    unsigned sum, cnt, mine, sp = 0u;
    for (;;) {
        sum = 0u; cnt = 0u; mine = 0u;
#pragma unroll
        for (unsigned j = 0; j < 16; ++j) { const unsigned c = xb_ld(&bar[XB_XCNT(j)]); sum += c; cnt += (c > 0u) ? 1u : 0u; }
        if (sum == G) { mine = xb_ld(&bar[XB_XCNT(x)]); break; }
        __builtin_amdgcn_s_sleep(1);
        if ((++sp & 255u) == 0u) { if (xb_ld(&bar[XB_TMO])) break; if (sp > XB_SPIN_CAP) { atomicAdd(&bar[XB_TMO], 1u); break; } }
    }
    nloc = mine > 0u ? mine : 1u; nx = cnt > 0u ? cnt : 1u;
}
DI void xcd_barrier(const XcdBarrier& b, int tid) {
    asm volatile("s_waitcnt vmcnt(0)" ::: "memory");
    __syncthreads();
    if (tid == 0) {
        unsigned* bar = b.bar; unsigned bx = b.x;
        asm volatile("" : "+s"(bar), "+s"(bx));
        __builtin_amdgcn_s_waitcnt(0);
        unsigned nloc = b.st[0], nx = b.st[1];
        if (nloc == 0u) { xcd_barrier_complete(bar, bx, nloc, nx); b.st[0] = nloc; b.st[1] = nx; }
        const unsigned old = xb_add(&bar[XB_XSUB(bx)], 1u);
        const unsigned gen = old / nloc;
        if (old + 1u == (gen + 1u) * nloc) {
            __builtin_amdgcn_fence(__ATOMIC_RELEASE, "agent");
            asm volatile("s_waitcnt vmcnt(0)" ::: "memory");
            const unsigned og = xb_add(&bar[XB_TOP], 1u);
            const unsigned tg = og / nx;
            if (og + 1u == (tg + 1u) * nx) xb_add(&bar[XB_TOPGEN], 1u);
            else XB_SPIN(xb_ld(&bar[XB_TOPGEN]) == tg, bar);
            __builtin_amdgcn_fence(__ATOMIC_ACQUIRE, "agent");
            xb_add(&bar[XB_XGEN(bx)], 1u);
            asm volatile("s_waitcnt vmcnt(0)" ::: "memory");
        } else {
            XB_SPIN(xb_ld(&bar[XB_XGEN(bx)]) == gen, bar);
            __builtin_amdgcn_fence(__ATOMIC_ACQUIRE, "agent");
            asm volatile("s_waitcnt vmcnt(0)" ::: "memory");
        }
    }
    __syncthreads();
}

namespace pg8 {
constexpr int BM = 256, BK = 64, HALF = 128, HTB = HALF * BK * 2, STAGE_BYTES = 8 * HTB, NXCD = 8, WGM = 8;
__host__ __device__ __forceinline__ int lds_byte(int r, int c) { const int st = (r >> 4) * 2 + (c >> 5), rr = r & 15, cc = c & 31, ob = rr * 64 + cc * 2; return st * 1024 + (ob ^ (((ob >> 9) & 1) << 5)); }
__host__ __device__ __forceinline__ void stage_rc(int b, int& R, int& C) { const int st = b / 1024, sb = b % 1024, swz = sb ^ (((sb >> 9) & 1) << 5); R = (st >> 1) * 16 + swz / 64; C = (st & 1) * 32 + (swz % 64) / 2; }
__host__ __device__ __forceinline__ int perm32(int rho) { const int n = rho >> 4, i = rho & 15; return 8 * (i >> 2) + 4 * n + (i & 3); }

struct Unit { int pm, pn, pb; };
struct Gemm { const void* A; const void* Bt; int lda, ldb, K; long a_pb, b_pb; };

template <bool SKIPMETA> struct StaticOrderT {
    static constexpr bool GATHER = false, KEEP = false;
    int nM, nN, nwg, G, c;
    DI void init(int M_, int N_, int G_, int c_) { nM = SKIPMETA ? NB * (TP / BM - 1) : M_ / BM; nN = N_ / BM; nwg = nM * nN; G = G_; c = c_; }
    DI bool tile(int i, int& pm, int& pn) const {
        const long L = (long)i * G + c; if (L >= nwg) return false;
        int wgid = (int)L; { const int q = nwg / NXCD, r = nwg % NXCD, xcd = wgid % NXCD, off = wgid / NXCD; wgid = (xcd < r ? xcd * (q + 1) : r * (q + 1) + (xcd - r) * q) + off; }
        const int nig = WGM * nN, gid = wgid / nig, fm = gid * WGM, gsz = (nM - fm) < WGM ? (nM - fm) : WGM;
        pm = fm + ((wgid % nig) % gsz); pn = (wgid % nig) / gsz;
        if constexpr (SKIPMETA) pm += pm / (TP / BM - 1) + 1;
        return true;
    }
    DI bool next(int i, Unit& u) const { u.pb = 0; return tile(i, u.pm, u.pn); }
    DI int arow(const Unit& u, int r) const { return u.pm * BM + r; }
};
using StaticOrder = StaticOrderT<false>;
using TokenOrder = StaticOrderT<true>;
template <int NB_, class SO = StaticOrder> struct BatchedOrder {
    static constexpr bool GATHER = false, KEEP = true;
    SO so;
    DI void init(int M_, int N_, int G_, int c_) { so.init(M_, N_, G_, c_); }
    DI bool next(int i, Unit& u) const { u.pb = i % NB_; return so.tile(i / NB_, u.pm, u.pn); }
    DI int arow(const Unit& u, int r) const { return u.pm * BM + r; }
};

template <class Epi, class Sched, bool ALIGN_EPI, bool FP8 = false>
DI void gemm_phase(LAS unsigned char* lds, const int tid, const Gemm g, const Sched& S, const Epi& E) {
    constexpr bool GATHER = Sched::GATHER; constexpr int ESZ = FP8 ? 1 : 2, BKE = 128 / ESZ;
    const int wid = __builtin_amdgcn_readfirstlane(tid >> 6), lane = tid & 63, wr = wid >> 2, wc = wid & 3, fr = lane & 15, fq = lane >> 4;
    const int K = g.K, nt = K / BKE;
    unsigned voffA[2], voffB[2];
#pragma unroll
    for (int i = 0; i < 2; ++i) { int R, C; stage_rc(tid * 16 + i * 8192, R, C); const int Rb = (R & ~31) + perm32(R & 31);
        voffA[i] = (unsigned)(R * g.lda) * (unsigned)ESZ + (unsigned)C * 2u; voffB[i] = (unsigned)(Rb * g.ldb) * (unsigned)ESZ + (unsigned)C * 2u; }
    const size_t kstep = (size_t)(BK * 2);
    const size_t hstepA = GATHER ? 0 : (size_t)HALF * g.lda * ESZ, tstepA = 2 * hstepA;
    const size_t hstepB = (size_t)HALF * g.ldb * ESZ, tstepB = 2 * hstepB;
    const unsigned ldsw = (unsigned)wid * 1024u;
    const int aoff = lds_byte(wr * 64 + fr, fq * 8), boff = lds_byte(wc * 32 + fr, fq * 8);
#define PG8_SA(b, h) (((b) * 2 + (h)) * HTB)
#define PG8_SB(b, h) ((4 + (b) * 2 + (h)) * HTB)
#define PG8_STAGE(bufoff, gbase, v0, v1) do { \
        __builtin_amdgcn_global_load_lds((const unsigned*)((const char*)(gbase) + (v0)), (LAS unsigned*)(lds + (bufoff) + ldsw), 16, 0, 0); \
        __builtin_amdgcn_global_load_lds((const unsigned*)((const char*)(gbase) + (v1)), (LAS unsigned*)(lds + (bufoff) + ldsw + 8192), 16, 0, 0); } while (0)
#define PG8_CAT(x, y) __builtin_bit_cast(i32x8, __builtin_shufflevector(x, y, 0, 1, 2, 3, 4, 5, 6, 7, 8, 9, 10, 11, 12, 13, 14, 15))
#define PG8_LDA(dst, b, h) do { _Pragma("unroll") for (int m = 0; m < 4; ++m) { _Pragma("unroll") for (int k = 0; k < 2; ++k) dst[m][k] = *(const LAS bf16x8*)(lds + PG8_SA(b, h) + aoff + m * 2048 + k * 1024); \
        if constexpr (FP8) dst##8[m] = PG8_CAT(dst[m][0], dst[m][1]); } } while (0)
#define PG8_LDB(dst, b, h) do { _Pragma("unroll") for (int n = 0; n < 2; ++n) { _Pragma("unroll") for (int k = 0; k < 2; ++k) dst[n][k] = *(const LAS bf16x8*)(lds + PG8_SB(b, h) + boff + n * 2048 + k * 1024); \
        if constexpr (FP8) dst##8[n] = PG8_CAT(dst[n][0], dst[n][1]); } } while (0)
#define PG8_MMA(ai, bj, At, Bt) do { __builtin_amdgcn_s_setprio(1); _Pragma("unroll") for (int m = 0; m < 4; ++m) _Pragma("unroll") for (int n = 0; n < 2; ++n) { \
        if constexpr (FP8) asm volatile("v_mfma_f32_16x16x128_f8f6f4 %0, %1, %2, %0" : "+v"(acc[ai][bj][m][n]) : "v"(Bt##8[n]), "v"(At##8[m])); \
        else { _Pragma("unroll") for (int k = 0; k < 2; ++k) acc[ai][bj][m][n] = __builtin_amdgcn_mfma_f32_16x16x32_bf16(Bt[n][k], At[m][k], acc[ai][bj][m][n], 0, 0, 0); } } \
        __builtin_amdgcn_s_setprio(0); } while (0)
#define PG8_WAIT_V(n) asm volatile("s_waitcnt vmcnt(" #n ")" ::: "memory")
#define PG8_WAIT_L(n) asm volatile("s_waitcnt lgkmcnt(" #n ")" ::: "memory")
#define PG8_BAR __builtin_amdgcn_s_barrier()
#define PG8_SCHED __builtin_amdgcn_sched_barrier(0)
#define PG8_VOFFS(u, v) do { if constexpr (GATHER) { _Pragma("unroll") for (int h_ = 0; h_ < 2; ++h_) _Pragma("unroll") for (int i_ = 0; i_ < 2; ++i_) { int R_, C_; stage_rc(tid * 16 + i_ * 8192, R_, C_); \
        v[h_][i_] = (unsigned)S.arow(u, h_ * HALF + R_) * (unsigned)(g.lda * ESZ) + (unsigned)C_ * 2u; } } } while (0)
#define PG8_ABASE(u) ((const char*)g.A + ((size_t)(u).pb * g.a_pb) * ESZ + (GATHER ? (size_t)0 : (size_t)(u).pm * tstepA))
#define PG8_BBASE(u) ((const char*)g.Bt + ((size_t)(u).pb * g.b_pb) * ESZ + (size_t)(u).pn * tstepB)
    Unit cur, nxt; int ui = 0;
    if (!S.next(0, cur)) return;
    f32x4 acc[2][2][4][2];
#pragma unroll
    for (int a = 0; a < 2; ++a)
#pragma unroll
        for (int b = 0; b < 2; ++b)
#pragma unroll
            for (int m = 0; m < 4; ++m)
#pragma unroll
                for (int n = 0; n < 2; ++n) acc[a][b][m][n] = (f32x4){0.f, 0.f, 0.f, 0.f};
    bf16x8 At[4][2], B0[2][2], B1[2][2];
    i32x8 At8[4], B08[2], B18[2];
    (void)At8; (void)B08; (void)B18;
    unsigned vA[2][2] = {{voffA[0], voffA[1]}, {voffA[0], voffA[1]}};
    PG8_VOFFS(cur, vA);
    const char* cA = PG8_ABASE(cur); const char* cB = PG8_BBASE(cur);
    PG8_STAGE(PG8_SB(0, 0), cB, voffB[0], voffB[1]); PG8_STAGE(PG8_SB(0, 1), cB + hstepB, voffB[0], voffB[1]);
    PG8_STAGE(PG8_SA(0, 0), cA, vA[0][0], vA[0][1]); PG8_STAGE(PG8_SA(0, 1), cA + hstepA, vA[1][0], vA[1][1]);
    if (wr == 1) PG8_BAR;
    PG8_WAIT_V(2); PG8_BAR;
    PG8_STAGE(PG8_SB(1, 0), cB + kstep, voffB[0], voffB[1]); PG8_STAGE(PG8_SA(1, 0), cA + kstep, vA[0][0], vA[0][1]); PG8_STAGE(PG8_SB(1, 1), cB + hstepB + kstep, voffB[0], voffB[1]);
    PG8_WAIT_V(6); PG8_BAR;
    for (;;) {
        const bool has_next = S.next(ui + 1, nxt);
        const char* nA = cA; const char* nB = cB;
        if (has_next) { nA = PG8_ABASE(nxt); nB = PG8_BBASE(nxt); }
#pragma nounroll
        for (int t = 0; t < nt; t += 2) {
            const bool last = (t == nt - 2);
            const char* a1 = cA + (size_t)(t + 1) * kstep;
            const char* a2 = last ? nA : cA + (size_t)(t + 2) * kstep; const char* b2 = last ? nB : cB + (size_t)(t + 2) * kstep;
            const char* a3 = a2 + kstep; const char* b3 = b2 + kstep;
            const unsigned c10 = vA[1][0], c11 = vA[1][1];
            if (last && has_next) PG8_VOFFS(nxt, vA);
            const unsigned w00 = vA[0][0], w01 = vA[0][1], w10 = vA[1][0], w11 = vA[1][1];
            PG8_LDB(B0, 0, 0); PG8_LDB(B1, 0, 1); PG8_SCHED; PG8_LDA(At, 0, 0); PG8_STAGE(PG8_SA(1, 1), a1 + hstepA, c10, c11);
            PG8_WAIT_V(8); PG8_WAIT_L(0); PG8_BAR; PG8_MMA(0, 0, At, B0); PG8_MMA(0, 1, At, B1); PG8_BAR; PG8_SCHED;
            PG8_LDA(At, 0, 1); PG8_STAGE(PG8_SB(0, 0), b2, voffB[0], voffB[1]); PG8_STAGE(PG8_SB(0, 1), b2 + hstepB, voffB[0], voffB[1]); PG8_STAGE(PG8_SA(0, 0), a2, w00, w01);
            PG8_WAIT_V(8); PG8_WAIT_L(0); PG8_BAR; PG8_MMA(1, 0, At, B0); PG8_MMA(1, 1, At, B1); PG8_BAR; PG8_SCHED;
            PG8_LDB(B0, 1, 0); PG8_LDB(B1, 1, 1); PG8_SCHED; PG8_LDA(At, 1, 0); PG8_STAGE(PG8_SA(0, 1), a2 + hstepA, w10, w11);
            PG8_WAIT_V(8); PG8_WAIT_L(0); PG8_BAR; PG8_MMA(0, 0, At, B0); PG8_MMA(0, 1, At, B1); PG8_BAR; PG8_SCHED;
            PG8_LDA(At, 1, 1); PG8_STAGE(PG8_SB(1, 0), b3, voffB[0], voffB[1]); PG8_STAGE(PG8_SB(1, 1), b3 + hstepB, voffB[0], voffB[1]); PG8_STAGE(PG8_SA(1, 0), a3, w00, w01);
            PG8_WAIT_V(8); PG8_WAIT_L(0); PG8_BAR; PG8_MMA(1, 0, At, B0); PG8_MMA(1, 1, At, B1); PG8_BAR; PG8_SCHED;
        }
        if constexpr (ALIGN_EPI) { if (wr == 0) PG8_BAR; }
        if constexpr (FP8) asm volatile("s_nop 15\n\ts_nop 15" ::: "memory");
        E(acc, cur, wr, wc, fr, fq);
        if (!has_next) break;
        if (!Sched::KEEP || nxt.pb == 0) {
#pragma unroll
        for (int a = 0; a < 2; ++a)
#pragma unroll
            for (int b = 0; b < 2; ++b)
#pragma unroll
                for (int m = 0; m < 4; ++m)
#pragma unroll
                    for (int n = 0; n < 2; ++n) acc[a][b][m][n] = (f32x4){0.f, 0.f, 0.f, 0.f};
        }
        cur = nxt; cA = nA; cB = nB; ++ui;
        if constexpr (ALIGN_EPI) { if (wr == 1) PG8_BAR; }
    }
    PG8_WAIT_V(0);
    if constexpr (!ALIGN_EPI) { if (wr == 0) PG8_BAR; }
    PG8_BAR;
#undef PG8_SA
#undef PG8_SB
#undef PG8_STAGE
#undef PG8_LDA
#undef PG8_LDB
#undef PG8_MMA
#undef PG8_CAT
#undef PG8_WAIT_V
#undef PG8_WAIT_L
#undef PG8_BAR
#undef PG8_SCHED
#undef PG8_VOFFS
#undef PG8_ABASE
#undef PG8_BBASE
}
}
namespace pg8 {
DI void store8(bf16_t* p, f32x4 v0, f32x4 v1) { u32x4 w; w.x = pk2(v0[0], v0[1]); w.y = pk2(v0[2], v0[3]); w.z = pk2(v1[0], v1[1]); w.w = pk2(v1[2], v1[3]); *(u32x4*)p = w; }
DI void load8(const bf16_t* p, f32x4& v0, f32x4& v1) { const u32x4 w = *(const u32x4*)p; v0 = (f32x4){bflo(w.x), bfhi(w.x), bflo(w.y), bfhi(w.y)}; v1 = (f32x4){bflo(w.z), bfhi(w.z), bflo(w.w), bfhi(w.w)}; }
DI void rope8(f32x4& v0, f32x4& v1, const f32x4 c, const f32x4 s) {
    const f32x4 a0 = v0, a1 = v1;
    v0[0] = a0[0] * c[0] - a0[1] * s[0]; v0[1] = a0[1] * c[0] + a0[0] * s[0];
    v0[2] = a0[2] * c[1] - a0[3] * s[1]; v0[3] = a0[3] * c[1] + a0[2] * s[1];
    v1[0] = a1[0] * c[2] - a1[1] * s[2]; v1[1] = a1[1] * c[2] + a1[0] * s[2];
    v1[2] = a1[2] * c[3] - a1[3] * s[3]; v1[3] = a1[3] * c[3] + a1[2] * s[3];
}
DI int row_pos(int row) { const int tp = row % TP; return tp >= PADF ? tp - PADF : 0; }

struct EpiProj {
    bf16_t* O; const float* tabR; const float* tabM; float* ssq;
    DI void operator()(const f32x4 (&acc)[2][2][4][2], const Unit& u, int wr, int wc, int fr, int fq) const {
        const int row0 = u.pm * BM + wr * 64 + fr, colw = u.pn * BM + wc * 32 + 8 * fq;
        const bool ropeR = u.pn < 2, ropeM = (u.pn == 7 && wc == 0);
#pragma unroll
        for (int ai = 0; ai < 2; ++ai) {
            f32x4 tc[4], ts[4];
#pragma unroll
            for (int m = 0; m < 4; ++m) { tc[m] = (f32x4){1.f, 1.f, 1.f, 1.f}; ts[m] = (f32x4){0.f, 0.f, 0.f, 0.f}; }
            if (ropeR || ropeM) {
#pragma unroll
                for (int m = 0; m < 4; ++m) { const int pos = row_pos(row0 + ai * HALF + m * 16);
                    const float* t = ropeR ? tabR + (size_t)pos * 64 + ((colw & 63) >> 1) : tabM + (size_t)pos * 32 + 4 * fq;
                    tc[m] = *(const f32x4*)t; ts[m] = *(const f32x4*)(t + (ropeR ? 32 : 16)); }
            }
#pragma unroll
            for (int m = 0; m < 4; ++m) {
                const int row = row0 + ai * HALF + m * 16;
                float sq = 0.f;
#pragma unroll
                for (int bj = 0; bj < 2; ++bj) {
                    f32x4 v0 = acc[ai][bj][m][0], v1 = acc[ai][bj][m][1]; const int col = colw + bj * HALF;
                    if (ropeR || (ropeM && bj == 1)) rope8(v0, v1, tc[m], ts[m]);
                    if (u.pn == 6 || (u.pn == 7 && bj == 0)) sq += (v0[0] * v0[0] + v0[1] * v0[1]) + (v0[2] * v0[2] + v0[3] * v0[3]) + (v1[0] * v1[0] + v1[1] * v1[1]) + (v1[2] * v1[2] + v1[3] * v1[3]);
                    store8(O + (size_t)row * NPROJ + col, v0, v1);
                }
                if (u.pn == 6 || u.pn == 7) { sq = sum_x16(sq); sq = sum_x32(sq); if (fq == 0) ssq[(size_t)row * 8 + (u.pn == 7 ? 4 : 0) + wc] = sq; }
            }
        }
    }
};
struct EpiQ {
    bf16_t* O; const float* tabM; const float* ssq;
    DI void operator()(const f32x4 (&acc)[2][2][4][2], const Unit& u, int wr, int wc, int fr, int fq) const {
        const int row0 = u.pm * BM + wr * 64 + fr, colw = u.pn * BM + wc * 32 + 8 * fq;
#pragma unroll
        for (int ai = 0; ai < 2; ++ai)
#pragma unroll
        for (int mh = 0; mh < 2; ++mh) {
            f32x4 sp[2], tc[2][2], ts[2][2];
#pragma unroll
            for (int mm = 0; mm < 2; ++mm) { const int row = row0 + ai * HALF + (2 * mh + mm) * 16, pos = row_pos(row);
                sp[mm] = *(const f32x4*)(ssq + (size_t)row * 8);
#pragma unroll
                for (int bj = 0; bj < 2; ++bj) { const int c = (colw + bj * HALF) % 96; const float* t = tabM + (size_t)pos * 32 + (c >= 64 ? ((c - 64) >> 1) : 0);
                    tc[mm][bj] = *(const f32x4*)t; ts[mm][bj] = *(const f32x4*)(t + 16); } }
#pragma unroll
            for (int mm = 0; mm < 2; ++mm) {
                const int m = 2 * mh + mm, row = row0 + ai * HALF + m * 16; const f32x4 s4 = sp[mm];
                const float rstd = 1.0f / sqrtf(((s4[0] + s4[1]) + (s4[2] + s4[3])) * (1.0f / 256.0f) + 1e-6f);
#pragma unroll
                for (int bj = 0; bj < 2; ++bj) {
                    f32x4 v0 = acc[ai][bj][m][0] * rstd, v1 = acc[ai][bj][m][1] * rstd; const int col = colw + bj * HALF;
                    const bool rp = (col % 96) >= 64;
                    f32x4 r0 = v0, r1 = v1; rope8(r0, r1, tc[mm][bj], ts[mm][bj]);
#pragma unroll
                    for (int j = 0; j < 4; ++j) { v0[j] = rp ? r0[j] : v0[j]; v1[j] = rp ? r1[j] : v1[j]; }
                    store8(O + (size_t)row * 768 + col, v0, v1);
                }
            }
        }
    }
};
struct EpiKV {
    bf16_t* O; const float* ssq;
    DI void operator()(const f32x4 (&acc)[2][2][4][2], const Unit& u, int wr, int wc, int fr, int fq) const {
        const int row0 = u.pm * BM + wr * 64 + fr, colw = u.pn * BM + wc * 32 + 8 * fq;
#pragma unroll
        for (int ai = 0; ai < 2; ++ai) {
            f32x4 sp[4];
#pragma unroll
            for (int m = 0; m < 4; ++m) sp[m] = *(const f32x4*)(ssq + (size_t)(row0 + ai * HALF + m * 16) * 8 + 4);
#pragma unroll
            for (int m = 0; m < 4; ++m) {
                const int row = row0 + ai * HALF + m * 16; const f32x4 s4 = sp[m];
                const float rstd = 1.0f / sqrtf(((s4[0] + s4[1]) + (s4[2] + s4[3])) * (1.0f / 128.0f) + 1e-6f);
#pragma unroll
                for (int bj = 0; bj < 2; ++bj) store8(O + (size_t)row * 1024 + colw + bj * HALF, acc[ai][bj][m][0] * rstd, acc[ai][bj][m][1] * rstd);
            }
        }
    }
};
DI unsigned gate_q4(const f32x4 v) { unsigned q[4];
#pragma unroll
    for (int j = 0; j < 4; ++j) q[j] = (unsigned)fmaxf(v[j] * 255.0f + 0.5f, 1.0f);
    return q[0] | (q[1] << 8) | (q[2] << 16) | (q[3] << 24); }
DI f32x4 gate_f4(const unsigned w) { return (f32x4){(float)(w & 0xffu), (float)((w >> 8) & 0xffu), (float)((w >> 16) & 0xffu), (float)(w >> 24)}; }
struct EpiGate {
    unsigned char* O; const float* bias;
    DI void operator()(const f32x4 (&acc)[2][2][4][2], const Unit& u, int wr, int wc, int fr, int fq) const {
        const int row0 = u.pm * BM + wr * 64 + fr, colw = u.pn * BM + wc * 32 + 8 * fq;
#pragma unroll
        for (int bj = 0; bj < 2; ++bj) { const f32x4 b0 = *(const f32x4*)(bias + colw + bj * HALF), b1 = *(const f32x4*)(bias + colw + bj * HALF + 4);
#pragma unroll
        for (int ai = 0; ai < 2; ++ai)
#pragma unroll
            for (int m = 0; m < 4; ++m) {
                const int row = row0 + ai * HALF + m * 16;
                { constexpr float DS = 1.0f / (X8_SCALE * WGU_SCALE); f32x4 v0 = acc[ai][bj][m][0] * DS + b0, v1 = acc[ai][bj][m][1] * DS + b1;
#pragma unroll
                    for (int j = 0; j < 4; ++j) { v0[j] = fast_sigmoid(v0[j]); v1[j] = fast_sigmoid(v1[j]); }
                    *(u32x2*)(O + gate_addr((size_t)row, colw + bj * HALF)) = (u32x2){gate_q4(v0), gate_q4(v1)}; }
            } }
    }
};
struct EpiBranch {
    bf16_t* O; const unsigned char* gates;
    DI void operator()(f32x4 (&acc)[2][2][4][2], const Unit& u, int wr, int wc, int fr, int fq) const {
        const int row0 = u.pm * BM + wr * 64 + fr, colw = u.pn * BM + wc * 32 + 8 * fq;
        const bool fin = u.pb == 3;
        const int gcol = u.pb * 1024 + colw; const int hoff = fin ? 0 : 4096;
        u32x2 G[2][4][2], H[2][4][2];
#pragma unroll
        for (int ai = 0; ai < 2; ++ai)
#pragma unroll
            for (int m = 0; m < 4; ++m)
#pragma unroll
                for (int bj = 0; bj < 2; ++bj) { const unsigned char* gp = gates + gate_addr((size_t)(row0 + ai * HALF + m * 16), gcol + bj * HALF); G[ai][m][bj] = *(const u32x2*)gp; H[ai][m][bj] = *(const u32x2*)(gp + hoff); }
#pragma unroll
        for (int ai = 0; ai < 2; ++ai)
#pragma unroll
            for (int m = 0; m < 4; ++m)
#pragma unroll
                for (int bj = 0; bj < 2; ++bj) {
                    f32x4 g0 = gate_f4(G[ai][m][bj][0]), g1 = gate_f4(G[ai][m][bj][1]); const f32x4 h0 = gate_f4(H[ai][m][bj][0]), h1 = gate_f4(H[ai][m][bj][1]);
#pragma unroll
                    for (int j = 0; j < 4; ++j) { g0[j] *= fin ? (1.0f / (255.0f * YB_SCALE * WDN_SCALE)) : __builtin_amdgcn_rcpf(h0[j]); g1[j] *= fin ? (1.0f / (255.0f * YB_SCALE * WDN_SCALE)) : __builtin_amdgcn_rcpf(h1[j]); }
                    acc[ai][bj][m][0] *= g0; acc[ai][bj][m][1] *= g1;
                    if (fin) store8(O + (size_t)(row0 + ai * HALF + m * 16) * 1024 + colw + bj * HALF, acc[ai][bj][m][0], acc[ai][bj][m][1]); }
    }
};
struct EpiOut {
    bf16_t* H;
    DI void operator()(const f32x4 (&acc)[2][2][4][2], const Unit& u, int wr, int wc, int fr, int fq) const {
        const int row0 = u.pm * BM + wr * 64 + fr, colw = u.pn * BM + wc * 32 + 8 * fq;
#pragma unroll
        for (int ai = 0; ai < 2; ++ai)
#pragma unroll
            for (int m = 0; m < 4; ++m) {
                const int row = row0 + ai * HALF + m * 16;
#pragma unroll
                for (int bj = 0; bj < 2; ++bj) { bf16_t* o = H + (size_t)row * 1024 + colw + bj * HALF; f32x4 p0, p1; load8(o, p0, p1);
                    store8(o, p0 * DN_ALPHA + acc[ai][bj][m][0], p1 * DN_ALPHA + acc[ai][bj][m][1]); }
            }
    }
};

struct MoeTabs { const LAS int* ebase; const LAS int* ecnt; const LAS unsigned char* tile_e; const int* list; int ntiles; };
template <int NN, bool GATHER_> struct MoeOrder {
    static constexpr bool GATHER = GATHER_, KEEP = false;
    MoeTabs T; int G, c;
    DI bool next(int i, Unit& u) const { int t, pn;
        if ((G & 7) == 0 && ((G >> 3) % NN) == 0) { const int x = c & 7, j = c >> 3, tpr = G / NN, tpx = tpr >> 3; pn = j % NN; t = i * tpr + x * tpx + j / NN; }
        else { const long L = (long)i * G + c; t = (int)(L / NN); pn = (int)(L % NN); }
        if (t >= T.ntiles) return false; u.pm = t; u.pn = pn; u.pb = __builtin_amdgcn_readfirstlane((int)T.tile_e[t]); return true; }
    DI int arow(const Unit& u, int r) const {
        const int e = u.pb, idx = (u.pm - T.ebase[e]) * BM + r;
        return idx < T.ecnt[e] ? (T.list[(size_t)e * M + idx] >> 2) : 0;
    }
};
struct EpiSwiglu {
    unsigned char* O; const float* bg; const float* bu;
    DI void operator()(const f32x4 (&acc)[2][2][4][2], const Unit& u, int wr, int wc, int fr, int fq) const {
        const int row0 = u.pm * BM + wr * 64 + fr, cw = u.pn * HALF + wc * 32 + 8 * fq;
        constexpr float DS = 1.0f / (X8_SCALE * WGU_SCALE);
        f32x4 g_b[2], u_b[2];
#pragma unroll
        for (int n = 0; n < 2; ++n) { g_b[n] = *(const f32x4*)(bg + (size_t)u.pb * DE + cw + 4 * n); u_b[n] = *(const f32x4*)(bu + (size_t)u.pb * DE + cw + 4 * n); }
#pragma unroll
        for (int ai = 0; ai < 2; ++ai)
#pragma unroll
            for (int m = 0; m < 4; ++m) {
                const int row = row0 + ai * HALF + m * 16; f32x4 o[2];
#pragma unroll
                for (int n = 0; n < 2; ++n) { const f32x4 gt = acc[ai][0][m][n] * DS + g_b[n], up = acc[ai][1][m][n] * DS + u_b[n];
#pragma unroll
                    for (int j = 0; j < 4; ++j) { const float gg = fminf(gt[j], 7.0f), uu = fminf(fmaxf(up[j], -7.0f), 7.0f); o[n][j] = (uu + 1.0f) * gg * fast_sigmoid(1.702f * gg) * ACT_SCALE; } }
                *(u32x2*)(O + (size_t)row * DE + cw) = (u32x2){pk4_fp8(o[0][0], o[0][1], o[0][2], o[0][3]), pk4_fp8(o[1][0], o[1][1], o[1][2], o[1][3])};
            }
    }
};
struct EpiDown {
    unsigned char* O; const float* bd; MoeTabs T;
    DI void operator()(const f32x4 (&acc)[2][2][4][2], const Unit& u, int wr, int wc, int fr, int fq) const {
        const int e = u.pb, r0 = wr * 64 + fr, colw = u.pn * BM + wc * 32 + 8 * fq, ibase = (u.pm - T.ebase[e]) * BM, cnt = T.ecnt[e];
        constexpr float DS = 1.0f / (ACT_SCALE * WDN_SCALE);
        f32x4 bv[2][2];
#pragma unroll
        for (int bj = 0; bj < 2; ++bj)
#pragma unroll
            for (int n = 0; n < 2; ++n) bv[bj][n] = *(const f32x4*)(bd + (size_t)e * D + colw + bj * HALF + 4 * n);
        int ents[2][4];
#pragma unroll
        for (int ai = 0; ai < 2; ++ai)
#pragma unroll
            for (int m = 0; m < 4; ++m) { const int idx = ibase + r0 + ai * HALF + m * 16; ents[ai][m] = T.list[(size_t)e * M + (idx < cnt ? idx : 0)]; }
#pragma unroll
        for (int ai = 0; ai < 2; ++ai)
#pragma unroll
            for (int m = 0; m < 4; ++m) {
                const int idx = ibase + r0 + ai * HALF + m * 16;
                if (idx < cnt) { const int ent = ents[ai][m];
#pragma unroll
                    for (int bj = 0; bj < 2; ++bj) { const f32x4 v0 = (acc[ai][bj][m][0] * DS + bv[bj][0]) * YS_SCALE, v1 = (acc[ai][bj][m][1] * DS + bv[bj][1]) * YS_SCALE;
                        *(u32x2*)(O + (size_t)ent * D + colw + bj * HALF) = (u32x2){pk4_fp8(v0[0], v0[1], v0[2], v0[3]), pk4_fp8(v1[0], v1[1], v1[2], v1[3])}; } }
            }
    }
};
}
struct KArgs { const float* in[34]; float* out; unsigned char* ws; int ph_lo, ph_hi; float invR[32]; float invM[16]; };
typedef const __attribute__((address_space(4))) KArgs* kargs_t;
DI kargs_t get_args() { kargs_t p = (kargs_t)__builtin_amdgcn_kernarg_segment_ptr(); asm volatile("" : "+s"(p)); return p; }
struct Frame {
    LAS unsigned char* lds; gu32* ctl; unsigned char* ws;
    int tid, lane, wave, G, bid;
};
enum { I_X = 0, I_META, I_LN0G, I_LN0B, I_WIN, I_WMERGE, I_BMERGE, I_GCQ, I_GCKV, I_WUQ, I_WUKV, I_CONVW, I_CONVB, I_WLA, I_BLA, I_WLX, I_BLX, I_LAM, I_WA2, I_BA2,
       I_WBR, I_WOUT, I_LN1G, I_LN1B, I_WR, I_BR, I_WEG, I_BEG, I_WEU, I_BEU, I_WED, I_BED, I_LN2G, I_LN2B };

struct ColSrc { const float* p; float scale; };
template <class F>
DI void transpose_fill(const Frame& Fr, F colmap, int n0, int k0, int ldsrc, const float* kscale, float post) {
    LAS float* scr = (LAS float*)(Fr.lds + Fr.wave * 16384);
    const int lane = Fr.lane;
    const ColSrc c0 = colmap(n0), c31 = colmap(n0 + 31), cme = colmap(n0 + (lane & 31));
    const bool contig = c0.p && c31.p == c0.p + 31 && cme.p == c0.p + (lane & 31) && c0.scale == c31.scale && (((size_t)c0.p & 15) == 0) && ((ldsrc & 3) == 0);
    if (__all(contig)) {
        const float sc = c0.scale * post; const int kk = lane >> 3, n4 = lane & 7;
        const float* src = c0.p + (size_t)(k0 + kk) * ldsrc + 4 * n4;
        f32x4 v[8];
#pragma unroll
        for (int i = 0; i < 8; ++i) v[i] = *(const f32x4*)(src + (size_t)(8 * i) * ldsrc);
#pragma unroll
        for (int i = 0; i < 8; ++i) { float ks = sc; if (kscale) ks *= kscale[k0 + 8 * i + kk]; LAS float* d = scr + (8 * i + kk) * 33 + 4 * n4; d[0] = v[i][0] * ks; d[1] = v[i][1] * ks; d[2] = v[i][2] * ks; d[3] = v[i][3] * ks; }
    } else {
        const float* src = cme.p ? cme.p : colmap(0).p;
        const float sc = cme.p ? cme.scale * post : 0.f;
        src += (size_t)(k0 + (lane >> 5)) * ldsrc;
        float v[32];
#pragma unroll
        for (int i = 0; i < 32; ++i) v[i] = src[(size_t)(2 * i) * ldsrc];
        if (kscale) {
#pragma unroll
            for (int i = 0; i < 32; ++i) v[i] *= kscale[k0 + 2 * i + (lane >> 5)];
        }
#pragma unroll
        for (int i = 0; i < 32; ++i) scr[(2 * i + (lane >> 5)) * 33 + (lane & 31)] = v[i] * sc;
    }
    LDS_WAIT(); asm volatile("" ::: "memory");
}
template <class F>
DI void transpose_item(const Frame& Fr, F colmap, int item, int ndst, int K, int ldsrc, const float* kscale, bf16_t* WT) {
    LAS float* scr = (LAS float*)(Fr.lds + Fr.wave * 16384);
    const int lane = Fr.lane, nblk = ndst / 32;
    const int kb = item / nblk, nb = item % nblk, k0 = 64 * kb, n0 = 32 * nb;
    transpose_fill(Fr, colmap, n0, k0, ldsrc, kscale, 1.0f);
    const int c = lane & 7;
#pragma unroll
    for (int j = 0; j < 4; ++j) { const int n = (lane >> 3) + 8 * j; const LAS float* s = scr + (8 * c) * 33 + n;
        u32x4 o; o.x = pk2(s[0 * 33], s[1 * 33]); o.y = pk2(s[2 * 33], s[3 * 33]); o.z = pk2(s[4 * 33], s[5 * 33]); o.w = pk2(s[6 * 33], s[7 * 33]);
        *(u32x4*)(WT + (size_t)(n0 + n) * K + k0 + 8 * c) = o; }
    LDS_WAIT(); asm volatile("" ::: "memory");
}
template <class F>
DI void transpose_item_fp8(const Frame& Fr, F colmap, int item, int ndst, int K, int ldsrc, float sc8, unsigned char* WT) {
    LAS float* scr = (LAS float*)(Fr.lds + Fr.wave * 16384);
    const int lane = Fr.lane, nblk = ndst / 32;
    const int kb = item / nblk, nb = item % nblk, k0 = 64 * kb, n0 = 32 * nb;
    transpose_fill(Fr, colmap, n0, k0, ldsrc, nullptr, sc8);
    const int c = lane & 7;
#pragma unroll
    for (int j = 0; j < 4; ++j) { const int n = (lane >> 3) + 8 * j; const LAS float* s = scr + (8 * c) * 33 + n;
        *(u32x2*)(WT + (size_t)(n0 + n) * K + k0 + 8 * c) = (u32x2){pk4_fp8(s[0 * 33], s[1 * 33], s[2 * 33], s[3 * 33]), pk4_fp8(s[4 * 33], s[5 * 33], s[6 * 33], s[7 * 33])}; }
    LDS_WAIT(); asm volatile("" ::: "memory");
}
struct MapIn {
    const float* W;
    DI ColSrc operator()(int n) const {
        int src; float sc = 1.f;
        if (n < 256) { const int h = n >> 6, c = n & 63; src = O_RQ + h * 64 + (c >> 1) + 32 * (c & 1); }
        else if (n < 512) { const int q = n - 256, h = q >> 6, c = q & 63; src = O_RK + h * 64 + (c >> 1) + 32 * (c & 1); sc = 0.125f; }
        else if (n < 1024) src = O_RV + (n - 512);
        else if (n < 1536) src = O_RG + (n - 1024);
        else if (n < 1792) src = O_CQ + (n - 1536);
        else if (n < 1920) src = O_CKV + (n - 1792);
        else if (n < 1952) { const int c = n - 1920; src = O_KR + (c >> 1) + 16 * (c & 1); }
        else if (n < 1968) src = O_GA + (n - 1952);
        else if (n < 2048) return ColSrc{nullptr, 0.f};
        else if (n < 2560) src = O_LX + (n - 2048);
        else if (n < 3072) src = O_LG + (n - 2560);
        else if (n < 3328) src = O_GQ + (n - 3072);
        else if (n < 3584) { src = O_GK + (n - 3328); sc = 0.125f; }
        else if (n < 4096) src = O_GV + (n - 3584);
        else src = O_GG + (n - 4096);
        return ColSrc{W + src, sc};
    }
};
struct MapPlain { const float* W; DI ColSrc operator()(int n) const { return ColSrc{W + n, 1.f}; } };
struct MapUq {
    const float* W;
    DI ColSrc operator()(int n) const { const int h = n / 96, c = n % 96; int src = h * 96 + c; if (c >= 64) { const int cc = c - 64; src = h * 96 + 64 + (cc >> 1) + 16 * (cc & 1); }
        return ColSrc{W + src, 0.10206207261596577f * LOG2E}; }
};
struct MapUkv {
    const float* W;
    DI ColSrc operator()(int n) const { const int q = n & 511, h = q >> 6, d = q & 63; return ColSrc{W + h * 128 + (n >= 512 ? 64 : 0) + d, 1.f}; }
};
struct MapGU {
    const float* Wg; const float* Wu;
    DI ColSrc operator()(int n) const { const int j = n >> 8, r = n & 255; const long dlt = (r < 128) ? 0 : (long)(Wu - Wg); return ColSrc{Wg + dlt + 128 * j + (r & 127), 1.f}; }
};

constexpr int CI_IN = (NPROJ / 32) * (D / 64), CI_MG = (4096 / 32) * (D / 64), CI_BR1 = (D / 32) * (512 / 64), CI_OUT = (D / 32) * (D / 64), CI_UQ = (768 / 32) * (256 / 64),
              CI_UKV = (1024 / 32) * (128 / 64), CI_GU1 = (2048 / 32) * (D / 64), CI_DN1 = (D / 32) * (DE / 64);
constexpr int CO_MG = CI_IN, CO_BR = CO_MG + CI_MG, CO_OUT = CO_BR + 4 * CI_BR1, CO_UQ = CO_OUT + CI_OUT, CO_UKV = CO_UQ + CI_UQ, CO_GU = CO_UKV + CI_UKV, CO_DN = CO_GU + NE * CI_GU1,
              CI_TOTAL = CO_DN + NE * CI_DN1;
struct ConvItem { const float* src; unsigned char* dst; float scale; int ldsrc, K, n0, k0; bool fast, fp8; };
DI ConvItem conv_decode(kargs_t a, unsigned char* ws, int l, int it, int lane) {
    ConvItem c; c.src = nullptr; c.dst = nullptr; c.scale = 1.f; c.ldsrc = 0; c.K = 0; c.n0 = 0; c.k0 = 0; c.fast = false; c.fp8 = false;
    const float* W = nullptr; int ndst = 0, srccol = -1; int r = it;
    if (it >= CO_DN) { r = it - CO_DN; const int e = r / CI_DN1; r %= CI_DN1; W = a->in[I_WED] + ((size_t)l * NE + e) * D * DE; ndst = D; c.K = DE; c.ldsrc = D; c.fp8 = true; c.scale = WDN_SCALE; c.dst = ws + W_DN + (size_t)e * D * DE; srccol = 0; }
    else if (it >= CO_GU) { r = it - CO_GU; const int e = r / CI_GU1; r %= CI_GU1; ndst = 2048; c.K = D; c.ldsrc = DE; c.fp8 = true; c.scale = WGU_SCALE; c.dst = ws + W_GU + (size_t)e * 2048 * D; srccol = -2;
        W = a->in[I_WEG] + ((size_t)l * NE + e) * D * DE; }
    else if (it >= CO_UQ) return c;
    else if (it >= CO_OUT) { r = it - CO_OUT; W = a->in[I_WOUT] + (size_t)l * D * D; ndst = D; c.K = D; c.ldsrc = D; c.dst = ws + W_OUT; srccol = 0; }
    else if (it >= CO_BR) { r = it - CO_BR; const int n = r / CI_BR1; r %= CI_BR1; W = a->in[I_WBR] + ((size_t)l * 4 + n) * 512 * D; ndst = D; c.K = 512; c.ldsrc = D; c.fp8 = true; c.scale = WDN_SCALE; c.dst = ws + W_BR + (size_t)n * D * 512; srccol = 0; }
    else if (it >= CO_MG) { r = it - CO_MG; W = a->in[I_WMERGE] + (size_t)l * D * 4096; ndst = 4096; c.K = D; c.ldsrc = 4096; c.fp8 = true; c.scale = WGU_SCALE; c.dst = ws + W_MG; srccol = 0; }
    else { W = a->in[I_WIN] + (size_t)l * D * D_IN; ndst = NPROJ; c.K = D; c.ldsrc = D_IN; c.dst = ws + W_IN; srccol = -3; }
    const int nblk = ndst / 32; c.k0 = 64 * (r / nblk); c.n0 = 32 * (r % nblk);
    int col;
    if (srccol == 0) col = c.n0;
    else if (srccol == -2) { const int j = c.n0 >> 8, rr = c.n0 & 255; if (rr >= 128) W = a->in[I_WEU] + (W - a->in[I_WEG]); col = 128 * j + (rr & 127); }
    else { if (c.n0 < 512 || (c.n0 >= 1920 && c.n0 < 2048)) return c;
        const ColSrc cs = MapIn{W}(c.n0); col = (int)(cs.p - W); c.scale = cs.scale; }
    const float* p0 = W + col;
    if ((((size_t)p0) & 15) != 0 || (c.ldsrc & 3) != 0) return c;
    c.src = p0 + (size_t)(c.k0 + 8 * (lane >> 3)) * c.ldsrc + 4 * (lane & 7); c.fast = true;
    return c;
}
DI void conv_load(const ConvItem& c, f32x4 (&v)[8]) {
#pragma unroll
    for (int i = 0; i < 8; ++i) v[i] = *(const f32x4*)(c.src + (size_t)i * c.ldsrc);
}
DI void conv_finish(const Frame& Fr, const ConvItem& c, const f32x4 (&v)[8]) {
    const int lane = Fr.lane, kg = lane >> 3, n4 = lane & 7; const float sc = c.scale;
#pragma unroll
    for (int j = 0; j < 4; ++j) { const size_t e = (size_t)(c.n0 + 4 * n4 + j) * c.K + c.k0 + 8 * kg;
        if (c.fp8) *(u32x2*)(c.dst + e) = (u32x2){pk4_fp8(v[0][j] * sc, v[1][j] * sc, v[2][j] * sc, v[3][j] * sc), pk4_fp8(v[4][j] * sc, v[5][j] * sc, v[6][j] * sc, v[7][j] * sc)};
        else *(u32x4*)((bf16_t*)c.dst + e) = (u32x4){pk2(v[0][j] * sc, v[1][j] * sc), pk2(v[2][j] * sc, v[3][j] * sc), pk2(v[4][j] * sc, v[5][j] * sc), pk2(v[6][j] * sc, v[7][j] * sc)}; }
}
DI void conv_slow(const Frame& F, kargs_t a, int l, int it) {
    unsigned char* ws = F.ws;
    if (it >= CO_UKV && it < CO_GU) transpose_item(F, MapUkv{a->in[I_WUKV] + (size_t)l * 128 * 1024}, it - CO_UKV, 1024, 128, 1024, a->in[I_GCKV] + l * 128, (bf16_t*)(ws + W_UKV));
    else if (it >= CO_UQ && it < CO_UKV) transpose_item(F, MapUq{a->in[I_WUQ] + (size_t)l * 256 * 768}, it - CO_UQ, 768, 256, 768, a->in[I_GCQ] + l * 256, (bf16_t*)(ws + W_UQ));
    else transpose_item(F, MapIn{a->in[I_WIN] + (size_t)l * D * D_IN}, it, NPROJ, D, D_IN, nullptr, (bf16_t*)(ws + W_IN));
}
DI void phase_convert(const Frame& F, kargs_t a, int l) {
    const int gw = F.bid * NWAVES + F.wave, NGW = F.G * NWAVES;
    unsigned char* ws = F.ws;
    f32x4 vc[8], vn[8];
#pragma unroll
    for (int i = 0; i < 8; ++i) { vc[i] = (f32x4){0.f, 0.f, 0.f, 0.f}; vn[i] = vc[i]; }
    int it = gw;
    ConvItem cur; cur.fast = false;
    if (it < CI_TOTAL) { cur = conv_decode(a, ws, l, it, F.lane); if (cur.fast) conv_load(cur, vc); }
    for (; it < CI_TOTAL; it += NGW) {
        const int itn = it + NGW; ConvItem nxt; nxt.fast = false;
        if (itn < CI_TOTAL) { nxt = conv_decode(a, ws, l, itn, F.lane); if (nxt.fast) conv_load(nxt, vn); }
        if (cur.fast) conv_finish(F, cur, vc); else conv_slow(F, a, l, it);
        cur = nxt;
#pragma unroll
        for (int i = 0; i < 8; ++i) vc[i] = vn[i];
    }
}


DI f32x4 bf16x4_to_f32(const u32x2 g) { return (f32x4){__uint_as_float(g[0] << 16), __uint_as_float(g[0] & 0xffff0000u), __uint_as_float(g[1] << 16), __uint_as_float(g[1] & 0xffff0000u)}; }
DI void meta_branch(const Frame& F, const unsigned char* gates) {
    unsigned char* ws = F.ws; LAS float* red = (LAS float*)F.lds;
    const int lane = F.lane, w = F.wave, fr = lane & 15, fq = lane >> 4, br = w >> 1, kb = (w & 1) * 256;
    for (int s = F.bid; s < NB * 64; s += F.G) {
        const int b = s >> 6, c0 = (s & 63) * 16;
        const size_t row = (size_t)b * TP + PADF + fr;
        const unsigned char* ap = ws + WS_YS + row * 2048 + br * 512 + kb + 16 * fq;
        const unsigned char* wp = ws + W_BR + ((size_t)br * D + c0 + fr) * 512 + kb + 16 * fq;
        u32x4 av[4], wv[4];
#pragma unroll
        for (int i = 0; i < 4; ++i) { av[i] = *(const u32x4*)(ap + 64 * i); wv[i] = *(const u32x4*)(wp + 64 * i); }
        const unsigned gg = *(const unsigned*)(gates + gate_addr(row, br * 1024 + c0 + 4 * fq));
        f32x4 acc = {0.f, 0.f, 0.f, 0.f};
#pragma unroll
        for (int i = 0; i < 4; ++i) {
            acc = __builtin_amdgcn_mfma_f32_16x16x32_fp8_fp8((long)(((unsigned long long)wv[i].y << 32) | wv[i].x), (long)(((unsigned long long)av[i].y << 32) | av[i].x), acc, 0, 0, 0);
            acc = __builtin_amdgcn_mfma_f32_16x16x32_fp8_fp8((long)(((unsigned long long)wv[i].w << 32) | wv[i].z), (long)(((unsigned long long)av[i].w << 32) | av[i].z), acc, 0, 0, 0); }
        *(LAS f32x4*)(red + w * 256 + fr * 16 + 4 * fq) = acc * (pg8::gate_f4(gg) * (1.0f / (255.0f * YB_SCALE * WDN_SCALE)));
        __syncthreads();
        if (F.tid < 64) { f32x4 sum = *(const LAS f32x4*)(red + F.tid * 4);
#pragma unroll
            for (int k = 1; k < 8; ++k) sum += *(const LAS f32x4*)(red + k * 256 + F.tid * 4);
            *(u32x2*)((bf16_t*)(ws + WS_MIX) + ((size_t)b * TP + PADF + (F.tid >> 2)) * 1024 + c0 + 4 * (F.tid & 3)) = (u32x2){pk2(sum[0], sum[1]), pk2(sum[2], sum[3])}; }
        __syncthreads();
    }
}
DI void meta_gates(const Frame& F, unsigned char* gates, const float* bias) {
    unsigned char* ws = F.ws; LAS float* red = (LAS float*)F.lds;
    const int lane = F.lane, w = F.wave, fr = lane & 15, fq = lane >> 4, cs = w & 3, kb = (w >> 2) * 512;
    for (int s = F.bid; s < NB * 64; s += F.G) {
        const int b = s >> 6, c0 = (s & 63) * 64;
        const size_t row = (size_t)b * TP + PADF + fr;
        const unsigned char* ap = ws + WS_H8 + row * D + kb + 16 * fq;
        const unsigned char* wp = ws + W_MG + (size_t)(c0 + 16 * cs + fr) * D + kb + 16 * fq;
        u32x4 av[8], wv[8];
#pragma unroll
        for (int i = 0; i < 8; ++i) { av[i] = *(const u32x4*)(ap + 64 * i); wv[i] = *(const u32x4*)(wp + 64 * i); }
        f32x4 acc = {0.f, 0.f, 0.f, 0.f};
#pragma unroll
        for (int i = 0; i < 8; ++i) {
            acc = __builtin_amdgcn_mfma_f32_16x16x32_fp8_fp8((long)(((unsigned long long)wv[i].y << 32) | wv[i].x), (long)(((unsigned long long)av[i].y << 32) | av[i].x), acc, 0, 0, 0);
            acc = __builtin_amdgcn_mfma_f32_16x16x32_fp8_fp8((long)(((unsigned long long)wv[i].w << 32) | wv[i].z), (long)(((unsigned long long)av[i].w << 32) | av[i].z), acc, 0, 0, 0); }
        *(LAS f32x4*)(red + w * 256 + fr * 16 + 4 * fq) = acc;
        __syncthreads();
        if (F.tid < 256) { const int r = F.tid >> 4, c4 = F.tid & 15, o = (c4 >> 2) * 256 + r * 16 + 4 * (c4 & 3);
            constexpr float DS = 1.0f / (X8_SCALE * WGU_SCALE);
            f32x4 v = (*(const LAS f32x4*)(red + o) + *(const LAS f32x4*)(red + 1024 + o)) * DS + *(const f32x4*)(bias + c0 + 4 * c4);
#pragma unroll
            for (int j = 0; j < 4; ++j) v[j] = fast_sigmoid(v[j]);
            *(unsigned*)(gates + gate_addr((size_t)b * TP + PADF + r, c0 + 4 * c4)) = pg8::gate_q4(v); }
        __syncthreads();
    }
}
DI void meta_out(const Frame& F, bf16_t* hb) {
    unsigned char* ws = F.ws; LAS float* red = (LAS float*)F.lds;
    const int lane = F.lane, w = F.wave, fr = lane & 15, fq = lane >> 4, kb = w * 128;
    for (int s = F.bid; s < NB * 64; s += F.G) {
        const int b = s >> 6, c0 = (s & 63) * 16;
        const size_t row = (size_t)b * TP + PADF + fr;
        const bf16_t* ap = (const bf16_t*)(ws + WS_MIX) + row * 1024 + kb + 8 * fq;
        const bf16_t* wp = (const bf16_t*)(ws + W_OUT) + (size_t)(c0 + fr) * 1024 + kb + 8 * fq;
        bf16x8 av[4], wv[4];
#pragma unroll
        for (int i = 0; i < 4; ++i) { av[i] = *(const bf16x8*)(ap + 32 * i); wv[i] = *(const bf16x8*)(wp + 32 * i); }
        f32x4 acc = {0.f, 0.f, 0.f, 0.f};
#pragma unroll
        for (int i = 0; i < 4; ++i) acc = __builtin_amdgcn_mfma_f32_16x16x32_bf16(wv[i], av[i], acc, 0, 0, 0);
        *(LAS f32x4*)(red + w * 256 + fr * 16 + 4 * fq) = acc;
        __syncthreads();
        if (F.tid < 64) { f32x4 sum = *(const LAS f32x4*)(red + F.tid * 4);
#pragma unroll
            for (int k = 1; k < 8; ++k) sum += *(const LAS f32x4*)(red + k * 256 + F.tid * 4);
            u32x2* o = (u32x2*)(hb + ((size_t)b * TP + PADF + (F.tid >> 2)) * 1024 + c0 + 4 * (F.tid & 3));
            const f32x4 p = bf16x4_to_f32(*o); sum += p * DN_ALPHA;
            *o = (u32x2){pk2(sum[0], sum[1]), pk2(sum[2], sum[3])}; }
        __syncthreads();
    }
}

DI void ln_stats(const f32x4 (&v)[4], float& mean, float& rstd) {
    float s = 0.f;
#pragma unroll
    for (int j = 0; j < 4; ++j) s += (v[j][0] + v[j][1]) + (v[j][2] + v[j][3]);
    mean = wave_sum(s) * (1.f / D); float s2 = 0.f;
#pragma unroll
    for (int j = 0; j < 4; ++j) { const f32x4 d = v[j] - mean; s2 += (d[0] * d[0] + d[1] * d[1]) + (d[2] * d[2] + d[3] * d[3]); }
    rstd = 1.0f / sqrtf(wave_sum(s2) * (1.f / D) + 1e-5f);
}
DI void row_store_bf16(bf16_t* orow, int lane, const f32x4 (&v)[4]) {
    u32x2* o8 = (u32x2*)orow + lane;
#pragma unroll
    for (int j = 0; j < 4; ++j) o8[64 * j] = (u32x2){pk2(v[j][0], v[j][1]), pk2(v[j][2], v[j][3])};
}
DI void row_load_bf16(const bf16_t* irow, int lane, f32x4 (&v)[4]) {
    const u32x2* i8 = (const u32x2*)irow + lane;
#pragma unroll
    for (int j = 0; j < 4; ++j) { const u32x2 w = i8[64 * j]; v[j] = (f32x4){bflo(w.x), bfhi(w.x), bflo(w.y), bfhi(w.y)}; }
}

DI void phase_ln0(const Frame& F, kargs_t a) {
    const int gw = F.bid * NWAVES + F.wave, NGW = F.G * NWAVES, lane = F.lane;
    bf16_t* hb = (bf16_t*)(F.ws + WS_HB);
    const float* g = a->in[I_LN0G]; const float* bb = a->in[I_LN0B];
    f32x4 gv[4], bv[4];
#pragma unroll
    for (int j = 0; j < 4; ++j) { gv[j] = *((const f32x4*)g + lane + 64 * j); bv[j] = *((const f32x4*)bb + lane + 64 * j); }
    for (int m = gw; m < M; m += NGW) {
        const int b = m / TP, tp = m % TP; f32x4 v[4];
        if (tp < PADF) {
#pragma unroll
            for (int j = 0; j < 4; ++j) v[j] = (f32x4){0.f, 0.f, 0.f, 0.f};
        } else {
            const int pos = tp - PADF; const float* src = pos < NMETA ? a->in[I_META] + (size_t)pos * D : a->in[I_X] + ((size_t)b * SEQ + pos - NMETA) * D;
#pragma unroll
            for (int j = 0; j < 4; ++j) v[j] = *((const f32x4*)src + lane + 64 * j);
            float mean, rstd; ln_stats(v, mean, rstd);
#pragma unroll
            for (int j = 0; j < 4; ++j) v[j] = (v[j] - mean) * rstd * gv[j] + bv[j];
        }
        row_store_bf16(hb + (size_t)m * D, lane, v);
        { unsigned* h8r = (unsigned*)(F.ws + WS_H8 + (size_t)m * D) + lane;
#pragma unroll
          for (int j = 0; j < 4; ++j) h8r[64 * j] = pk4_fp8(v[j][0] * X8_SCALE, v[j][1] * X8_SCALE, v[j][2] * X8_SCALE, v[j][3] * X8_SCALE); }
    }
    float* tabR = (float*)(F.ws + WS_TABR); float* tabM = (float*)(F.ws + WS_TABM);
    const int gt = F.bid * NTHREADS + F.tid, NGT = F.G * NTHREADS;
    for (int i = gt; i < TT * 48; i += NGT) {
        const int pos = i / 48, f = i % 48; const float inv = f < 32 ? a->invR[f] : a->invM[f - 32];
        const float angf = (float)pos * inv; const double ang = (double)angf;
        const double kq = rint(ang * 0.63661977236758134308); double r = fma(-kq, 1.57079632679489655800e+00, ang); r = fma(-kq, 6.12323399573676603587e-17, r);
        const double r2 = r * r;
        const double sn = r * (1.0 + r2 * (-1.0 / 6 + r2 * (1.0 / 120 + r2 * (-1.0 / 5040 + r2 * (1.0 / 362880 + r2 * (-1.0 / 39916800))))));
        const double cs = 1.0 + r2 * (-0.5 + r2 * (1.0 / 24 + r2 * (-1.0 / 720 + r2 * (1.0 / 40320 + r2 * (-1.0 / 3628800 + r2 * (1.0 / 479001600))))));
        const int q = ((int)kq) & 3; double c, s;
        if (q == 0) { c = cs; s = sn; } else if (q == 1) { c = -sn; s = cs; } else if (q == 2) { c = -cs; s = -sn; } else { c = sn; s = -cs; }
        if (f < 32) { tabR[(size_t)pos * 64 + f] = (float)c; tabR[(size_t)pos * 64 + 32 + f] = (float)s; }
        else { tabM[(size_t)pos * 32 + f - 32] = (float)c; tabM[(size_t)pos * 32 + 16 + f - 32] = (float)s; }
    }
}

DI void ln1_row_norm(bf16_t* hb, unsigned char* x8, int m, int lane, const f32x4 (&gv)[4], const f32x4 (&bv)[4], f32x4 (&v)[4], bool& valid) {
    valid = false;
#pragma unroll
    for (int j = 0; j < 4; ++j) v[j] = (f32x4){0.f, 0.f, 0.f, 0.f};
    if (m >= M) return;
    const int tp = m % TP;
    unsigned* x8r = (unsigned*)(x8 + (size_t)m * D) + lane;
    if (tp < PADF) { row_store_bf16(hb + (size_t)m * D, lane, v);
#pragma unroll
        for (int j = 0; j < 4; ++j) x8r[64 * j] = 0u;
        return; }
    valid = true;
    row_load_bf16(hb + (size_t)m * D, lane, v);
    float mean, rstd; ln_stats(v, mean, rstd);
#pragma unroll
    for (int j = 0; j < 4; ++j) v[j] = (v[j] - mean) * rstd * gv[j] + bv[j];
    row_store_bf16(hb + (size_t)m * D, lane, v);
#pragma unroll
    for (int j = 0; j < 4; ++j) x8r[64 * j] = pk4_fp8(v[j][0] * X8_SCALE, v[j][1] * X8_SCALE, v[j][2] * X8_SCALE, v[j][3] * X8_SCALE);
}
DI float butterfly32(float (&p)[NE], int lane) {
#pragma unroll
    for (int i = 0; i < 16; ++i) { const bool up = (lane & 32) != 0; const float send = up ? p[i] : p[i + 16], keep = up ? p[i + 16] : p[i]; p[i] = keep + xor32_f(send, lane); }
#pragma unroll
    for (int i = 0; i < 8; ++i) { const bool up = (lane & 16) != 0; const float send = up ? p[i] : p[i + 8], keep = up ? p[i + 8] : p[i]; p[i] = keep + xor16_f(send, lane); }
#pragma unroll
    for (int i = 0; i < 4; ++i) { const bool up = (lane & 8) != 0; const float send = up ? p[i] : p[i + 4], keep = up ? p[i + 4] : p[i]; p[i] = keep + xor8_f(send); }
#pragma unroll
    for (int i = 0; i < 2; ++i) { const bool up = (lane & 4) != 0; const float send = up ? p[i] : p[i + 2], keep = up ? p[i + 2] : p[i]; p[i] = keep + xor4_f(send); }
    { const bool up = (lane & 2) != 0; const float send = up ? p[0] : p[1], keep = up ? p[1] : p[0]; p[0] = keep + xor2_f(send); }
    return p[0] + xor1_f(p[0]);
}
DI void ln1_route(float logit, int m, int lane, int* topi, float* topw, LAS unsigned* rt) {
    float cand = (lane & 1) ? -3.0e38f : logit; float tv[4]; int ti[4];
#pragma unroll
    for (int r = 0; r < 4; ++r) {
        const float mx = wave_max(cand);
        const int idx = __ffsll((long long)__ballot(cand == mx)) - 1;
        tv[r] = mx; ti[r] = idx >> 1; if (lane == idx) cand = -3.0e38f;
    }
    const float e1 = fast_exp(tv[1] - tv[0]), e2 = fast_exp(tv[2] - tv[0]), e3 = fast_exp(tv[3] - tv[0]); const float inv = 1.0f / (1.0f + e1 + e2 + e3);
    if (lane < 4) {
        const int my_e = lane == 0 ? ti[0] : lane == 1 ? ti[1] : lane == 2 ? ti[2] : ti[3];
        const float my_w = (lane == 0 ? 1.0f : lane == 1 ? e1 : lane == 2 ? e2 : e3) * inv;
        topi[(size_t)m * 4 + lane] = my_e; topw[(size_t)m * 4 + lane] = my_w;
        const unsigned lp = __hip_atomic_fetch_add(rt + my_e, 1u, __ATOMIC_RELAXED, __HIP_MEMORY_SCOPE_WORKGROUP);
        const unsigned slot = __hip_atomic_fetch_add(rt + 64, 1u, __ATOMIC_RELAXED, __HIP_MEMORY_SCOPE_WORKGROUP);
        rt[128 + 2 * slot] = (unsigned)(m * 4 + lane); rt[128 + 2 * slot + 1] = ((unsigned)my_e << 16) | lp;
    }
}
DI void phase_ln1(const Frame& F, kargs_t a, int l) {
    const int gw = F.bid * NWAVES + F.wave, NGW = F.G * NWAVES, lane = F.lane;
    bf16_t* hb = (bf16_t*)(F.ws + WS_HB);
    int* topi = (int*)(F.ws + WS_TOPI); float* topw = (float*)(F.ws + WS_TOPW); int* list = (int*)(F.ws + WS_LIST); unsigned char* x8 = F.ws + WS_X8;
    gu32* ecnt = F.ctl + CW_ECNT + 2048 * l;
    LAS unsigned* rt = (LAS unsigned*)(F.lds + TAB_OFF + 1024);
    if (F.tid < 128) rt[F.tid] = 0u;
    constexpr int WRP = D + 4;
    LAS float* wrt = (LAS float*)F.lds;
    const float* wr = a->in[I_WR] + (size_t)l * D * NE;
    for (int i = F.tid; i < D * NE; i += NTHREADS) { const int k = i >> 5, e = i & 31; wrt[e * WRP + k] = wr[i]; }
    __syncthreads();
    const float* g = a->in[I_LN1G] + l * D; const float* bb = a->in[I_LN1B] + l * D;
    f32x4 gv[4], bv[4];
#pragma unroll
    for (int j = 0; j < 4; ++j) { gv[j] = *((const f32x4*)g + lane + 64 * j); bv[j] = *((const f32x4*)bb + lane + 64 * j); }
    const float brl = a->in[I_BR][l * NE + ((lane >> 1) & 31)];
    for (int m0 = gw; m0 < M; m0 += 2 * NGW) {
        const int m1 = m0 + NGW;
        f32x4 x0[4], x1[4]; bool val0, val1;
        ln1_row_norm(hb, x8, m0, lane, gv, bv, x0, val0);
        ln1_row_norm(hb, x8, m1, lane, gv, bv, x1, val1);
        if (!val0 && !val1) continue;
        float p0[NE], p1[NE];
#pragma unroll
        for (int e = 0; e < NE; ++e) { float s0 = 0.f, s1 = 0.f;
#pragma unroll
            for (int j = 0; j < 4; ++j) { const f32x4 w = *((const LAS f32x4*)(wrt + e * WRP) + lane + 64 * j);
#pragma unroll
                for (int q = 0; q < 4; ++q) { s0 = __builtin_fmaf(x0[j][q], w[q], s0); s1 = __builtin_fmaf(x1[j][q], w[q], s1); } }
            p0[e] = s0; p1[e] = s1; }
        const float l0 = butterfly32(p0, lane) + brl, l1 = butterfly32(p1, lane) + brl;
        if (val0) ln1_route(l0, m0, lane, topi, topw, rt);
        if (val1) ln1_route(l1, m1, lane, topi, topw, rt);
    }
    __syncthreads();
    if (F.tid < NE) { const unsigned c = rt[F.tid]; rt[32 + F.tid] = c ? __hip_atomic_fetch_add(ecnt + 64 * F.tid, c, RLX_AGENT) : 0u; }
    __syncthreads();
    const unsigned nent = rt[64];
    for (unsigned i = F.tid; i < nent; i += NTHREADS) { const unsigned val = rt[128 + 2 * i], w = rt[128 + 2 * i + 1], e = w >> 16, lp = w & 0xffffu;
        list[(size_t)e * M + rt[32 + e] + lp] = (int)val; }
    __syncthreads();
}

DI void phase_ln2(const Frame& F, kargs_t a, int l) {
    const int gw = F.bid * NWAVES + F.wave, NGW = F.G * NWAVES, lane = F.lane;
    bf16_t* hb = (bf16_t*)(F.ws + WS_HB); const unsigned char* ys8 = F.ws + WS_YSLOT; const float* topw = (const float*)(F.ws + WS_TOPW);
    const float* g = a->in[I_LN2G] + l * D; const float* bb = a->in[I_LN2B] + l * D;
    f32x4 gv[4], bv[4];
#pragma unroll
    for (int j = 0; j < 4; ++j) { gv[j] = *((const f32x4*)g + lane + 64 * j); bv[j] = *((const f32x4*)bb + lane + 64 * j); }
    for (int m = gw; m < M; m += NGW) {
        const int b = m / TP, tp = m % TP; f32x4 v[4];
        if (tp < PADF) {
#pragma unroll
            for (int j = 0; j < 4; ++j) v[j] = (f32x4){0.f, 0.f, 0.f, 0.f};
            row_store_bf16(hb + (size_t)m * D, lane, v);
            { unsigned* h8r = (unsigned*)(F.ws + WS_H8 + (size_t)m * D) + lane;
#pragma unroll
              for (int j = 0; j < 4; ++j) h8r[64 * j] = 0u; }
            continue;
        }
        row_load_bf16(hb + (size_t)m * D, lane, v);
        const f32x4 w = *(const f32x4*)(topw + (size_t)m * 4);
#pragma unroll
        for (int j = 0; j < 4; ++j) v[j] = v[j] * DN_ALPHA;
#pragma unroll
        for (int k = 0; k < 4; ++k) { const unsigned* y8 = (const unsigned*)(ys8 + ((size_t)m * 4 + k) * D) + lane; const float wk = w[k] * (1.0f / YS_SCALE);
#pragma unroll
            for (int j = 0; j < 4; ++j) { const unsigned q = y8[64 * j]; const f32x2 lo = __builtin_amdgcn_cvt_pk_f32_fp8((int)q, false), hi2 = __builtin_amdgcn_cvt_pk_f32_fp8((int)q, true);
                v[j] += (f32x4){lo[0], lo[1], hi2[0], hi2[1]} * wk; } }
        float mean, rstd; ln_stats(v, mean, rstd);
#pragma unroll
        for (int j = 0; j < 4; ++j) v[j] = (v[j] - mean) * rstd * gv[j] + bv[j];
        if (l == DEPTH - 1) {
            if (tp >= PADF + NMETA) { float* orow = a->out + ((size_t)b * SEQ + (tp - PADF - NMETA)) * D;
#pragma unroll
                for (int j = 0; j < 4; ++j) *((f32x4*)orow + lane + 64 * j) = v[j]; }
        } else { row_store_bf16(hb + (size_t)m * D, lane, v);
            unsigned* h8r = (unsigned*)(F.ws + WS_H8 + (size_t)m * D) + lane;
#pragma unroll
            for (int j = 0; j < 4; ++j) h8r[64 * j] = pk4_fp8(v[j][0] * X8_SCALE, v[j][1] * X8_SCALE, v[j][2] * X8_SCALE, v[j][3] * X8_SCALE); }
    }
}

DI pg8::MoeTabs moe_tables(const Frame& F, int l) {
    LAS int* ebase = (LAS int*)(F.lds + TAB_OFF); LAS int* ecnt = ebase + 64; LAS unsigned char* tile_e = (LAS unsigned char*)(ebase + 128);
    __syncthreads();
    if (F.tid < NE) ecnt[F.tid] = (int)__hip_atomic_load(F.ctl + CW_ECNT + 2048 * l + 64 * F.tid, RLX_AGENT);
    __syncthreads();
    if (F.tid == 0) { int t = 0;
#pragma nounroll
        for (int e = 0; e < NE; ++e) { ebase[e] = t; t += (ecnt[e] + 255) >> 8; }
        ebase[32] = t; }
    __syncthreads();
    for (int t = F.tid; t < ebase[32]; t += NTHREADS) { int e = 0;
#pragma nounroll
        for (int k = 1; k < NE; ++k) e += (ebase[k] <= t) ? 1 : 0;
        tile_e[t] = (unsigned char)e; }
    __syncthreads();
    pg8::MoeTabs T; T.ebase = ebase; T.ecnt = ecnt; T.tile_e = tile_e; T.list = (const int*)(F.ws + WS_LIST); T.ntiles = ebase[32];
    return T;
}

constexpr int LA_QP = 144, LA_VP = 272;
constexpr int LA_HEAD = 64 * LA_QP * 2 + 64 * LA_VP;
constexpr int LA_BT = 2 * LA_HEAD, LA_TOT = LA_BT + 32768, LA_GA = LA_TOT + 2048, LA_ST = LA_GA + 4096, LA_WL = LA_ST + 2048;
#ifndef LA_SEC
#define LA_SEC 0
#endif
template <bool PHASE_C>
DI void linattn_phase(const Frame& F, kargs_t a, int l) {
    const int tid = F.tid, lane = F.lane, wave = F.wave, r32 = lane & 31, hi = lane >> 5;
    const bf16_t* proj = (const bf16_t*)(F.ws + WS_R1);
    LAS unsigned char* L = F.lds;
    LAS float* bT = (LAS float*)(L + LA_BT); LAS float* tot = (LAS float*)(L + LA_TOT); LAS float* gas = (LAS float*)(L + LA_GA); LAS float* stx = (LAS float*)(L + LA_ST);
    const int NU = NB * NCH * 2, USTEP = F.G >> 1;
    int hp_loaded = -1; float lg0 = 0.f, lg1 = 0.f; LAS float* wl = (LAS float*)(L + LA_WL);
    u32x4 pk[2], pq[2], pv[4]; u32x2 pga2 = (u32x2){0, 0};
#pragma unroll
    for (int i = 0; i < 2; ++i) { pk[i] = (u32x4){0, 0, 0, 0}; pq[i] = (u32x4){0, 0, 0, 0}; }
#pragma unroll
    for (int i = 0; i < 4; ++i) pv[i] = (u32x4){0, 0, 0, 0};
#define LA_LOADS(u_) do { const int hp_ = (F.bid & 1) + 2 * ((u_) / (NB * NCH)), bc_ = (u_) % (NB * NCH), c_ = bc_ % NCH, b_ = bc_ / NCH; const bool gl_ = hp_ >= 2; const int m0_ = b_ * TP + 64 * c_; \
        const int qc_ = (gl_ ? C_GQ : C_RQ) + 128 * (hp_ & 1), kc_ = (gl_ ? C_GK : C_RK) + 128 * (hp_ & 1), vc_ = (gl_ ? C_GV : C_RV) + 256 * (hp_ & 1); \
        _Pragma("unroll") for (int i = 0; i < 2; ++i) { const int task = tid + 512 * i, tok = task >> 4, cg = task & 15; pk[i] = *(const u32x4*)(proj + (size_t)(m0_ + tok) * NPROJ + kc_ + 8 * cg); \
            if (PHASE_C) pq[i] = *(const u32x4*)(proj + (size_t)(m0_ + tok) * NPROJ + qc_ + 8 * cg); } \
        _Pragma("unroll") for (int i = 0; i < 4; ++i) { const int ch = tid + 512 * i, tok = ch >> 5, cc = ch & 31; pv[i] = *(const u32x4*)(proj + (size_t)(m0_ + tok) * NPROJ + vc_ + 8 * cc); } \
        if (gl_ && tid < 256) pga2 = *(const u32x2*)(proj + (size_t)(m0_ + (tid >> 2)) * NPROJ + C_GA + 4 * (tid & 3)); } while (0)
    bf16x8 svn[4][2]; u32x2 gwn[2][4];
#define LA_S_LOADS(u_) do { if (PHASE_C) { const int hp_ = (F.bid & 1) + 2 * ((u_) / (NB * NCH)), bc_ = (u_) % (NB * NCH), c_ = bc_ % NCH, b_ = bc_ / NCH; \
        const int hlw_ = wave >> 2, eh_ = wave & 1; \
        const bf16_t* ST_ = (const bf16_t*)(F.ws + WS_ST) + ((size_t)(b_ * 8 + 2 * hp_ + hlw_) * NCH + c_) * 128 * 64; \
        _Pragma("unroll") for (int s = 0; s < 4; ++s) _Pragma("unroll") for (int mm = 0; mm < 2; ++mm) svn[s][mm] = *(const bf16x8*)(ST_ + (size_t)(32 * (2 * eh_ + mm) + r32) * 64 + 16 * s + 8 * hi); } } while (0)
#define LA_G_LOADS(u_) do { if (PHASE_C) { const int hp_ = (F.bid & 1) + 2 * ((u_) / (NB * NCH)), bc_ = (u_) % (NB * NCH), c_ = bc_ % NCH, b_ = bc_ / NCH; const int m0_ = b_ * TP + 64 * c_; \
        const int hlw_ = wave >> 2, nt_ = (wave >> 1) & 1, eh_ = wave & 1, iq_ = 32 * nt_ + r32; \
        const bf16_t* grow_ = proj + (size_t)(m0_ + iq_) * NPROJ + ((hp_ >= 2 ? C_GG : C_RG) + 256 * (hp_ & 1)) + 128 * hlw_; \
        _Pragma("unroll") for (int mm = 0; mm < 2; ++mm) _Pragma("unroll") for (int r4 = 0; r4 < 4; ++r4) gwn[mm][r4] = *(const u32x2*)(grow_ + 32 * (2 * eh_ + mm) + 8 * r4 + 4 * hi); } } while (0)
    int u = F.bid >> 1;
    if (u < NU) { LA_LOADS(u); LA_S_LOADS(u); LA_G_LOADS(u); }
    for (; u < NU; u += USTEP) {
        const int hp = (F.bid & 1) + 2 * (u / (NB * NCH)), bc = u % (NB * NCH), c = bc % NCH, b = bc / NCH;
        const bool isgla = hp >= 2; const int m0 = b * TP + 64 * c;
        const int gc0 = (isgla ? C_GG : C_RG) + 256 * (hp & 1);
        const int hlw = wave >> 2, h8 = 2 * hp + hlw;
        bf16_t* ST = (bf16_t*)(F.ws + WS_ST) + ((size_t)(b * 8 + h8) * NCH + c) * 128 * 64;
        const int nt = (wave >> 1) & 1, eh = wave & 1, iq = 32 * nt + r32;
        if (hp != hp_loaded) {
            hp_loaded = hp;
            if (isgla) { if (tid < 128) { const int gcol = 128 * (hp & 1) + tid;
#pragma unroll
                    for (int j = 0; j < 16; ++j) wl[j * 128 + tid] = a->in[I_WA2][((size_t)l * 16 + j) * 256 + gcol];
                    wl[16 * 128 + tid] = a->in[I_BA2][l * 256 + gcol]; } }
            else { lg0 = log1pf(-exp2f(-5.0f - (float)(2 * (hp & 1)))); lg1 = log1pf(-exp2f(-5.0f - (float)(2 * (hp & 1) + 1))); }
        }
        __syncthreads();
        for (int srep_ = 0; srep_ < ((LA_SEC & 1) && PHASE_C ? 2 : 1); ++srep_)
        if (isgla) {
            if (tid < 256) *(LAS f32x4*)(gas + (tid >> 2) * 16 + 4 * (tid & 3)) = (f32x4){bflo(pga2.x), bfhi(pga2.x), bflo(pga2.y), bfhi(pga2.y)};
            __syncthreads();
            const int col = tid & 127, qt = tid >> 7; float run = 0.f; float wa[16];
#pragma unroll
            for (int j = 0; j < 16; ++j) wa[j] = wl[j * 128 + col];
            const float ba = wl[16 * 128 + col];
#pragma unroll
            for (int t = 0; t < 16; ++t) { const int tok = 16 * qt + t; float x = ba;
#pragma unroll
                for (int j4 = 0; j4 < 4; ++j4) { const f32x4 gq = *(const LAS f32x4*)(gas + tok * 16 + 4 * j4); x += (gq[0] * wa[4 * j4] + gq[1] * wa[4 * j4 + 1]) + (gq[2] * wa[4 * j4 + 2] + gq[3] * wa[4 * j4 + 3]); }
                const float la = (fminf(x, 0.f) - __logf(1.0f + __expf(-fabsf(x)))) * (1.0f / 16.0f);
                run += la; bT[tok * 128 + col] = run; }
            tot[qt * 128 + col] = run;
            __syncthreads();
        }
        for (int srep_ = 0; srep_ < ((LA_SEC & 2) && PHASE_C ? 2 : 1); ++srep_)
#pragma unroll
        for (int i = 0; i < 2; ++i) {
            const int task = tid + 512 * i, tok = task >> 4, cg = task & 15, hl = cg >> 3, d0 = (8 * cg) & 63;
            float bv[8], bl[8];
            if (isgla) {
#pragma unroll
                for (int j = 0; j < 8; ++j) { const int cc = 8 * cg + j; const float t0 = tot[cc], t1 = tot[128 + cc], t2 = tot[256 + cc], t3 = tot[384 + cc]; const int qq = tok >> 4;
                    bv[j] = bT[tok * 128 + cc] + (qq > 0 ? t0 : 0.f) + (qq > 1 ? t1 : 0.f) + (qq > 2 ? t2 : 0.f); bl[j] = (t0 + t1) + (t2 + t3); }
            } else {
                const float lg = hl ? lg1 : lg0;
#pragma unroll
                for (int j = 0; j < 8; ++j) { bv[j] = (float)(tok + 1) * lg; bl[j] = 64.0f * lg; }
            }
            const u32x4 kw = pk[i];
            float kf[8] = {bflo(kw.x), bfhi(kw.x), bflo(kw.y), bfhi(kw.y), bflo(kw.z), bfhi(kw.z), bflo(kw.w), bfhi(kw.w)};
            LAS unsigned char* hb_ = L + hl * LA_HEAD;
            if (PHASE_C) {
                const u32x4 qw = pq[i];
                float qf_[8] = {bflo(qw.x), bfhi(qw.x), bflo(qw.y), bfhi(qw.y), bflo(qw.z), bfhi(qw.z), bflo(qw.w), bfhi(qw.w)};
                u32x4 qo, ko;
#pragma unroll
                for (int j = 0; j < 4; ++j) { const float e0 = fast_exp(bv[2 * j]), e1 = fast_exp(bv[2 * j + 1]);
                    qo[j] = pk2(qf_[2 * j] * e0, qf_[2 * j + 1] * e1); ko[j] = pk2(kf[2 * j] * __builtin_amdgcn_rcpf(e0), kf[2 * j + 1] * __builtin_amdgcn_rcpf(e1)); }
                *(LAS u32x4*)(hb_ + tok * LA_QP + d0 * 2) = qo; *(LAS u32x4*)(hb_ + 64 * LA_QP + tok * LA_QP + d0 * 2) = ko;
            } else {
                u32x4 ko;
#pragma unroll
                for (int j = 0; j < 4; ++j) ko[j] = pk2(kf[2 * j] * fast_exp(bl[2 * j] - bv[2 * j]), kf[2 * j + 1] * fast_exp(bl[2 * j + 1] - bv[2 * j + 1]));
                *(LAS u32x4*)(hb_ + 64 * LA_QP + tok * LA_QP + d0 * 2) = ko;
                if (tok == 63) { float* dec = (float*)(F.ws + WS_DEC) + ((size_t)(b * 8 + 2 * hp + hl) * NCH + c) * 64 + d0;
#pragma unroll
                    for (int j = 0; j < 8; ++j) dec[j] = fast_exp(bl[j]); }
            }
        }
#pragma unroll
        for (int i = 0; i < 4; ++i) { const int ch = tid + 512 * i, tok = ch >> 5, cc = ch & 31, hl = cc >> 4, e0 = (8 * cc) & 127;
            *(LAS u32x4*)(L + hl * LA_HEAD + 128 * LA_QP + tok * LA_VP + e0 * 2) = pv[i]; }
        { const int un = u + USTEP; if (un < NU) LA_LOADS(un); }
        __syncthreads();
        const LAS unsigned char* Qs = L + hlw * LA_HEAD; const LAS unsigned char* Ks = Qs + 64 * LA_QP; const LAS unsigned char* Vs = Qs + 128 * LA_QP;
        if (!PHASE_C) {
            const int mt = wave & 3; f32x16 acc[2]; acc[0] = f32x16{}; acc[1] = f32x16{};
#pragma unroll
            for (int s = 0; s < 4; ++s) { const bf16x8 av = frag_tr(Vs, LA_VP, 16 * s, 32 * mt, lane);
#pragma unroll
                for (int n2 = 0; n2 < 2; ++n2) acc[n2] = MFMA32(av, frag_tr(Ks, LA_QP, 16 * s, 32 * n2, lane), acc[n2]); }
            { LAS bf16_t* TT = (LAS bf16_t*)(L + LA_BT) + hlw * 8192;
#pragma unroll
              for (int n2 = 0; n2 < 2; ++n2)
#pragma unroll
                  for (int r = 0; r < 16; ++r) TT[(32 * mt + crow(r, hi)) * 64 + 32 * n2 + r32] = (bf16_t)f2bf(acc[n2][r]); }
            __syncthreads();
            { bf16_t* ST0 = (bf16_t*)(F.ws + WS_ST) + ((size_t)(b * 8 + 2 * hp) * NCH + c) * 128 * 64;
#pragma unroll
              for (int i = 0; i < 4; ++i) { const int ch = tid + 512 * i, hl2 = ch >> 10, off = (ch & 1023) * 8;
                  *(u32x4*)(ST0 + (size_t)hl2 * NCH * 8192 + off) = *(const LAS u32x4*)(L + LA_BT + hl2 * 16384 + off * 2); } }
        } else {
            bf16x8 qf[4]; f32x16 o[2]; f32x16 sT[2];
            for (int srep_ = 0; srep_ < ((LA_SEC & 4) ? 2 : 1); ++srep_) {
#pragma unroll
            for (int s = 0; s < 4; ++s) qf[s] = frag_row(Qs + iq * LA_QP + (16 * s + 8 * hi) * 2);
            sT[0] = f32x16{}; sT[1] = f32x16{};
#pragma unroll
            for (int jt = 0; jt < 2; ++jt) {
                if (jt <= nt) {
#pragma unroll
                    for (int s = 0; s < 4; ++s) sT[jt] = MFMA32(frag_row(Ks + (32 * jt + r32) * LA_QP + (16 * s + 8 * hi) * 2), qf[s], sT[jt]);
#pragma unroll
                    for (int r = 0; r < 16; ++r) if (32 * jt + crow(r, hi) > iq) sT[jt][r] = 0.f;
                }
            }
            o[0] = f32x16{}; o[1] = f32x16{};
#pragma unroll
            for (int jt = 0; jt < 2; ++jt)
#pragma unroll
                for (int s2 = 0; s2 < 2; ++s2) { const bf16x8 pf = pack_step(sT[jt], s2);
#pragma unroll
                    for (int mm = 0; mm < 2; ++mm) o[mm] = MFMA32(frag_tr_perm(Vs, LA_VP, 32 * jt + 16 * s2, 32 * (2 * eh + mm), lane), pf, o[mm]); }
#pragma unroll
            for (int s = 0; s < 4; ++s)
#pragma unroll
                for (int mm = 0; mm < 2; ++mm) o[mm] = MFMA32(svn[s][mm], qf[s], o[mm]);
            }
            { const int un = u + USTEP; if (un < NU) LA_S_LOADS(un); }
            float s1 = 0.f, s2 = 0.f;
#pragma unroll
            for (int mm = 0; mm < 2; ++mm)
#pragma unroll
                for (int r = 0; r < 16; ++r) { s1 += o[mm][r]; s2 += o[mm][r] * o[mm][r]; }
            s1 = sum_x32(s1); s2 = sum_x32(s2);
            LAS float* sx = stx + ((hlw * 2 + nt) * 2) * 64;
            if (hi == 0) { sx[eh * 64 + r32 * 2] = s1; sx[eh * 64 + r32 * 2 + 1] = s2; }
            __syncthreads();
            const float t1 = sx[r32 * 2] + sx[64 + r32 * 2], t2 = sx[r32 * 2 + 1] + sx[64 + r32 * 2 + 1];
            float mean = 0.f, rstd;
            if (isgla) rstd = 1.0f / sqrtf(t2 * (1.0f / 128.0f) + 1e-6f);
            else { mean = t1 * (1.0f / 128.0f); rstd = 1.0f / sqrtf(fmaxf(t2 * (1.0f / 128.0f) - mean * mean, 0.f) + 1e-5f); }
            unsigned char* yrow = F.ws + WS_YS + (size_t)(m0 + iq) * 2048 + (isgla ? 1536 : 0) + 256 * (hp & 1) + 128 * hlw;
            for (int srep_ = 0; srep_ < ((LA_SEC & 8) ? 2 : 1); ++srep_)
#pragma unroll
            for (int mm = 0; mm < 2; ++mm)
#pragma unroll
                for (int r4 = 0; r4 < 4; ++r4) { const int e = 32 * (2 * eh + mm) + 8 * r4 + 4 * hi;
                    const u32x2 gw_ = gwn[mm][r4]; const float gf[4] = {bflo(gw_.x), bfhi(gw_.x), bflo(gw_.y), bfhi(gw_.y)}; float y[4];
#pragma unroll
                    for (int j = 0; j < 4; ++j) { const float gsw = gf[j] * fast_sigmoid(gf[j]); y[j] = (o[mm][4 * r4 + j] - mean) * rstd * gsw; }
                    *(unsigned*)(yrow + e) = pk4_fp8(y[0] * YB_SCALE, y[1] * YB_SCALE, y[2] * YB_SCALE, y[3] * YB_SCALE); }
            { const int un = u + USTEP; if (un < NU) LA_G_LOADS(un); }
        }
    }
#undef LA_LOADS
#undef LA_S_LOADS
#undef LA_G_LOADS
    __syncthreads();
}

DI void linattn_scan_unit(const Frame& F, int unit) {
    const int eg = unit & 3, bh = unit >> 2; const int e = 32 * eg + (F.tid >> 4), d = 4 * (F.tid & 15);
    bf16_t* ST = (bf16_t*)(F.ws + WS_ST) + (size_t)bh * NCH * 128 * 64 + (size_t)e * 64 + d; const float* dec = (const float*)(F.ws + WS_DEC) + (size_t)bh * NCH * 64 + d;
    float s[4] = {0.f, 0.f, 0.f, 0.f};
    constexpr int SD = 12; static_assert(NCH % SD == 0, "scan depth");
    for (int c0 = 0; c0 < NCH; c0 += SD) {
        u32x2 kv[SD]; f32x4 dc[SD];
#pragma unroll
        for (int i = 0; i < SD; ++i) { kv[i] = *(const u32x2*)(ST + (size_t)(c0 + i) * 8192); dc[i] = *(const f32x4*)(dec + (size_t)(c0 + i) * 64); }
#pragma unroll
        for (int i = 0; i < SD; ++i) {
            *(u32x2*)(ST + (size_t)(c0 + i) * 8192) = (u32x2){pk2(s[0], s[1]), pk2(s[2], s[3])};
            s[0] = dc[i][0] * s[0] + bflo(kv[i].x); s[1] = dc[i][1] * s[1] + bfhi(kv[i].x); s[2] = dc[i][2] * s[2] + bflo(kv[i].y); s[3] = dc[i][3] * s[3] + bfhi(kv[i].y); }
    }
}

DI float gelu_tanh(float x) { const float z = 0.7978845608028654f * (x + 0.044715f * x * x * x); const float t = 1.0f - 2.0f * __builtin_amdgcn_rcpf(__builtin_amdgcn_exp2f(2.0f * LOG2E * z) + 1.0f); return 0.5f * x * (1.0f + t); }
constexpr int LRU_XP = 144;
constexpr int LRU_G = 64 * LRU_XP, LRU_EX = LRU_G + 32768, LRU_IN = LRU_EX + 4096, LRU_INB = 67 * 128 + 64 * 128, LRU_Y = LRU_IN + 2 * LRU_INB;
template <bool PHASE_C>
DI void lru_phase(const Frame& F, kargs_t a, int l) {
    const int tid = F.tid, lane = F.lane, wave = F.wave, r32 = lane & 31, hi = lane >> 5;
    const bf16_t* proj = (const bf16_t*)(F.ws + WS_R1);
    LAS unsigned char* Xs = F.lds; LAS float* G = (LAS float*)(F.lds + LRU_G); LAS float* ex = (LAS float*)(F.lds + LRU_EX);
    const int d = tid & 63, g = tid >> 6;
    const int NU = NB * NCH * 8;
    int n_loaded = -1;
    bf16x8 bw[4] = {}; float gbias = 0.f, w0 = 0.f, w1 = 0.f, w2 = 0.f, w3 = 0.f, cb = 0.f, sp = 0.f;
    const int mt = wave >> 2, ntile = wave & 3, type = ntile >> 1, dcol = 32 * (ntile & 1) + r32;
    const int crow_ = tid >> 3, ccol = tid & 7;
    u32x4 px0 = (u32x4){0, 0, 0, 0}, px1 = (u32x4){0, 0, 0, 0}, pg = (u32x4){0, 0, 0, 0}; float hpre = 0.f;
#define LRU_LOADS(u_) do { const int n_ = (u_) & 7, bc_ = (u_) >> 3, c_ = bc_ % NCH, b_ = bc_ / NCH; const int m0_ = b_ * TP + 64 * c_; \
        { const int t_ = crow_ - 3; px0 = (64 * c_ + t_ >= 0) ? *(const u32x4*)(proj + (size_t)(m0_ + t_) * NPROJ + C_LX + 64 * n_ + 8 * ccol) : (u32x4){0, 0, 0, 0}; } \
        if (tid < 24) px1 = *(const u32x4*)(proj + (size_t)(m0_ + 61 + crow_) * NPROJ + C_LX + 64 * n_ + 8 * ccol); \
        if (PHASE_C) { pg = *(const u32x4*)(proj + (size_t)(m0_ + crow_) * NPROJ + C_LG + 64 * n_ + 8 * ccol); \
            hpre = ((const float*)(F.ws + WS_LRUH))[((size_t)b_ * NCH + c_) * 512 + 64 * n_ + d]; } } while (0)
#define LRU_PUT(buf_) do { LAS unsigned char* T_ = F.lds + LRU_IN + (buf_) * LRU_INB; *(LAS u32x4*)(T_ + crow_ * 128 + ccol * 16) = px0; if (tid < 24) *(LAS u32x4*)(T_ + (64 + crow_) * 128 + ccol * 16) = px1; \
        if (PHASE_C) *(LAS u32x4*)(T_ + 67 * 128 + crow_ * 128 + ccol * 16) = pg; } while (0)
    int u = F.bid, buf = 0;
    __syncthreads();
    if (u < NU) { LRU_LOADS(u); LRU_PUT(0); }
    float hin = hpre;
    __syncthreads();
    for (; u < NU; u += F.G) {
        const int n = u & 7, bc = u >> 3, c = bc % NCH, b = bc / NCH; const int m0 = b * TP + 64 * c, ch0 = 64 * n, ch = ch0 + d;
        const int un = u + F.G;
        if (un < NU) LRU_LOADS(un);
        if (n != n_loaded) {
            n_loaded = n;
            const float* cw = a->in[I_CONVW] + (size_t)l * 4 * 512 + ch; w0 = cw[0]; w1 = cw[512]; w2 = cw[1024]; w3 = cw[1536]; cb = a->in[I_CONVB][l * 512 + ch];
            const float lam = a->in[I_LAM][l * 512 + ch]; sp = fmaxf(-lam, 0.f) + __logf(1.0f + __expf(-fabsf(lam)));
            const float* W = (type ? a->in[I_WLX] : a->in[I_WLA]) + ((size_t)(l * 8 + n) * 64) * 64 + dcol; gbias = (type ? a->in[I_BLX] : a->in[I_BLA])[l * 512 + ch0 + dcol];
#pragma unroll
            for (int s = 0; s < 4; ++s) { u32x4 p;
#pragma unroll
                for (int j = 0; j < 4; ++j) p[j] = pk2(W[(size_t)(16 * s + 8 * hi + 2 * j) * 64], W[(size_t)(16 * s + 8 * hi + 2 * j + 1) * 64]);
                bw[s] = __builtin_bit_cast(bf16x8, p); }
        }
        const LAS bf16_t* XT = (const LAS bf16_t*)(F.lds + LRU_IN + buf * LRU_INB); const LAS bf16_t* GT = XT + 67 * 64;
        float xv[8], gb[8];
        { float x[11];
#pragma unroll
          for (int i = 0; i < 11; ++i) x[i] = bf2f(XT[(8 * g + i) * 64 + d]);
#pragma unroll
          for (int i = 0; i < 8; ++i) { xv[i] = cb + (w0 * x[i] + w1 * x[i + 1]) + (w2 * x[i + 2] + w3 * x[i + 3]);
              *(LAS bf16_t*)(Xs + (8 * g + i) * LRU_XP + d * 2) = (bf16_t)f2bf(xv[i]); }
          if (PHASE_C) {
#pragma unroll
              for (int i = 0; i < 8; ++i) gb[i] = bf2f(GT[(8 * g + i) * 64 + d]); }
        }
        __syncthreads();
        { f32x16 acc = f32x16{};
#pragma unroll
          for (int s = 0; s < 4; ++s) acc = MFMA32(frag_row(Xs + (32 * mt + r32) * LRU_XP + (16 * s + 8 * hi) * 2), bw[s], acc);
#pragma unroll
          for (int r = 0; r < 16; ++r) G[(type * 64 + 32 * mt + crow(r, hi)) * 64 + dcol] = fast_sigmoid(acc[r] + gbias); }
        __syncthreads();
        float av[8], uv[8]; float Aloc = 1.f, hloc = 0.f;
#pragma unroll
        for (int i = 0; i < 8; ++i) { const int t = 8 * g + i; const float r = G[t * 64 + d], ig = G[(64 + t) * 64 + d];
            const float la = -8.0f * r * sp; float av_ = fast_exp(la); float uv_ = sqrtf(fmaxf(1.0f - av_ * av_, 0.f)) * ig * xv[i];
            if (64 * c + t < PADF) { av_ = 1.f; uv_ = 0.f; }
            av[i] = av_; uv[i] = uv_; Aloc *= av_; hloc = av_ * hloc + uv_; }
        ex[(g * 64 + d) * 2] = Aloc; ex[(g * 64 + d) * 2 + 1] = hloc;
        if (un < NU) LRU_PUT(buf ^ 1);
        __syncthreads();
        float h = PHASE_C ? hin : 0.f; float Ap = 1.f;
#pragma unroll
        for (int gg = 0; gg < 8; ++gg) if (gg < g) { const float A_ = ex[(gg * 64 + d) * 2], H_ = ex[(gg * 64 + d) * 2 + 1]; h = A_ * h + H_; Ap *= A_; }
        if (!PHASE_C) { if (g == 7) { ((float*)(F.ws + WS_LRUA))[((size_t)b * NCH + c) * 512 + ch] = Ap * Aloc; ((float*)(F.ws + WS_LRUH))[((size_t)b * NCH + c) * 512 + ch] = Aloc * h + hloc; } }
        else {
            LAS unsigned char* YT = F.lds + LRU_Y;
#pragma unroll
            for (int i = 0; i < 8; ++i) { const int t = 8 * g + i; h = av[i] * h + uv[i]; YT[t * 64 + d] = (unsigned char)(pk4_fp8(h * gelu_tanh(gb[i]) * YB_SCALE, 0.f, 0.f, 0.f) & 0xffu); }
            __syncthreads();
            *(u32x2*)(F.ws + WS_YS + (size_t)(m0 + crow_) * 2048 + 1024 + ch0 + 8 * ccol) = *(const LAS u32x2*)(F.lds + LRU_Y + crow_ * 64 + ccol * 8);
        }
        hin = hpre; buf ^= 1;
    }
#undef LRU_LOADS
#undef LRU_PUT
    __syncthreads();
}
DI void lru_scan_unit(const Frame& F, int b) {
    float* LA = (float*)(F.ws + WS_LRUA) + (size_t)b * NCH * 512 + F.tid; float* LH = (float*)(F.ws + WS_LRUH) + (size_t)b * NCH * 512 + F.tid;
    float h = 0.f;
    constexpr int SD = 12;
    for (int c0 = 0; c0 < NCH; c0 += SD) { float A_[SD], H_[SD];
#pragma unroll
        for (int i = 0; i < SD; ++i) { A_[i] = LA[(size_t)(c0 + i) * 512]; H_[i] = LH[(size_t)(c0 + i) * 512]; }
#pragma unroll
        for (int i = 0; i < SD; ++i) { LH[(size_t)(c0 + i) * 512] = h; h = A_[i] * h + H_[i]; } }
}

constexpr int AT_KP = 208, AT_VP = 144;
constexpr int AT_KB = 64 * AT_KP, AT_VB = 64 * AT_VP, AT_VOFF = 2 * AT_KB;
DI void attn_unit(const Frame& F, int b, int hd, int qb) {
    const int tid = F.tid, lane = F.lane, wave = F.wave, r32 = lane & 31, hi = lane >> 5;
    const bf16_t* proj = (const bf16_t*)(F.ws + WS_R1); const bf16_t* qg = (const bf16_t*)(F.ws + WS_Q); const bf16_t* kvg = (const bf16_t*)(F.ws + WS_KV);
    LAS unsigned char* L = F.lds;
    const int tq = 256 * qb + 32 * wave + r32; const size_t mq = (size_t)b * TP + tq;
    bf16x8 qf[6];
#pragma unroll
    for (int s = 0; s < 6; ++s) qf[s] = *(const bf16x8*)(qg + mq * 768 + hd * 96 + 16 * s + 8 * hi);
    const bf16_t* src[3]; int dst[3];
#pragma unroll
    for (int i = 0; i < 3; ++i) { const int id = tid + 512 * i;
        if (id < 768) { const int key = id / 12, cc = id % 12; src[i] = cc < 8 ? kvg + (size_t)key * 1024 + hd * 64 + 8 * cc : proj + (size_t)key * NPROJ + C_KR + 8 * (cc - 8); dst[i] = key * AT_KP + cc * 16; }
        else { const int v = id - 768, key = v >> 3, cc = v & 7; src[i] = kvg + (size_t)key * 1024 + 512 + hd * 64 + 8 * cc; dst[i] = AT_VOFF + key * AT_VP + cc * 16; } }
    const bool third = tid < 256;
    const bool rope0 = (tid < 768) && ((tid % 12) >= 8), rope1 = (tid + 512 < 768) && (((tid + 512) % 12) >= 8);
#define AT_GL(i, kt, isrope) (*(const u32x4*)(src[i] + ((size_t)b * TP + 64 * (kt)) * ((isrope) ? (size_t)NPROJ : (size_t)1024)))
    const int kt0 = 3, kt1 = 4 * qb + 3;
    __syncthreads();
    u32x4 st0 = AT_GL(0, kt0, rope0), st1 = AT_GL(1, kt0, rope1), st2 = third ? AT_GL(2, kt0, false) : (u32x4){0, 0, 0, 0};
    *(LAS u32x4*)(L + dst[0]) = st0; *(LAS u32x4*)(L + dst[1]) = st1; if (third) *(LAS u32x4*)(L + dst[2]) = st2;
    __syncthreads();
    f32x16 o[2]; o[0] = f32x16{}; o[1] = f32x16{};
    constexpr float ATT_THR = 8.0f;
    float mref = 0.f, lrun = 0.f; f32x16 negm = f32x16{};
    for (int kt = kt0; kt <= kt1; ++kt) {
        const int cur = (kt - kt0) & 1; const bool more = kt < kt1;
        if (more) { st0 = AT_GL(0, kt + 1, rope0); st1 = AT_GL(1, kt + 1, rope1); if (third) st2 = AT_GL(2, kt + 1, false); }
        const LAS unsigned char* Kb = L + cur * AT_KB; const LAS unsigned char* Vb = L + AT_VOFF + cur * AT_VB;
        f32x16 p[2];
#pragma unroll
        for (int sub = 0; sub < 2; ++sub) { p[sub] = MFMA32(frag_row(Kb + (32 * sub + r32) * AT_KP + (8 * hi) * 2), qf[0], negm);
#pragma unroll
            for (int s = 1; s < 6; ++s) p[sub] = MFMA32(frag_row(Kb + (32 * sub + r32) * AT_KP + (16 * s + 8 * hi) * 2), qf[s], p[sub]); }
        if (kt == kt0 || kt >= 4 * qb) {
#pragma unroll
            for (int sub = 0; sub < 2; ++sub)
#pragma unroll
                for (int r = 0; r < 16; ++r) { const int key = 64 * kt + 32 * sub + crow(r, hi); if (key > tq || key < PADF) p[sub][r] = -1.0e30f; }
        }
        float mx = fmaxf(p[0][0], p[1][0]);
#pragma unroll
        for (int r = 1; r < 16; ++r) mx = fmaxf(fmaxf(mx, p[0][r]), p[1][r]);
        mx = max_x32(mx);
        if (kt == kt0 || __any(mx > ATT_THR)) {
            const float delta = (kt == kt0) ? mx : fmaxf(mx, 0.f);
            const float fac = (kt == kt0) ? 0.f : __builtin_amdgcn_exp2f(-delta);
            mref += delta; lrun *= fac;
#pragma unroll
            for (int dv = 0; dv < 2; ++dv) o[dv] = o[dv] * fac;
#pragma unroll
            for (int sub = 0; sub < 2; ++sub)
#pragma unroll
                for (int r = 0; r < 16; ++r) p[sub][r] -= delta;
#pragma unroll
            for (int r = 0; r < 16; ++r) negm[r] = -mref;
        }
        float ps = 0.f;
#pragma unroll
        for (int sub = 0; sub < 2; ++sub)
#pragma unroll
            for (int r = 0; r < 16; ++r) { p[sub][r] = __builtin_amdgcn_exp2f(p[sub][r]); ps += p[sub][r]; }
        lrun += ps;
#pragma unroll
        for (int sub = 0; sub < 2; ++sub)
#pragma unroll
            for (int s2 = 0; s2 < 2; ++s2) { const bf16x8 pf = pack_step(p[sub], s2);
#pragma unroll
                for (int dv = 0; dv < 2; ++dv) o[dv] = MFMA32(frag_tr_perm(Vb, AT_VP, 32 * sub + 16 * s2, 32 * dv, lane), pf, o[dv]); }
        if (more) { const int nb = cur ^ 1;
            const int d0 = dst[0] + (dst[0] >= AT_VOFF ? nb * AT_VB : nb * AT_KB), d1 = dst[1] + (dst[1] >= AT_VOFF ? nb * AT_VB : nb * AT_KB), d2 = dst[2] + (dst[2] >= AT_VOFF ? nb * AT_VB : nb * AT_KB);
            *(LAS u32x4*)(L + d0) = st0; *(LAS u32x4*)(L + d1) = st1; if (third) *(LAS u32x4*)(L + d2) = st2; }
        __syncthreads();
    }
    lrun = sum_x32(lrun);
    const float inv = 1.0f / lrun;
    unsigned char* yrow = F.ws + WS_YS + mq * 2048 + 512 + hd * 64;
#pragma unroll
    for (int dv = 0; dv < 2; ++dv)
#pragma unroll
        for (int r4 = 0; r4 < 4; ++r4) { const int e = 32 * dv + 8 * r4 + 4 * hi;
            const float iv = inv * YB_SCALE; *(unsigned*)(yrow + e) = pk4_fp8(o[dv][4 * r4] * iv, o[dv][4 * r4 + 1] * iv, o[dv][4 * r4 + 2] * iv, o[dv][4 * r4 + 3] * iv); }
}
#ifdef CONV_TWICE
#define CONV_AGAIN(l_) { asm volatile("" ::: "memory"); phase_convert(F, get_args(), l_); }
#else
#define CONV_AGAIN(l_)
#endif
#ifndef MK_PER_PHASE
#define MK_PER_PHASE 0
#endif
constexpr int NPH_L = 12, NPHASES = 1 + DEPTH * NPH_L;
constexpr int ATT_UNITS = (TP / 256) * NB * 8;

DI int lane_id_volatile() { int r; asm volatile("v_mbcnt_lo_u32_b32 %0, -1, 0\n\tv_mbcnt_hi_u32_b32 %0, -1, %0" : "=v"(r)); return r; }
__global__ void __launch_bounds__(NTHREADS, 2) trunk_fwd(KArgs args) {
    extern __shared__ __attribute__((aligned(16))) unsigned char lds_raw[];
    Frame F;
    F.lds = (LAS unsigned char*)lds_raw; F.ws = nullptr; F.ctl = nullptr;
    const int wave0 = __builtin_amdgcn_readfirstlane((int)threadIdx.x >> 6);
#define MYTID() (wave0 * 64 + lane_id_volatile())
    F.tid = MYTID(); F.lane = F.tid & 63; F.wave = wave0; F.G = gridDim.x; F.bid = blockIdx.x;
    volatile LAS unsigned* MISC = (volatile LAS unsigned*)(F.lds + MISC_OFF);
    if (F.tid < 64) MISC[F.tid] = 0u;
    __syncthreads();
    XcdBarrier bar; bar.bar = (unsigned*)(args.ws + WS_CTL) + CW_BAR; bar.x = 0; bar.st = nullptr;
    const int lo = args.ph_lo, hi = args.ph_hi;
    if (hi - lo > 1) bar = xcd_barrier_post((unsigned*)(args.ws + WS_CTL) + CW_BAR, MISC + 8, F.tid);
#ifndef PH_MASK
#define PH_MASK 0xFFFFFFFFu
#endif
#define EN(kk) (((PH_MASK) >> (kk)) & 1u)
#define IN(k) (lo <= (k) && (k) < hi)
#define SEAM(k) do { if (IN(k) && IN((k) + 1)) xcd_barrier(bar, MYTID()); } while (0)
#define PHASE_BEGIN kargs_t A = get_args(); unsigned char* ws = A->ws; F.ws = ws; F.ctl = (gu32*)(ws + WS_CTL); \
    { int t_ = MYTID(); asm volatile("" : "+v"(t_)); F.tid = t_; F.lane = t_ & 63; F.wave = __builtin_amdgcn_readfirstlane(t_ >> 6); int b_ = blockIdx.x, g_ = gridDim.x; asm volatile("" : "+s"(b_), "+s"(g_)); F.bid = b_; F.G = g_; } \
    bf16_t* hb = (bf16_t*)(ws + WS_HB); bf16_t* proj = (bf16_t*)(ws + WS_R1); \
    const float* tabR = (const float*)(ws + WS_TABR); const float* tabM = (const float*)(ws + WS_TABM); float* ssq = (float*)(ws + WS_SSQ); \
    (void)hb; (void)proj; (void)tabR; (void)tabM; (void)ssq;

    if (EN(12) && IN(0)) { PHASE_BEGIN phase_convert(F, A, 0); CONV_AGAIN(0) phase_ln0(F, A); }
    SEAM(0);
#define PH0(l, P, QSEL) \
        if (EN(0) && IN(P + 0)) { }
#define PH1(l, P, QSEL) \
        if (EN(1) && IN(P + 1)) { PHASE_BEGIN \
            pg8::Gemm g{hb, (const bf16_t*)(ws + W_IN), D, D, D, 0, 0}; pg8::StaticOrder S; S.init(M, NPROJ, F.G, F.bid); \
            pg8::EpiProj E{proj, tabR, tabM, ssq}; \
            pg8::gemm_phase<pg8::EpiProj, pg8::StaticOrder, true>(F.lds, F.tid, g, S, E); \
        }
#define PH2(l, P, QSEL) \
        if (EN(2) && IN(P + 2)) { PHASE_BEGIN \
            if (EN(13)) { pg8::Gemm g{proj + C_CQ, (const bf16_t*)(ws + W_UQ), NPROJ, 256, 256, 0, 0}; pg8::StaticOrder S; S.init(M, 768, F.G, F.bid); \
              pg8::EpiQ E{(bf16_t*)(ws + WS_Q), tabM, ssq}; \
              pg8::gemm_phase<pg8::EpiQ, pg8::StaticOrder, true>(F.lds, F.tid, g, S, E); } \
            if (EN(14)) { pg8::Gemm g{proj + C_CKV, (const bf16_t*)(ws + W_UKV), NPROJ, 128, 128, 0, 0}; pg8::StaticOrder S; S.init(M, 1024, F.G, (F.bid + 140) % F.G); \
              pg8::EpiKV E{(bf16_t*)(ws + WS_KV), ssq}; \
              pg8::gemm_phase<pg8::EpiKV, pg8::StaticOrder, true>(F.lds, F.tid, g, S, E); } \
            { Frame F2 = F; F2.bid = (F.bid + 156) % F.G; if (EN(15)) linattn_phase<false>(F2, A, l); if constexpr (REP(15)) linattn_phase<false>(F2, A, l); } \
            { Frame F2 = F; F2.bid = (F.bid + 220) % F.G; if (EN(16)) lru_phase<false>(F2, A, l); if constexpr (REP(16)) lru_phase<false>(F2, A, l); } \
        }
#define PH3(l, P, QSEL) \
        if (EN(3) && IN(P + 3)) { PHASE_BEGIN \
            if (QSEL == 0) for (int u = F.bid; u < 128 + NB; u += F.G) { if (u < 128) linattn_scan_unit(F, u); else lru_scan_unit(F, u - 128); } \
            for (;;) { \
                __syncthreads(); \
                if (F.tid == 0) MISC[0] = __hip_atomic_fetch_add(F.ctl + CW_QUEUE + 64 * (l + 2 * QSEL), 1u, RLX_AGENT); \
                __syncthreads(); \
                const int u = (int)MISC[0]; \
                if (u >= ATT_UNITS) break; \
                const int qb = (TP / 256 - 1) - u / 32, bh = u % 32; \
                attn_unit(F, bh >> 3, bh & 7, qb); \
            } \
        }
#define PH4(l, P, QSEL) \
        if (EN(4) && IN(P + 4)) { PHASE_BEGIN \
            linattn_phase<true>(F, A, l); if constexpr (REP(17)) linattn_phase<true>(F, A, l); \
            { Frame F2 = F; F2.bid = (F.bid + 128) % F.G; lru_phase<true>(F2, A, l); if constexpr (REP(18)) lru_phase<true>(F2, A, l); } \
        }
#define PH5(l, P, QSEL) \
        if (EN(5) && IN(P + 5)) { PHASE_BEGIN \
            pg8::Gemm g{ws + WS_H8, ws + W_MG, D, D, D, 0, 0}; pg8::TokenOrder S; S.init(M, 4096, F.G, F.bid); \
            pg8::EpiGate E{(unsigned char*)proj, A->in[I_BMERGE] + (size_t)l * 4096}; \
            meta_gates(F, (unsigned char*)proj, A->in[I_BMERGE] + (size_t)l * 4096); \
            pg8::gemm_phase<pg8::EpiGate, pg8::TokenOrder, true, true>(F.lds, F.tid, g, S, E); \
        }
#define PH6(l, P, QSEL) \
        if (EN(6) && IN(P + 6)) { PHASE_BEGIN \
            pg8::Gemm g{ws + WS_YS, ws + W_BR, 2048, 512, 512, 512, (long)D * 512}; pg8::BatchedOrder<4, pg8::TokenOrder> S; S.init(M, D, F.G, F.bid); \
            pg8::EpiBranch E{(bf16_t*)(ws + WS_MIX), (const unsigned char*)proj}; \
            meta_branch(F, (const unsigned char*)proj); \
            pg8::gemm_phase<pg8::EpiBranch, pg8::BatchedOrder<4, pg8::TokenOrder>, true, true>(F.lds, F.tid, g, S, E); \
        }
#define PH7(l, P, QSEL) \
        if (EN(7) && IN(P + 7)) { PHASE_BEGIN \
            pg8::Gemm g{(const bf16_t*)(ws + WS_MIX), (const bf16_t*)(ws + W_OUT), D, D, D, 0, 0}; pg8::TokenOrder S; S.init(M, D, F.G, F.bid); \
            pg8::EpiOut E{hb}; \
            meta_out(F, hb); \
            pg8::gemm_phase<pg8::EpiOut, pg8::TokenOrder, true>(F.lds, F.tid, g, S, E); \
        }
#define PH8(l, P, QSEL) \
        if (EN(8) && IN(P + 8)) { PHASE_BEGIN phase_ln1(F, A, l); }
#define PH9(l, P, QSEL) \
        if (EN(9) && IN(P + 9)) { PHASE_BEGIN \
            const pg8::MoeTabs T = moe_tables(F, l); \
            pg8::Gemm g{ws + WS_X8, ws + W_GU, D, D, D, 0, (long)2048 * D}; pg8::MoeOrder<8, true> S{T, F.G, F.bid}; \
            pg8::EpiSwiglu E{ws + WS_R1, A->in[I_BEG] + (size_t)l * NE * DE, A->in[I_BEU] + (size_t)l * NE * DE}; \
            pg8::gemm_phase<pg8::EpiSwiglu, pg8::MoeOrder<8, true>, true, true>(F.lds, F.tid, g, S, E); \
        }
#define PH10(l, P, QSEL) \
        if (EN(10) && IN(P + 10)) { PHASE_BEGIN \
            const pg8::MoeTabs T = moe_tables(F, l); \
            pg8::Gemm g{ws + WS_R1, ws + W_DN, DE, DE, DE, 0, (long)D * DE}; pg8::MoeOrder<4, false> S{T, F.G, F.bid}; \
            pg8::EpiDown E{ws + WS_YSLOT, A->in[I_BED] + (size_t)l * NE * D, T}; \
            pg8::gemm_phase<pg8::EpiDown, pg8::MoeOrder<4, false>, true, true>(F.lds, F.tid, g, S, E); \
        }
#define PH11(l, P, QSEL) \
        if (EN(11) && IN(P + 11)) { PHASE_BEGIN if (l + 1 < DEPTH) { phase_convert(F, A, l + 1); CONV_AGAIN(l + 1) } phase_ln2(F, A, l); }
#ifndef REP_MASK
#define REP_MASK 0u
#endif
#define REP(k) (((REP_MASK) >> (k)) & 1u)
#define LAYER_BODY(l) { constexpr int P = 1 + (l) * NPH_L; \
    PH0(l, P, 0) if constexpr (REP(0)) { PH0(l, P, 1) } \
    PH1(l, P, 0) if constexpr (REP(1)) { PH1(l, P, 1) } \
    SEAM(P + 1); \
    PH2(l, P, 0) if constexpr (REP(2)) { PH2(l, P, 1) } \
    SEAM(P + 2); \
    PH3(l, P, 0) if constexpr (REP(3)) { PH3(l, P, 1) } \
    SEAM(P + 3); \
    PH4(l, P, 0) if constexpr (REP(4)) { PH4(l, P, 1) } \
    SEAM(P + 4); \
    PH5(l, P, 0) if constexpr (REP(5)) { PH5(l, P, 1) } \
    SEAM(P + 5); \
    PH6(l, P, 0) if constexpr (REP(6)) { PH6(l, P, 1) } \
    SEAM(P + 6); \
    PH7(l, P, 0) if constexpr (REP(7)) { PH7(l, P, 1) } \
    SEAM(P + 7); \
    PH8(l, P, 0) if constexpr (REP(8)) { PH8(l, P, 1) } \
    SEAM(P + 8); \
    PH9(l, P, 0) if constexpr (REP(9)) { PH9(l, P, 1) } \
    SEAM(P + 9); \
    PH10(l, P, 0) if constexpr (REP(10)) { PH10(l, P, 1) } \
    SEAM(P + 10); \
    PH11(l, P, 0) if constexpr (REP(11)) { PH11(l, P, 1) } \
    SEAM(P + 11); \
}
    { constexpr int l = 0; LAYER_BODY(l) }
    { constexpr int l = 1; LAYER_BODY(l) }
#undef LAYER_BODY
#undef IN
#undef SEAM
}

extern "C" void kernel_launch(void* const* d_in, const int* in_sizes, int n_in, void* d_out, int out_size, void* d_ws, size_t ws_size, hipStream_t stream) {
    static int grid = 0;
    if (grid == 0) {
        if (n_in != 34 || ws_size < WS_END) { fprintf(stderr, "kernel_launch: expected 34 inputs and >= %zu bytes of workspace; got %d, %zu\n", (size_t)WS_END, n_in, ws_size); grid = -1; return; }
        int dev = 0, cus = 0;
        if (hipGetDevice(&dev) != hipSuccess || hipDeviceGetAttribute(&cus, hipDeviceAttributeMultiprocessorCount, dev) != hipSuccess) { grid = -1; return; }
        if (hipFuncSetAttribute((const void*)trunk_fwd, hipFuncAttributeMaxDynamicSharedMemorySize, LDS_BYTES) != hipSuccess) { fprintf(stderr, "kernel_launch: hipFuncSetAttribute failed\n"); grid = -1; return; }
        int per_cu = 0;
        if (hipOccupancyMaxActiveBlocksPerMultiprocessor(&per_cu, (const void*)trunk_fwd, NTHREADS, LDS_BYTES) != hipSuccess || per_cu < 1) fprintf(stderr, "kernel_launch: occupancy query reports %d\n", per_cu);
        (void)hipGetLastError();
        grid = cus >= 256 ? 256 : (cus & ~7);
        if (grid < 8) { fprintf(stderr, "kernel_launch: %d CUs: too few\n", cus); grid = -1; return; }
    }
    if (grid < 0) return;
    (void)hipMemsetAsync((char*)d_ws + WS_CTL, 0, CTL_ZERO_BYTES, stream);
    KArgs a{};
    for (int i = 0; i < 34; ++i) a.in[i] = (const float*)d_in[i];
    a.out = (float*)d_out; a.ws = (unsigned char*)d_ws;
    for (int i = 0; i < 32; ++i) a.invR[i] = (float)pow(10000.0, -(double)(2 * i) / 64.0);
    for (int i = 0; i < 16; ++i) a.invM[i] = (float)pow(10000.0, -(double)(2 * i) / 32.0);
#if MK_PER_PHASE
    for (int p = 0; p < NPHASES; ++p) { a.ph_lo = p; a.ph_hi = p + 1; hipLaunchKernelGGL(trunk_fwd, dim3(grid), dim3(NTHREADS), LDS_BYTES, stream, a); }
#else
    a.ph_lo = 0; a.ph_hi = NPHASES;
    hipLaunchKernelGGL(trunk_fwd, dim3(grid), dim3(NTHREADS), LDS_BYTES, stream, a);
#endif
}
```

```cpp
#include <hip/hip_runtime.h>
#include <cstdio>
#include <cstdint>
#include <cmath>

#define LAS __attribute__((address_space(3)))
#define GAS __attribute__((address_space(1)))
typedef unsigned short bf16_t;
typedef short bf16x8 __attribute__((ext_vector_type(8)));
typedef short s16x4 __attribute__((ext_vector_type(4)));
typedef short v4i16_t __attribute__((ext_vector_type(4)));
typedef float f32x2 __attribute__((ext_vector_type(2)));
typedef float f32x4 __attribute__((ext_vector_type(4)));
typedef float f32x16 __attribute__((ext_vector_type(16)));
typedef unsigned u32x2 __attribute__((ext_vector_type(2)));
typedef unsigned u32x4 __attribute__((ext_vector_type(4)));
typedef __bf16 bf16x2_t __attribute__((ext_vector_type(2)));
typedef GAS unsigned gu32;
typedef int i32x8 __attribute__((ext_vector_type(8)));
#define DI __device__ __forceinline__
#define RLX_AGENT __ATOMIC_RELAXED, __HIP_MEMORY_SCOPE_AGENT

constexpr int NB = 4, SEQ = 8192, NMETA = 16, TT = SEQ + NMETA;
constexpr int PADF = 240, TP = PADF + TT;
constexpr int M = NB * TP;
constexpr int D = 1024, DEPTH = 2;
__device__ __forceinline__ size_t gate_addr(size_t r, int c) { return ((r >> 2) << 14) + ((size_t)(c >> 7) << 9) + (size_t)(((c >> 5) & 3) << 7) + ((r & 3) << 5) + (size_t)(c & 31); }
constexpr int NPROJ = 4608;
constexpr int C_RQ = 0, C_RK = 256, C_RV = 512, C_RG = 1024, C_CQ = 1536, C_CKV = 1792, C_KR = 1920, C_GA = 1952, C_LX = 2048, C_LG = 2560,
              C_GQ = 3072, C_GK = 3328, C_GV = 3584, C_GG = 4096;
constexpr int O_RQ = 0, O_RK = 256, O_RV = 512, O_RG = 1024, O_CQ = 1536, O_CKV = 1792, O_KR = 1920, O_LX = 1952, O_LG = 2464, O_GQ = 2976,
              O_GK = 3232, O_GV = 3488, O_GA = 4000, O_GG = 4016, D_IN = 4528;
constexpr int NE = 32, TOPK = 4, DE = 1024;
constexpr int NCH = TP / 64;
constexpr int MAXTILES = 545;
constexpr float DN_ALPHA = 1.4142135623730951f;
constexpr float LOG2E = 1.4426950408889634f;

constexpr size_t MiB = 1u << 20;
constexpr size_t WS_CTL = 0, CTL_ZERO_BYTES = 64 * 1024;
constexpr size_t WS_HB = 1 * MiB;
constexpr size_t WS_R1 = WS_HB + 66 * MiB;
constexpr size_t WS_R2 = WS_R1 + 297 * MiB;
constexpr size_t WS_YS = WS_R2;
constexpr size_t WS_Q = WS_YS + 132 * MiB;
constexpr size_t WS_KV = WS_Q + 50 * MiB;
constexpr size_t WS_MIX = WS_Q;
constexpr size_t WS_X8 = WS_R2;
constexpr size_t WS_YSLOT = WS_R2;
constexpr size_t WS_ST = WS_R2 + 264 * MiB;
constexpr size_t WS_W = WS_ST + 66 * MiB;
constexpr size_t W_IN = WS_W;
constexpr size_t W_MG = W_IN + 9 * MiB;
constexpr size_t W_BR = W_MG + 8 * MiB;
constexpr size_t W_OUT = W_BR + 4 * MiB;
constexpr size_t W_UQ = W_OUT + 2 * MiB;
constexpr size_t W_UKV = W_UQ + 512 * 1024;
constexpr size_t W_GU = W_UKV + 512 * 1024;
constexpr size_t W_DN = W_GU + 64 * MiB;
constexpr size_t WS_MISC = W_DN + 32 * MiB;
constexpr size_t WS_SSQ = WS_MISC;
constexpr size_t WS_TABR = WS_SSQ + 2 * MiB;
constexpr size_t WS_TABM = WS_TABR + 3 * MiB;
constexpr size_t WS_DEC = WS_TABM + 2 * MiB;
constexpr size_t WS_LRUA = WS_DEC + 2 * MiB;
constexpr size_t WS_LRUH = WS_LRUA + 2 * MiB;
constexpr size_t WS_TOPI = WS_LRUH + 2 * MiB;
constexpr size_t WS_TOPW = WS_TOPI + 1 * MiB;
constexpr size_t WS_LIST = WS_TOPW + 1 * MiB;
constexpr size_t WS_H8 = WS_LIST + 5 * MiB;
constexpr size_t WS_END = WS_H8 + 34 * MiB;
static_assert(WS_END <= 1024 * MiB, "workspace map exceeds 1 GiB");
static_assert((size_t)M * NPROJ * 2 <= 297 * MiB && (size_t)MAXTILES * 256 * 1024 * 2 <= 297 * MiB && (size_t)M * 4096 * 2 <= 297 * MiB, "R1");
static_assert((size_t)M * 4 * 1024 * 2 <= 264 * MiB && WS_KV + (size_t)M * 1024 * 2 <= WS_ST, "R2");
constexpr int CW_BAR = 4096;
constexpr int CW_QUEUE = 8192;
constexpr int CW_ECNT = 12288;

constexpr int RING_BYTES = 131072;
constexpr int TAB_OFF = RING_BYTES;
constexpr int MISC_OFF = RING_BYTES + 12288;
constexpr int LDS_BYTES = 147456;
constexpr int NWAVES = 8, NTHREADS = 512;

#define LDS_WAIT() asm volatile("s_waitcnt lgkmcnt(0)" ::: "memory")
#define VM_WAIT() asm volatile("s_waitcnt vmcnt(0)" ::: "memory")
DI unsigned f2bf(float f) { unsigned u = __builtin_bit_cast(unsigned, f); return (u + 0x7fffu + ((u >> 16) & 1u)) >> 16; }
DI unsigned pk2(float lo, float hi) { f32x2 v = {lo, hi}; bf16x2_t b = __builtin_convertvector(v, bf16x2_t); return __builtin_bit_cast(unsigned, b); }
DI float bf2f(unsigned short h) { return __builtin_bit_cast(float, (unsigned)h << 16); }
DI float bflo(unsigned w) { return __builtin_bit_cast(float, w << 16); }
DI float bfhi(unsigned w) { return __builtin_bit_cast(float, w & 0xffff0000u); }
DI unsigned pk4_fp8(float a, float b, float c, float d) {
    a = fminf(fmaxf(a, -448.f), 448.f); b = fminf(fmaxf(b, -448.f), 448.f); c = fminf(fmaxf(c, -448.f), 448.f); d = fminf(fmaxf(d, -448.f), 448.f);
    int w = __builtin_amdgcn_cvt_pk_fp8_f32(a, b, 0, false); w = __builtin_amdgcn_cvt_pk_fp8_f32(c, d, w, true); return (unsigned)w; }
constexpr float X8_SCALE = 16.f, WGU_SCALE = 256.f, ACT_SCALE = 4.f, WDN_SCALE = 512.f, YS_SCALE = 16.f, YB_SCALE = 16.f;
#define DPPF(v, ctrl) __builtin_bit_cast(float, __builtin_amdgcn_update_dpp(0, __builtin_bit_cast(int, (v)), (ctrl), 0xF, 0xF, true))
#define DPP_X1 0xB1
#define DPP_X2 0x4E
#define DPP_QREV 0x1B
#define DPP_HMIR 0x141
#define DPP_MIR 0x140
#define DPP_X8 0x128
DI float rdlane_f(float v, int l) { return __builtin_bit_cast(float, __builtin_amdgcn_readlane(__builtin_bit_cast(int, v), l)); }
DI float xor1_f(float v) { return DPPF(v, DPP_X1); }
DI float xor2_f(float v) { return DPPF(v, DPP_X2); }
DI float xor4_f(float v) { const float t = DPPF(v, DPP_HMIR); return DPPF(t, DPP_QREV); }
DI float xor8_f(float v) { return DPPF(v, DPP_X8); }
#define SWAP32(a_, b_) asm volatile("s_nop 1\n\tv_permlane32_swap_b32 %0, %1" : "+v"(a_), "+v"(b_))
#define SWAP16(a_, b_) asm volatile("s_nop 1\n\tv_permlane16_swap_b32 %0, %1" : "+v"(a_), "+v"(b_))
DI float xor16_f(float v, int lane) { float a_ = v, b_ = v; SWAP16(a_, b_); return (lane & 16) ? a_ : b_; }
DI float xor32_f(float v, int lane) { float a_ = v, b_ = v; SWAP32(a_, b_); return (lane & 32) ? a_ : b_; }
DI float sum_x32(float v) { float a_ = v, b_ = v; SWAP32(a_, b_); return a_ + b_; }
DI float max_x32(float v) { float a_ = v, b_ = v; SWAP32(a_, b_); return fmaxf(a_, b_); }
DI float sum_x16(float v) { float a_ = v, b_ = v; SWAP16(a_, b_); return a_ + b_; }
DI float wave_sum(float v) {
    v += DPPF(v, DPP_X1); v += DPPF(v, DPP_X2); v += DPPF(v, DPP_HMIR); v += DPPF(v, DPP_MIR);
    return (rdlane_f(v, 0) + rdlane_f(v, 16)) + (rdlane_f(v, 32) + rdlane_f(v, 48));
}
DI float wave_max(float v) {
    v = fmaxf(v, DPPF(v, DPP_X1)); v = fmaxf(v, DPPF(v, DPP_X2)); v = fmaxf(v, DPPF(v, DPP_HMIR)); v = fmaxf(v, DPPF(v, DPP_MIR));
    return fmaxf(fmaxf(rdlane_f(v, 0), rdlane_f(v, 16)), fmaxf(rdlane_f(v, 32), rdlane_f(v, 48)));
}
DI float fast_exp(float x) { return __builtin_amdgcn_exp2f(x * LOG2E); }
DI float fast_sigmoid(float x) { return __builtin_amdgcn_rcpf(1.0f + __builtin_amdgcn_exp2f(-x * LOG2E)); }
DI int crow(int r, int hi) { return (r & 3) + 8 * (r >> 2) + 4 * hi; }
#define MFMA32(a, b, c) __builtin_amdgcn_mfma_f32_32x32x16_bf16((a), (b), (c), 0, 0, 0)
DI s16x4 vtr(const LAS unsigned char* p) { return __builtin_bit_cast(s16x4, __builtin_amdgcn_ds_read_tr16_b64_v4i16((LAS v4i16_t*)p)); }
DI bf16x8 frag_row(const LAS unsigned char* p) { return *(const LAS bf16x8*)p; }
DI bf16x8 frag_tr(const LAS unsigned char* base, int pitch, int k0, int f0, int lane) {
    const int hi = lane >> 5, blk = (lane >> 4) & 1, q = (lane & 15) >> 2, p = lane & 3;
    const LAS unsigned char* a = base + (k0 + 8 * hi + q) * pitch + (f0 + 16 * blk + 4 * p) * 2;
    const s16x4 lo = vtr(a), h4 = vtr(a + 4 * pitch);
    return __builtin_shufflevector(lo, h4, 0, 1, 2, 3, 4, 5, 6, 7);
}
DI bf16x8 frag_tr_perm(const LAS unsigned char* base, int pitch, int k0, int f0, int lane) {
    const int hi = lane >> 5, blk = (lane >> 4) & 1, q = (lane & 15) >> 2, p = lane & 3;
    const LAS unsigned char* a = base + (k0 + 4 * hi + q) * pitch + (f0 + 16 * blk + 4 * p) * 2;
    const s16x4 lo = vtr(a), h4 = vtr(a + 8 * pitch);
    return __builtin_shufflevector(lo, h4, 0, 1, 2, 3, 4, 5, 6, 7);
}
DI bf16x8 pack_step(const f32x16& x, int s) {
    u32x4 p;
    p[0] = pk2(x[8 * s + 0], x[8 * s + 1]); p[1] = pk2(x[8 * s + 2], x[8 * s + 3]); p[2] = pk2(x[8 * s + 4], x[8 * s + 5]); p[3] = pk2(x[8 * s + 6], x[8 * s + 7]);
    return __builtin_bit_cast(bf16x8, p);
}

#define XB_TMO      128
#define XB_XCNT(j)  (256  + 64 * (j))
#define XB_XSUB(j)  (1280 + 64 * (j))
#define XB_XGEN(j)  (2304 + 64 * (j))
#define XB_TOP      3328
#define XB_TOPGEN   3392
#define XCD_BAR_WORDS 3456
#define XB_SPIN_CAP (1u << 22)
DI unsigned xb_ld(unsigned* p)              { return __hip_atomic_load(p, __ATOMIC_RELAXED, __HIP_MEMORY_SCOPE_AGENT); }
DI unsigned xb_add(unsigned* p, unsigned v) { return __hip_atomic_fetch_add(p, v, __ATOMIC_RELAXED, __HIP_MEMORY_SCOPE_AGENT); }
DI unsigned xb_xcc_id() { return (unsigned)__builtin_amdgcn_s_getreg((3 << 11) | 20) & 0xFu; }
#define XB_SPIN(cond, bar) do { unsigned _sp = 0; while (cond) { __builtin_amdgcn_s_sleep(1); \
    if ((++_sp & 255u) == 0u) { if (xb_ld(&(bar)[XB_TMO])) break; if (_sp > XB_SPIN_CAP) { atomicAdd(&(bar)[XB_TMO], 1u); break; } } } } while (0)
struct XcdBarrier { unsigned* bar; unsigned x; volatile LAS unsigned* st; };
DI XcdBarrier xcd_barrier_post(unsigned* bar, volatile LAS unsigned* st, int tid) {
    XcdBarrier b; b.bar = bar; b.x = xb_xcc_id(); b.st = st;
    if (tid == 0) (void)xb_add(&bar[XB_XCNT(b.x)], 1u);
    return b;
}
DI void xcd_barrier_complete(unsigned* bar, unsigned x, unsigned& nloc, unsigned& nx) {
    const unsigned G = gridDim.x * gridDim.y * gridDim.z;
    unsigned sum, cnt, mine, sp = 0u;
    for (;;) {
        sum = 0u; cnt = 0u; mine = 0u;
#pragma unroll
        for (unsigned j = 0; j < 16; ++j) { const unsigned c = xb_ld(&bar[XB_XCNT(j)]); sum += c; cnt += (c > 0u) ? 1u : 0u; }
        if (sum == G) { mine = xb_ld(&bar[XB_XCNT(x)]); break; }
        __builtin_amdgcn_s_sleep(1);
        if ((++sp & 255u) == 0u) { if (xb_ld(&bar[XB_TMO])) break; if (sp > XB_SPIN_CAP) { atomicAdd(&bar[XB_TMO], 1u); break; } }
    }
    nloc = mine > 0u ? mine : 1u; nx = cnt > 0u ? cnt : 1u;
}
DI void xcd_barrier(const XcdBarrier& b, int tid) {
    asm volatile("s_waitcnt vmcnt(0)" ::: "memory");
    __syncthreads();
    if (tid == 0) {
        unsigned* bar = b.bar; unsigned bx = b.x;
        asm volatile("" : "+s"(bar), "+s"(bx));
        __builtin_amdgcn_s_waitcnt(0);
        unsigned nloc = b.st[0], nx = b.st[1];
        if (nloc == 0u) { xcd_barrier_complete(bar, bx, nloc, nx); b.st[0] = nloc; b.st[1] = nx; }
        const unsigned old = xb_add(&bar[XB_XSUB(bx)], 1u);
        const unsigned gen = old / nloc;
        if (old + 1u == (gen + 1u) * nloc) {
            __builtin_amdgcn_fence(__ATOMIC_RELEASE, "agent");
            asm volatile("s_waitcnt vmcnt(0)" ::: "memory");
            const unsigned og = xb_add(&bar[XB_TOP], 1u);
            const unsigned tg = og / nx;
            if (og + 1u == (tg + 1u) * nx) xb_add(&bar[XB_TOPGEN], 1u);
            else XB_SPIN(xb_ld(&bar[XB_TOPGEN]) == tg, bar);
            __builtin_amdgcn_fence(__ATOMIC_ACQUIRE, "agent");
            xb_add(&bar[XB_XGEN(bx)], 1u);
            asm volatile("s_waitcnt vmcnt(0)" ::: "memory");
        } else {
            XB_SPIN(xb_ld(&bar[XB_XGEN(bx)]) == gen, bar);
            __builtin_amdgcn_fence(__ATOMIC_ACQUIRE, "agent");
            asm volatile("s_waitcnt vmcnt(0)" ::: "memory");
        }
    }
    __syncthreads();
}

namespace pg8 {
constexpr int BM = 256, BK = 64, HALF = 128, HTB = HALF * BK * 2, STAGE_BYTES = 8 * HTB, NXCD = 8, WGM = 8;
__host__ __device__ __forceinline__ int lds_byte(int r, int c) { const int st = (r >> 4) * 2 + (c >> 5), rr = r & 15, cc = c & 31, ob = rr * 64 + cc * 2; return st * 1024 + (ob ^ (((ob >> 9) & 1) << 5)); }
__host__ __device__ __forceinline__ void stage_rc(int b, int& R, int& C) { const int st = b / 1024, sb = b % 1024, swz = sb ^ (((sb >> 9) & 1) << 5); R = (st >> 1) * 16 + swz / 64; C = (st & 1) * 32 + (swz % 64) / 2; }
__host__ __device__ __forceinline__ int perm32(int rho) { const int n = rho >> 4, i = rho & 15; return 8 * (i >> 2) + 4 * n + (i & 3); }

struct Unit { int pm, pn, pb; };
struct Gemm { const void* A; const void* Bt; int lda, ldb, K; long a_pb, b_pb; };

template <bool SKIPMETA> struct StaticOrderT {
    static constexpr bool GATHER = false, KEEP = false;
    int nM, nN, nwg, G, c;
    DI void init(int M_, int N_, int G_, int c_) { nM = SKIPMETA ? NB * (TP / BM - 1) : M_ / BM; nN = N_ / BM; nwg = nM * nN; G = G_; c = c_; }
    DI bool tile(int i, int& pm, int& pn) const {
        const long L = (long)i * G + c; if (L >= nwg) return false;
        int wgid = (int)L; { const int q = nwg / NXCD, r = nwg % NXCD, xcd = wgid % NXCD, off = wgid / NXCD; wgid = (xcd < r ? xcd * (q + 1) : r * (q + 1) + (xcd - r) * q) + off; }
        const int nig = WGM * nN, gid = wgid / nig, fm = gid * WGM, gsz = (nM - fm) < WGM ? (nM - fm) : WGM;
        pm = fm + ((wgid % nig) % gsz); pn = (wgid % nig) / gsz;
        if constexpr (SKIPMETA) pm += pm / (TP / BM - 1) + 1;
        return true;
    }
    DI bool next(int i, Unit& u) const { u.pb = 0; return tile(i, u.pm, u.pn); }
    DI int arow(const Unit& u, int r) const { return u.pm * BM + r; }
};
using StaticOrder = StaticOrderT<false>;
using TokenOrder = StaticOrderT<true>;
template <int NB_, class SO = StaticOrder> struct BatchedOrder {
    static constexpr bool GATHER = false, KEEP = true;
    SO so;
    DI void init(int M_, int N_, int G_, int c_) { so.init(M_, N_, G_, c_); }
    DI bool next(int i, Unit& u) const { u.pb = i % NB_; return so.tile(i / NB_, u.pm, u.pn); }
    DI int arow(const Unit& u, int r) const { return u.pm * BM + r; }
};

template <class Epi, class Sched, bool ALIGN_EPI, bool FP8 = false>
DI void gemm_phase(LAS unsigned char* lds, const int tid, const Gemm g, const Sched& S, const Epi& E) {
    constexpr bool GATHER = Sched::GATHER; constexpr int ESZ = FP8 ? 1 : 2, BKE = 128 / ESZ;
    const int wid = __builtin_amdgcn_readfirstlane(tid >> 6), lane = tid & 63, wr = wid >> 2, wc = wid & 3, fr = lane & 15, fq = lane >> 4;
    const int K = g.K, nt = K / BKE;
    unsigned voffA[2], voffB[2];
#pragma unroll
    for (int i = 0; i < 2; ++i) { int R, C; stage_rc(tid * 16 + i * 8192, R, C); const int Rb = (R & ~31) + perm32(R & 31);
        voffA[i] = (unsigned)(R * g.lda) * (unsigned)ESZ + (unsigned)C * 2u; voffB[i] = (unsigned)(Rb * g.ldb) * (unsigned)ESZ + (unsigned)C * 2u; }
    const size_t kstep = (size_t)(BK * 2);
    const size_t hstepA = GATHER ? 0 : (size_t)HALF * g.lda * ESZ, tstepA = 2 * hstepA;
    const size_t hstepB = (size_t)HALF * g.ldb * ESZ, tstepB = 2 * hstepB;
    const unsigned ldsw = (unsigned)wid * 1024u;
    const int aoff = lds_byte(wr * 64 + fr, fq * 8), boff = lds_byte(wc * 32 + fr, fq * 8);
#define PG8_SA(b, h) (((b) * 2 + (h)) * HTB)
#define PG8_SB(b, h) ((4 + (b) * 2 + (h)) * HTB)
#define PG8_STAGE(bufoff, gbase, v0, v1) do { \
        __builtin_amdgcn_global_load_lds((const unsigned*)((const char*)(gbase) + (v0)), (LAS unsigned*)(lds + (bufoff) + ldsw), 16, 0, 0); \
        __builtin_amdgcn_global_load_lds((const unsigned*)((const char*)(gbase) + (v1)), (LAS unsigned*)(lds + (bufoff) + ldsw + 8192), 16, 0, 0); } while (0)
#define PG8_CAT(x, y) __builtin_bit_cast(i32x8, __builtin_shufflevector(x, y, 0, 1, 2, 3, 4, 5, 6, 7, 8, 9, 10, 11, 12, 13, 14, 15))
#define PG8_LDA(dst, b, h) do { _Pragma("unroll") for (int m = 0; m < 4; ++m) { _Pragma("unroll") for (int k = 0; k < 2; ++k) dst[m][k] = *(const LAS bf16x8*)(lds + PG8_SA(b, h) + aoff + m * 2048 + k * 1024); \
        if constexpr (FP8) dst##8[m] = PG8_CAT(dst[m][0], dst[m][1]); } } while (0)
#define PG8_LDB(dst, b, h) do { _Pragma("unroll") for (int n = 0; n < 2; ++n) { _Pragma("unroll") for (int k = 0; k < 2; ++k) dst[n][k] = *(const LAS bf16x8*)(lds + PG8_SB(b, h) + boff + n * 2048 + k * 1024); \
        if constexpr (FP8) dst##8[n] = PG8_CAT(dst[n][0], dst[n][1]); } } while (0)
#define PG8_MMA(ai, bj, At, Bt) do { __builtin_amdgcn_s_setprio(1); _Pragma("unroll") for (int m = 0; m < 4; ++m) _Pragma("unroll") for (int n = 0; n < 2; ++n) { \
        if constexpr (FP8) asm volatile("v_mfma_f32_16x16x128_f8f6f4 %0, %1, %2, %0" : "+v"(acc[ai][bj][m][n]) : "v"(Bt##8[n]), "v"(At##8[m])); \
        else { _Pragma("unroll") for (int k = 0; k < 2; ++k) acc[ai][bj][m][n] = __builtin_amdgcn_mfma_f32_16x16x32_bf16(Bt[n][k], At[m][k], acc[ai][bj][m][n], 0, 0, 0); } } \
        __builtin_amdgcn_s_setprio(0); } while (0)
#define PG8_WAIT_V(n) asm volatile("s_waitcnt vmcnt(" #n ")" ::: "memory")
#define PG8_WAIT_L(n) asm volatile("s_waitcnt lgkmcnt(" #n ")" ::: "memory")
#define PG8_BAR __builtin_amdgcn_s_barrier()
#define PG8_SCHED __builtin_amdgcn_sched_barrier(0)
#define PG8_VOFFS(u, v) do { if constexpr (GATHER) { _Pragma("unroll") for (int h_ = 0; h_ < 2; ++h_) _Pragma("unroll") for (int i_ = 0; i_ < 2; ++i_) { int R_, C_; stage_rc(tid * 16 + i_ * 8192, R_, C_); \
        v[h_][i_] = (unsigned)S.arow(u, h_ * HALF + R_) * (unsigned)(g.lda * ESZ) + (unsigned)C_ * 2u; } } } while (0)
#define PG8_ABASE(u) ((const char*)g.A + ((size_t)(u).pb * g.a_pb) * ESZ + (GATHER ? (size_t)0 : (size_t)(u).pm * tstepA))
#define PG8_BBASE(u) ((const char*)g.Bt + ((size_t)(u).pb * g.b_pb) * ESZ + (size_t)(u).pn * tstepB)
    Unit cur, nxt; int ui = 0;
    if (!S.next(0, cur)) return;
    f32x4 acc[2][2][4][2];
#pragma unroll
    for (int a = 0; a < 2; ++a)
#pragma unroll
        for (int b = 0; b < 2; ++b)
#pragma unroll
            for (int m = 0; m < 4; ++m)
#pragma unroll
                for (int n = 0; n < 2; ++n) acc[a][b][m][n] = (f32x4){0.f, 0.f, 0.f, 0.f};
    bf16x8 At[4][2], B0[2][2], B1[2][2];
    i32x8 At8[4], B08[2], B18[2];
    (void)At8; (void)B08; (void)B18;
    unsigned vA[2][2] = {{voffA[0], voffA[1]}, {voffA[0], voffA[1]}};
    PG8_VOFFS(cur, vA);
    const char* cA = PG8_ABASE(cur); const char* cB = PG8_BBASE(cur);
    PG8_STAGE(PG8_SB(0, 0), cB, voffB[0], voffB[1]); PG8_STAGE(PG8_SB(0, 1), cB + hstepB, voffB[0], voffB[1]);
    PG8_STAGE(PG8_SA(0, 0), cA, vA[0][0], vA[0][1]); PG8_STAGE(PG8_SA(0, 1), cA + hstepA, vA[1][0], vA[1][1]);
    if (wr == 1) PG8_BAR;
    PG8_WAIT_V(2); PG8_BAR;
    PG8_STAGE(PG8_SB(1, 0), cB + kstep, voffB[0], voffB[1]); PG8_STAGE(PG8_SA(1, 0), cA + kstep, vA[0][0], vA[0][1]); PG8_STAGE(PG8_SB(1, 1), cB + hstepB + kstep, voffB[0], voffB[1]);
    PG8_WAIT_V(6); PG8_BAR;
    for (;;) {
        const bool has_next = S.next(ui + 1, nxt);
        const char* nA = cA; const char* nB = cB;
        if (has_next) { nA = PG8_ABASE(nxt); nB = PG8_BBASE(nxt); }
#pragma nounroll
        for (int t = 0; t < nt; t += 2) {
            const bool last = (t == nt - 2);
            const char* a1 = cA + (size_t)(t + 1) * kstep;
            const char* a2 = last ? nA : cA + (size_t)(t + 2) * kstep; const char* b2 = last ? nB : cB + (size_t)(t + 2) * kstep;
            const char* a3 = a2 + kstep; const char* b3 = b2 + kstep;
            const unsigned c10 = vA[1][0], c11 = vA[1][1];
            if (last && has_next) PG8_VOFFS(nxt, vA);
            const unsigned w00 = vA[0][0], w01 = vA[0][1], w10 = vA[1][0], w11 = vA[1][1];
            PG8_LDB(B0, 0, 0); PG8_LDB(B1, 0, 1); PG8_SCHED; PG8_LDA(At, 0, 0); PG8_STAGE(PG8_SA(1, 1), a1 + hstepA, c10, c11);
            PG8_WAIT_V(8); PG8_WAIT_L(0); PG8_BAR; PG8_MMA(0, 0, At, B0); PG8_MMA(0, 1, At, B1); PG8_BAR; PG8_SCHED;
            PG8_LDA(At, 0, 1); PG8_STAGE(PG8_SB(0, 0), b2, voffB[0], voffB[1]); PG8_STAGE(PG8_SB(0, 1), b2 + hstepB, voffB[0], voffB[1]); PG8_STAGE(PG8_SA(0, 0), a2, w00, w01);
            PG8_WAIT_V(8); PG8_WAIT_L(0); PG8_BAR; PG8_MMA(1, 0, At, B0); PG8_MMA(1, 1, At, B1); PG8_BAR; PG8_SCHED;
            PG8_LDB(B0, 1, 0); PG8_LDB(B1, 1, 1); PG8_SCHED; PG8_LDA(At, 1, 0); PG8_STAGE(PG8_SA(0, 1), a2 + hstepA, w10, w11);
            PG8_WAIT_V(8); PG8_WAIT_L(0); PG8_BAR; PG8_MMA(0, 0, At, B0); PG8_MMA(0, 1, At, B1); PG8_BAR; PG8_SCHED;
            PG8_LDA(At, 1, 1); PG8_STAGE(PG8_SB(1, 0), b3, voffB[0], voffB[1]); PG8_STAGE(PG8_SB(1, 1), b3 + hstepB, voffB[0], voffB[1]); PG8_STAGE(PG8_SA(1, 0), a3, w00, w01);
            PG8_WAIT_V(8); PG8_WAIT_L(0); PG8_BAR; PG8_MMA(1, 0, At, B0); PG8_MMA(1, 1, At, B1); PG8_BAR; PG8_SCHED;
        }
        if constexpr (ALIGN_EPI) { if (wr == 0) PG8_BAR; }
        if constexpr (FP8) asm volatile("s_nop 15\n\ts_nop 15" ::: "memory");
        E(acc, cur, wr, wc, fr, fq);
        if (!has_next) break;
        if (!Sched::KEEP || nxt.pb == 0) {
#pragma unroll
        for (int a = 0; a < 2; ++a)
#pragma unroll
            for (int b = 0; b < 2; ++b)
#pragma unroll
                for (int m = 0; m < 4; ++m)
#pragma unroll
                    for (int n = 0; n < 2; ++n) acc[a][b][m][n] = (f32x4){0.f, 0.f, 0.f, 0.f};
        }
        cur = nxt; cA = nA; cB = nB; ++ui;
        if constexpr (ALIGN_EPI) { if (wr == 1) PG8_BAR; }
    }
    PG8_WAIT_V(0);
    if constexpr (!ALIGN_EPI) { if (wr == 0) PG8_BAR; }
    PG8_BAR;
#undef PG8_SA
#undef PG8_SB
#undef PG8_STAGE
#undef PG8_LDA
#undef PG8_LDB
#undef PG8_MMA
#undef PG8_CAT
#undef PG8_WAIT_V
#undef PG8_WAIT_L
#undef PG8_BAR
#undef PG8_SCHED
#undef PG8_VOFFS
#undef PG8_ABASE
#undef PG8_BBASE
}
}
namespace pg8 {
DI void store8(bf16_t* p, f32x4 v0, f32x4 v1) { u32x4 w; w.x = pk2(v0[0], v0[1]); w.y = pk2(v0[2], v0[3]); w.z = pk2(v1[0], v1[1]); w.w = pk2(v1[2], v1[3]); *(u32x4*)p = w; }
DI void load8(const bf16_t* p, f32x4& v0, f32x4& v1) { const u32x4 w = *(const u32x4*)p; v0 = (f32x4){bflo(w.x), bfhi(w.x), bflo(w.y), bfhi(w.y)}; v1 = (f32x4){bflo(w.z), bfhi(w.z), bflo(w.w), bfhi(w.w)}; }
DI void rope8(f32x4& v0, f32x4& v1, const f32x4 c, const f32x4 s) {
    const f32x4 a0 = v0, a1 = v1;
    v0[0] = a0[0] * c[0] - a0[1] * s[0]; v0[1] = a0[1] * c[0] + a0[0] * s[0];
    v0[2] = a0[2] * c[1] - a0[3] * s[1]; v0[3] = a0[3] * c[1] + a0[2] * s[1];
    v1[0] = a1[0] * c[2] - a1[1] * s[2]; v1[1] = a1[1] * c[2] + a1[0] * s[2];
    v1[2] = a1[2] * c[3] - a1[3] * s[3]; v1[3] = a1[3] * c[3] + a1[2] * s[3];
}
DI int row_pos(int row) { const int tp = row % TP; return tp >= PADF ? tp - PADF : 0; }

struct EpiProj {
    bf16_t* O; const float* tabR; const float* tabM; float* ssq;
    DI void operator()(const f32x4 (&acc)[2][2][4][2], const Unit& u, int wr, int wc, int fr, int fq) const {
        const int row0 = u.pm * BM + wr * 64 + fr, colw = u.pn * BM + wc * 32 + 8 * fq;
        const bool ropeR = u.pn < 2, ropeM = (u.pn == 7 && wc == 0);
#pragma unroll
        for (int ai = 0; ai < 2; ++ai) {
            f32x4 tc[4], ts[4];
#pragma unroll
            for (int m = 0; m < 4; ++m) { tc[m] = (f32x4){1.f, 1.f, 1.f, 1.f}; ts[m] = (f32x4){0.f, 0.f, 0.f, 0.f}; }
            if (ropeR || ropeM) {
#pragma unroll
                for (int m = 0; m < 4; ++m) { const int pos = row_pos(row0 + ai * HALF + m * 16);
                    const float* t = ropeR ? tabR + (size_t)pos * 64 + ((colw & 63) >> 1) : tabM + (size_t)pos * 32 + 4 * fq;
                    tc[m] = *(const f32x4*)t; ts[m] = *(const f32x4*)(t + (ropeR ? 32 : 16)); }
            }
#pragma unroll
            for (int m = 0; m < 4; ++m) {
                const int row = row0 + ai * HALF + m * 16;
                float sq = 0.f;
#pragma unroll
                for (int bj = 0; bj < 2; ++bj) {
                    f32x4 v0 = acc[ai][bj][m][0], v1 = acc[ai][bj][m][1]; const int col = colw + bj * HALF;
                    if (ropeR || (ropeM && bj == 1)) rope8(v0, v1, tc[m], ts[m]);
                    if (u.pn == 6 || (u.pn == 7 && bj == 0)) sq += (v0[0] * v0[0] + v0[1] * v0[1]) + (v0[2] * v0[2] + v0[3] * v0[3]) + (v1[0] * v1[0] + v1[1] * v1[1]) + (v1[2] * v1[2] + v1[3] * v1[3]);
                    store8(O + (size_t)row * NPROJ + col, v0, v1);
                }
                if (u.pn == 6 || u.pn == 7) { sq = sum_x16(sq); sq = sum_x32(sq); if (fq == 0) ssq[(size_t)row * 8 + (u.pn == 7 ? 4 : 0) + wc] = sq; }
            }
        }
    }
};
struct EpiQ {
    bf16_t* O; const float* tabM; const float* ssq;
    DI void operator()(const f32x4 (&acc)[2][2][4][2], const Unit& u, int wr, int wc, int fr, int fq) const {
        const int row0 = u.pm * BM + wr * 64 + fr, colw = u.pn * BM + wc * 32 + 8 * fq;
#pragma unroll
        for (int ai = 0; ai < 2; ++ai)
#pragma unroll
        for (int mh = 0; mh < 2; ++mh) {
            f32x4 sp[2], tc[2][2], ts[2][2];
#pragma unroll
            for (int mm = 0; mm < 2; ++mm) { const int row = row0 + ai * HALF + (2 * mh + mm) * 16, pos = row_pos(row);
                sp[mm] = *(const f32x4*)(ssq + (size_t)row * 8);
#pragma unroll
                for (int bj = 0; bj < 2; ++bj) { const int c = (colw + bj * HALF) % 96; const float* t = tabM + (size_t)pos * 32 + (c >= 64 ? ((c - 64) >> 1) : 0);
                    tc[mm][bj] = *(const f32x4*)t; ts[mm][bj] = *(const f32x4*)(t + 16); } }
#pragma unroll
            for (int mm = 0; mm < 2; ++mm) {
                const int m = 2 * mh + mm, row = row0 + ai * HALF + m * 16; const f32x4 s4 = sp[mm];
                const float rstd = 1.0f / sqrtf(((s4[0] + s4[1]) + (s4[2] + s4[3])) * (1.0f / 256.0f) + 1e-6f);
#pragma unroll
                for (int bj = 0; bj < 2; ++bj) {
                    f32x4 v0 = acc[ai][bj][m][0] * rstd, v1 = acc[ai][bj][m][1] * rstd; const int col = colw + bj * HALF;
                    const bool rp = (col % 96) >= 64;
                    f32x4 r0 = v0, r1 = v1; rope8(r0, r1, tc[mm][bj], ts[mm][bj]);
#pragma unroll
                    for (int j = 0; j < 4; ++j) { v0[j] = rp ? r0[j] : v0[j]; v1[j] = rp ? r1[j] : v1[j]; }
                    store8(O + (size_t)row * 768 + col, v0, v1);
                }
            }
        }
    }
};
struct EpiKV {
    bf16_t* O; const float* ssq;
    DI void operator()(const f32x4 (&acc)[2][2][4][2], const Unit& u, int wr, int wc, int fr, int fq) const {
        const int row0 = u.pm * BM + wr * 64 + fr, colw = u.pn * BM + wc * 32 + 8 * fq;
#pragma unroll
        for (int ai = 0; ai < 2; ++ai) {
            f32x4 sp[4];
#pragma unroll
            for (int m = 0; m < 4; ++m) sp[m] = *(const f32x4*)(ssq + (size_t)(row0 + ai * HALF + m * 16) * 8 + 4);
#pragma unroll
            for (int m = 0; m < 4; ++m) {
                const int row = row0 + ai * HALF + m * 16; const f32x4 s4 = sp[m];
                const float rstd = 1.0f / sqrtf(((s4[0] + s4[1]) + (s4[2] + s4[3])) * (1.0f / 128.0f) + 1e-6f);
#pragma unroll
                for (int bj = 0; bj < 2; ++bj) store8(O + (size_t)row * 1024 + colw + bj * HALF, acc[ai][bj][m][0] * rstd, acc[ai][bj][m][1] * rstd);
            }
        }
    }
};
DI unsigned gate_q4(const f32x4 v) { unsigned q[4];
#pragma unroll
    for (int j = 0; j < 4; ++j) q[j] = (unsigned)fmaxf(v[j] * 255.0f + 0.5f, 1.0f);
    return q[0] | (q[1] << 8) | (q[2] << 16) | (q[3] << 24); }
DI f32x4 gate_f4(const unsigned w) { return (f32x4){(float)(w & 0xffu), (float)((w >> 8) & 0xffu), (float)((w >> 16) & 0xffu), (float)(w >> 24)}; }
struct EpiGate {
    unsigned char* O; const float* bias;
    DI void operator()(const f32x4 (&acc)[2][2][4][2], const Unit& u, int wr, int wc, int fr, int fq) const {
        const int row0 = u.pm * BM + wr * 64 + fr, colw = u.pn * BM + wc * 32 + 8 * fq;
#pragma unroll
        for (int bj = 0; bj < 2; ++bj) { const f32x4 nb0 = *(const f32x4*)(bias + colw + bj * HALF) * -LOG2E, nb1 = *(const f32x4*)(bias + colw + bj * HALF + 4) * -LOG2E;
#pragma unroll
        for (int ai = 0; ai < 2; ++ai)
#pragma unroll
            for (int m = 0; m < 4; ++m) {
                const int row = row0 + ai * HALF + m * 16;
                { constexpr float DSL = -LOG2E / (X8_SCALE * WGU_SCALE); f32x4 v0 = acc[ai][bj][m][0] * DSL + nb0, v1 = acc[ai][bj][m][1] * DSL + nb1;
#pragma unroll
                    for (int j = 0; j < 4; ++j) { v0[j] = __builtin_amdgcn_rcpf(1.0f + __builtin_amdgcn_exp2f(v0[j])); v1[j] = __builtin_amdgcn_rcpf(1.0f + __builtin_amdgcn_exp2f(v1[j])); }
                    *(u32x2*)(O + gate_addr((size_t)row, colw + bj * HALF)) = (u32x2){gate_q4(v0), gate_q4(v1)}; }
            } }
    }
};
struct EpiBranch {
    bf16_t* O; const unsigned char* gates;
    DI void operator()(f32x4 (&acc)[2][2][4][2], const Unit& u, int wr, int wc, int fr, int fq) const {
        const int row0 = u.pm * BM + wr * 64 + fr, colw = u.pn * BM + wc * 32 + 8 * fq;
        const bool fin = u.pb == 3;
        const int gcol = u.pb * 1024 + colw; const int hoff = fin ? 0 : 4096;
        u32x2 G[2][4][2], H[2][4][2];
#pragma unroll
        for (int ai = 0; ai < 2; ++ai)
#pragma unroll
            for (int m = 0; m < 4; ++m)
#pragma unroll
                for (int bj = 0; bj < 2; ++bj) { const unsigned char* gp = gates + gate_addr((size_t)(row0 + ai * HALF + m * 16), gcol + bj * HALF); G[ai][m][bj] = *(const u32x2*)gp; H[ai][m][bj] = *(const u32x2*)(gp + hoff); }
#pragma unroll
        for (int ai = 0; ai < 2; ++ai)
#pragma unroll
            for (int m = 0; m < 4; ++m)
#pragma unroll
                for (int bj = 0; bj < 2; ++bj) {
                    f32x4 g0 = gate_f4(G[ai][m][bj][0]), g1 = gate_f4(G[ai][m][bj][1]); const f32x4 h0 = gate_f4(H[ai][m][bj][0]), h1 = gate_f4(H[ai][m][bj][1]);
#pragma unroll
                    for (int j = 0; j < 4; ++j) { g0[j] *= fin ? (1.0f / (255.0f * YB_SCALE * WDN_SCALE)) : __builtin_amdgcn_rcpf(h0[j]); g1[j] *= fin ? (1.0f / (255.0f * YB_SCALE * WDN_SCALE)) : __builtin_amdgcn_rcpf(h1[j]); }
                    acc[ai][bj][m][0] *= g0; acc[ai][bj][m][1] *= g1;
                    if (fin) store8(O + (size_t)(row0 + ai * HALF + m * 16) * 1024 + colw + bj * HALF, acc[ai][bj][m][0], acc[ai][bj][m][1]); }
    }
};
struct EpiOut {
    bf16_t* H;
    DI void operator()(const f32x4 (&acc)[2][2][4][2], const Unit& u, int wr, int wc, int fr, int fq) const {
        const int row0 = u.pm * BM + wr * 64 + fr, colw = u.pn * BM + wc * 32 + 8 * fq;
#pragma unroll
        for (int ai = 0; ai < 2; ++ai)
#pragma unroll
            for (int m = 0; m < 4; ++m) {
                const int row = row0 + ai * HALF + m * 16;
#pragma unroll
                for (int bj = 0; bj < 2; ++bj) { bf16_t* o = H + (size_t)row * 1024 + colw + bj * HALF; f32x4 p0, p1; load8(o, p0, p1);
                    store8(o, p0 * DN_ALPHA + acc[ai][bj][m][0], p1 * DN_ALPHA + acc[ai][bj][m][1]); }
            }
    }
};

struct MoeTabs { const LAS int* ebase; const LAS int* ecnt; const LAS unsigned char* tile_e; const int* list; int ntiles; };
template <int NN, bool GATHER_> struct MoeOrder {
    static constexpr bool GATHER = GATHER_, KEEP = false;
    MoeTabs T; int G, c;
    DI bool next(int i, Unit& u) const { int t, pn;
        if ((G & 7) == 0 && ((G >> 3) % NN) == 0) { const int x = c & 7, j = c >> 3, tpr = G / NN, tpx = tpr >> 3; pn = j % NN; t = i * tpr + x * tpx + j / NN; }
        else { const long L = (long)i * G + c; t = (int)(L / NN); pn = (int)(L % NN); }
        if (t >= T.ntiles) return false; u.pm = t; u.pn = pn; u.pb = __builtin_amdgcn_readfirstlane((int)T.tile_e[t]); return true; }
    DI int arow(const Unit& u, int r) const {
        const int e = u.pb, idx = (u.pm - T.ebase[e]) * BM + r;
        return idx < T.ecnt[e] ? (T.list[(size_t)e * M + idx] >> 2) : 0;
    }
};
struct EpiSwiglu {
    unsigned char* O; const float* bg; const float* bu;
    DI void operator()(const f32x4 (&acc)[2][2][4][2], const Unit& u, int wr, int wc, int fr, int fq) const {
        const int row0 = u.pm * BM + wr * 64 + fr, cw = u.pn * HALF + wc * 32 + 8 * fq;
        constexpr float DS = 1.0f / (X8_SCALE * WGU_SCALE);
        f32x4 g_b[2], u_b[2];
#pragma unroll
        for (int n = 0; n < 2; ++n) { g_b[n] = *(const f32x4*)(bg + (size_t)u.pb * DE + cw + 4 * n); u_b[n] = *(const f32x4*)(bu + (size_t)u.pb * DE + cw + 4 * n); }
#pragma unroll
        for (int ai = 0; ai < 2; ++ai)
#pragma unroll
            for (int m = 0; m < 4; ++m) {
                const int row = row0 + ai * HALF + m * 16; f32x4 o[2];
#pragma unroll
                for (int n = 0; n < 2; ++n) { const f32x4 gt = acc[ai][0][m][n] * DS + g_b[n], up = acc[ai][1][m][n] * DS + u_b[n];
#pragma unroll
                    for (int j = 0; j < 4; ++j) { const float gg = fminf(gt[j], 7.0f), uu = fminf(fmaxf(up[j], -7.0f), 7.0f); const float sg = __builtin_amdgcn_rcpf(1.0f + __builtin_amdgcn_exp2f(gg * (-1.702f * LOG2E)));
                        o[n][j] = __builtin_fmaf(uu, ACT_SCALE, ACT_SCALE) * (gg * sg); } }
                *(u32x2*)(O + (size_t)row * DE + cw) = (u32x2){pk4_fp8(o[0][0], o[0][1], o[0][2], o[0][3]), pk4_fp8(o[1][0], o[1][1], o[1][2], o[1][3])};
            }
    }
};
struct EpiDown {
    unsigned char* O; const float* bd; MoeTabs T;
    DI void operator()(const f32x4 (&acc)[2][2][4][2], const Unit& u, int wr, int wc, int fr, int fq) const {
        const int e = u.pb, r0 = wr * 64 + fr, colw = u.pn * BM + wc * 32 + 8 * fq, ibase = (u.pm - T.ebase[e]) * BM, cnt = T.ecnt[e];
        constexpr float DS = 1.0f / (ACT_SCALE * WDN_SCALE);
        f32x4 bv[2][2];
#pragma unroll
        for (int bj = 0; bj < 2; ++bj)
#pragma unroll
            for (int n = 0; n < 2; ++n) bv[bj][n] = *(const f32x4*)(bd + (size_t)e * D + colw + bj * HALF + 4 * n);
        int ents[2][4];
#pragma unroll
        for (int ai = 0; ai < 2; ++ai)
#pragma unroll
            for (int m = 0; m < 4; ++m) { const int idx = ibase + r0 + ai * HALF + m * 16; ents[ai][m] = T.list[(size_t)e * M + (idx < cnt ? idx : 0)]; }
#pragma unroll
        for (int ai = 0; ai < 2; ++ai)
#pragma unroll
            for (int m = 0; m < 4; ++m) {
                const int idx = ibase + r0 + ai * HALF + m * 16;
                if (idx < cnt) { const int ent = ents[ai][m];
#pragma unroll
                    for (int bj = 0; bj < 2; ++bj) { const f32x4 v0 = (acc[ai][bj][m][0] * DS + bv[bj][0]) * YS_SCALE, v1 = (acc[ai][bj][m][1] * DS + bv[bj][1]) * YS_SCALE;
                        *(u32x2*)(O + (size_t)ent * D + colw + bj * HALF) = (u32x2){pk4_fp8(v0[0], v0[1], v0[2], v0[3]), pk4_fp8(v1[0], v1[1], v1[2], v1[3])}; } }
            }
    }
};
}
struct KArgs { const float* in[34]; float* out; unsigned char* ws; int ph_lo, ph_hi; float invR[32]; float invM[16]; };
typedef const __attribute__((address_space(4))) KArgs* kargs_t;
DI kargs_t get_args() { kargs_t p = (kargs_t)__builtin_amdgcn_kernarg_segment_ptr(); asm volatile("" : "+s"(p)); return p; }
struct Frame {
    LAS unsigned char* lds; gu32* ctl; unsigned char* ws;
    int tid, lane, wave, G, bid;
};
enum { I_X = 0, I_META, I_LN0G, I_LN0B, I_WIN, I_WMERGE, I_BMERGE, I_GCQ, I_GCKV, I_WUQ, I_WUKV, I_CONVW, I_CONVB, I_WLA, I_BLA, I_WLX, I_BLX, I_LAM, I_WA2, I_BA2,
       I_WBR, I_WOUT, I_LN1G, I_LN1B, I_WR, I_BR, I_WEG, I_BEG, I_WEU, I_BEU, I_WED, I_BED, I_LN2G, I_LN2B };

struct ColSrc { const float* p; float scale; };
template <class F>
DI void transpose_fill(const Frame& Fr, F colmap, int n0, int k0, int ldsrc, const float* kscale, float post) {
    LAS float* scr = (LAS float*)(Fr.lds + Fr.wave * 16384);
    const int lane = Fr.lane;
    const ColSrc c0 = colmap(n0), c31 = colmap(n0 + 31), cme = colmap(n0 + (lane & 31));
    const bool contig = c0.p && c31.p == c0.p + 31 && cme.p == c0.p + (lane & 31) && c0.scale == c31.scale && (((size_t)c0.p & 15) == 0) && ((ldsrc & 3) == 0);
    if (__all(contig)) {
        const float sc = c0.scale * post; const int kk = lane >> 3, n4 = lane & 7;
        const float* src = c0.p + (size_t)(k0 + kk) * ldsrc + 4 * n4;
        f32x4 v[8];
#pragma unroll
        for (int i = 0; i < 8; ++i) v[i] = *(const f32x4*)(src + (size_t)(8 * i) * ldsrc);
#pragma unroll
        for (int i = 0; i < 8; ++i) { float ks = sc; if (kscale) ks *= kscale[k0 + 8 * i + kk]; LAS float* d = scr + (8 * i + kk) * 33 + 4 * n4; d[0] = v[i][0] * ks; d[1] = v[i][1] * ks; d[2] = v[i][2] * ks; d[3] = v[i][3] * ks; }
    } else {
        const float* src = cme.p ? cme.p : colmap(0).p;
        const float sc = cme.p ? cme.scale * post : 0.f;
        src += (size_t)(k0 + (lane >> 5)) * ldsrc;
        float v[32];
#pragma unroll
        for (int i = 0; i < 32; ++i) v[i] = src[(size_t)(2 * i) * ldsrc];
        if (kscale) {
#pragma unroll
            for (int i = 0; i < 32; ++i) v[i] *= kscale[k0 + 2 * i + (lane >> 5)];
        }
#pragma unroll
        for (int i = 0; i < 32; ++i) scr[(2 * i + (lane >> 5)) * 33 + (lane & 31)] = v[i] * sc;
    }
    LDS_WAIT(); asm volatile("" ::: "memory");
}
template <class F>
DI void transpose_item(const Frame& Fr, F colmap, int item, int ndst, int K, int ldsrc, const float* kscale, bf16_t* WT) {
    LAS float* scr = (LAS float*)(Fr.lds + Fr.wave * 16384);
    const int lane = Fr.lane, nblk = ndst / 32;
    const int kb = item / nblk, nb = item % nblk, k0 = 64 * kb, n0 = 32 * nb;
    transpose_fill(Fr, colmap, n0, k0, ldsrc, kscale, 1.0f);
    const int c = lane & 7;
#pragma unroll
    for (int j = 0; j < 4; ++j) { const int n = (lane >> 3) + 8 * j; const LAS float* s = scr + (8 * c) * 33 + n;
        u32x4 o; o.x = pk2(s[0 * 33], s[1 * 33]); o.y = pk2(s[2 * 33], s[3 * 33]); o.z = pk2(s[4 * 33], s[5 * 33]); o.w = pk2(s[6 * 33], s[7 * 33]);
        *(u32x4*)(WT + (size_t)(n0 + n) * K + k0 + 8 * c) = o; }
    LDS_WAIT(); asm volatile("" ::: "memory");
}
template <class F>
DI void transpose_item_fp8(const Frame& Fr, F colmap, int item, int ndst, int K, int ldsrc, float sc8, unsigned char* WT) {
    LAS float* scr = (LAS float*)(Fr.lds + Fr.wave * 16384);
    const int lane = Fr.lane, nblk = ndst / 32;
    const int kb = item / nblk, nb = item % nblk, k0 = 64 * kb, n0 = 32 * nb;
    transpose_fill(Fr, colmap, n0, k0, ldsrc, nullptr, sc8);
    const int c = lane & 7;
#pragma unroll
    for (int j = 0; j < 4; ++j) { const int n = (lane >> 3) + 8 * j; const LAS float* s = scr + (8 * c) * 33 + n;
        *(u32x2*)(WT + (size_t)(n0 + n) * K + k0 + 8 * c) = (u32x2){pk4_fp8(s[0 * 33], s[1 * 33], s[2 * 33], s[3 * 33]), pk4_fp8(s[4 * 33], s[5 * 33], s[6 * 33], s[7 * 33])}; }
    LDS_WAIT(); asm volatile("" ::: "memory");
}
struct MapIn {
    const float* W;
    DI ColSrc operator()(int n) const {
        int src; float sc = 1.f;
        if (n < 256) { const int h = n >> 6, c = n & 63; src = O_RQ + h * 64 + (c >> 1) + 32 * (c & 1); }
        else if (n < 512) { const int q = n - 256, h = q >> 6, c = q & 63; src = O_RK + h * 64 + (c >> 1) + 32 * (c & 1); sc = 0.125f; }
        else if (n < 1024) src = O_RV + (n - 512);
        else if (n < 1536) src = O_RG + (n - 1024);
        else if (n < 1792) src = O_CQ + (n - 1536);
        else if (n < 1920) src = O_CKV + (n - 1792);
        else if (n < 1952) { const int c = n - 1920; src = O_KR + (c >> 1) + 16 * (c & 1); }
        else if (n < 1968) src = O_GA + (n - 1952);
        else if (n < 2048) return ColSrc{nullptr, 0.f};
        else if (n < 2560) src = O_LX + (n - 2048);
        else if (n < 3072) src = O_LG + (n - 2560);
        else if (n < 3328) src = O_GQ + (n - 3072);
        else if (n < 3584) { src = O_GK + (n - 3328); sc = 0.125f; }
        else if (n < 4096) src = O_GV + (n - 3584);
        else src = O_GG + (n - 4096);
        return ColSrc{W + src, sc};
    }
};
struct MapPlain { const float* W; DI ColSrc operator()(int n) const { return ColSrc{W + n, 1.f}; } };
struct MapUq {
    const float* W;
    DI ColSrc operator()(int n) const { const int h = n / 96, c = n % 96; int src = h * 96 + c; if (c >= 64) { const int cc = c - 64; src = h * 96 + 64 + (cc >> 1) + 16 * (cc & 1); }
        return ColSrc{W + src, 0.10206207261596577f * LOG2E}; }
};
struct MapUkv {
    const float* W;
    DI ColSrc operator()(int n) const { const int q = n & 511, h = q >> 6, d = q & 63; return ColSrc{W + h * 128 + (n >= 512 ? 64 : 0) + d, 1.f}; }
};
struct MapGU {
    const float* Wg; const float* Wu;
    DI ColSrc operator()(int n) const { const int j = n >> 8, r = n & 255; const long dlt = (r < 128) ? 0 : (long)(Wu - Wg); return ColSrc{Wg + dlt + 128 * j + (r & 127), 1.f}; }
};

constexpr int CI_IN = (NPROJ / 32) * (D / 64), CI_MG = (4096 / 32) * (D / 64), CI_BR1 = (D / 32) * (512 / 64), CI_OUT = (D / 32) * (D / 64), CI_UQ = (768 / 32) * (256 / 64),
              CI_UKV = (1024 / 32) * (128 / 64), CI_GU1 = (2048 / 32) * (D / 64), CI_DN1 = (D / 32) * (DE / 64);
constexpr int CO_MG = CI_IN, CO_BR = CO_MG + CI_MG, CO_OUT = CO_BR + 4 * CI_BR1, CO_UQ = CO_OUT + CI_OUT, CO_UKV = CO_UQ + CI_UQ, CO_GU = CO_UKV + CI_UKV, CO_DN = CO_GU + NE * CI_GU1,
              CI_TOTAL = CO_DN + NE * CI_DN1;
struct ConvItem { const float* src; unsigned char* dst; float scale; int ldsrc, K, n0, k0; bool fast, fp8; };
DI ConvItem conv_decode(kargs_t a, unsigned char* ws, int l, int it, int lane) {
    ConvItem c; c.src = nullptr; c.dst = nullptr; c.scale = 1.f; c.ldsrc = 0; c.K = 0; c.n0 = 0; c.k0 = 0; c.fast = false; c.fp8 = false;
    const float* W = nullptr; int ndst = 0, srccol = -1; int r = it;
    if (it >= CO_DN) { r = it - CO_DN; const int e = r / CI_DN1; r %= CI_DN1; W = a->in[I_WED] + ((size_t)l * NE + e) * D * DE; ndst = D; c.K = DE; c.ldsrc = D; c.fp8 = true; c.scale = WDN_SCALE; c.dst = ws + W_DN + (size_t)e * D * DE; srccol = 0; }
    else if (it >= CO_GU) { r = it - CO_GU; const int e = r / CI_GU1; r %= CI_GU1; ndst = 2048; c.K = D; c.ldsrc = DE; c.fp8 = true; c.scale = WGU_SCALE; c.dst = ws + W_GU + (size_t)e * 2048 * D; srccol = -2;
        W = a->in[I_WEG] + ((size_t)l * NE + e) * D * DE; }
    else if (it >= CO_UQ) return c;
    else if (it >= CO_OUT) { r = it - CO_OUT; W = a->in[I_WOUT] + (size_t)l * D * D; ndst = D; c.K = D; c.ldsrc = D; c.dst = ws + W_OUT; srccol = 0; }
    else if (it >= CO_BR) { r = it - CO_BR; const int n = r / CI_BR1; r %= CI_BR1; W = a->in[I_WBR] + ((size_t)l * 4 + n) * 512 * D; ndst = D; c.K = 512; c.ldsrc = D; c.fp8 = true; c.scale = WDN_SCALE; c.dst = ws + W_BR + (size_t)n * D * 512; srccol = 0; }
    else if (it >= CO_MG) { r = it - CO_MG; W = a->in[I_WMERGE] + (size_t)l * D * 4096; ndst = 4096; c.K = D; c.ldsrc = 4096; c.fp8 = true; c.scale = WGU_SCALE; c.dst = ws + W_MG; srccol = 0; }
    else { W = a->in[I_WIN] + (size_t)l * D * D_IN; ndst = NPROJ; c.K = D; c.ldsrc = D_IN; c.dst = ws + W_IN; srccol = -3; }
    const int nblk = ndst / 32; c.k0 = 64 * (r / nblk); c.n0 = 32 * (r % nblk);
    int col;
    if (srccol == 0) col = c.n0;
    else if (srccol == -2) { const int j = c.n0 >> 8, rr = c.n0 & 255; if (rr >= 128) W = a->in[I_WEU] + (W - a->in[I_WEG]); col = 128 * j + (rr & 127); }
    else { if (c.n0 < 512 || (c.n0 >= 1920 && c.n0 < 2048)) return c;
        const ColSrc cs = MapIn{W}(c.n0); col = (int)(cs.p - W); c.scale = cs.scale; }
    const float* p0 = W + col;
    if ((((size_t)p0) & 15) != 0 || (c.ldsrc & 3) != 0) return c;
    c.src = p0 + (size_t)(c.k0 + 8 * (lane >> 3)) * c.ldsrc + 4 * (lane & 7); c.fast = true;
    return c;
}
DI void conv_load(const ConvItem& c, f32x4 (&v)[8]) {
#pragma unroll
    for (int i = 0; i < 8; ++i) v[i] = *(const f32x4*)(c.src + (size_t)i * c.ldsrc);
}
DI void conv_finish(const Frame& Fr, const ConvItem& c, const f32x4 (&v)[8]) {
    const int lane = Fr.lane, kg = lane >> 3, n4 = lane & 7; const float sc = c.scale;
#pragma unroll
    for (int j = 0; j < 4; ++j) { const size_t e = (size_t)(c.n0 + 4 * n4 + j) * c.K + c.k0 + 8 * kg;
        if (c.fp8) *(u32x2*)(c.dst + e) = (u32x2){pk4_fp8(v[0][j] * sc, v[1][j] * sc, v[2][j] * sc, v[3][j] * sc), pk4_fp8(v[4][j] * sc, v[5][j] * sc, v[6][j] * sc, v[7][j] * sc)};
        else *(u32x4*)((bf16_t*)c.dst + e) = (u32x4){pk2(v[0][j] * sc, v[1][j] * sc), pk2(v[2][j] * sc, v[3][j] * sc), pk2(v[4][j] * sc, v[5][j] * sc), pk2(v[6][j] * sc, v[7][j] * sc)}; }
}
DI void conv_slow(const Frame& F, kargs_t a, int l, int it) {
    unsigned char* ws = F.ws;
    if (it >= CO_UKV && it < CO_GU) transpose_item(F, MapUkv{a->in[I_WUKV] + (size_t)l * 128 * 1024}, it - CO_UKV, 1024, 128, 1024, a->in[I_GCKV] + l * 128, (bf16_t*)(ws + W_UKV));
    else if (it >= CO_UQ && it < CO_UKV) transpose_item(F, MapUq{a->in[I_WUQ] + (size_t)l * 256 * 768}, it - CO_UQ, 768, 256, 768, a->in[I_GCQ] + l * 256, (bf16_t*)(ws + W_UQ));
    else transpose_item(F, MapIn{a->in[I_WIN] + (size_t)l * D * D_IN}, it, NPROJ, D, D_IN, nullptr, (bf16_t*)(ws + W_IN));
}
DI void phase_convert(const Frame& F, kargs_t a, int l) {
    const int gw = F.bid * NWAVES + F.wave, NGW = F.G * NWAVES;
    unsigned char* ws = F.ws;
    f32x4 vc[8], vn[8];
#pragma unroll
    for (int i = 0; i < 8; ++i) { vc[i] = (f32x4){0.f, 0.f, 0.f, 0.f}; vn[i] = vc[i]; }
    int it = gw;
    ConvItem cur; cur.fast = false;
    if (it < CI_TOTAL) { cur = conv_decode(a, ws, l, it, F.lane); if (cur.fast) conv_load(cur, vc); }
    for (; it < CI_TOTAL; it += NGW) {
        const int itn = it + NGW; ConvItem nxt; nxt.fast = false;
        if (itn < CI_TOTAL) { nxt = conv_decode(a, ws, l, itn, F.lane); if (nxt.fast) conv_load(nxt, vn); }
        if (cur.fast) conv_finish(F, cur, vc); else conv_slow(F, a, l, it);
        cur = nxt;
#pragma unroll
        for (int i = 0; i < 8; ++i) vc[i] = vn[i];
    }
}


DI f32x4 bf16x4_to_f32(const u32x2 g) { return (f32x4){__uint_as_float(g[0] << 16), __uint_as_float(g[0] & 0xffff0000u), __uint_as_float(g[1] << 16), __uint_as_float(g[1] & 0xffff0000u)}; }
DI void meta_branch(const Frame& F, const unsigned char* gates) {
    unsigned char* ws = F.ws; LAS float* red = (LAS float*)F.lds;
    const int lane = F.lane, w = F.wave, fr = lane & 15, fq = lane >> 4, br = w >> 1, kb = (w & 1) * 256;
    for (int s = F.bid; s < NB * 64; s += F.G) {
        const int b = s >> 6, c0 = (s & 63) * 16;
        const size_t row = (size_t)b * TP + PADF + fr;
        const unsigned char* ap = ws + WS_YS + row * 2048 + br * 512 + kb + 16 * fq;
        const unsigned char* wp = ws + W_BR + ((size_t)br * D + c0 + fr) * 512 + kb + 16 * fq;
        u32x4 av[4], wv[4];
#pragma unroll
        for (int i = 0; i < 4; ++i) { av[i] = *(const u32x4*)(ap + 64 * i); wv[i] = *(const u32x4*)(wp + 64 * i); }
        const unsigned gg = *(const unsigned*)(gates + gate_addr(row, br * 1024 + c0 + 4 * fq));
        f32x4 acc = {0.f, 0.f, 0.f, 0.f};
#pragma unroll
        for (int i = 0; i < 4; ++i) {
            acc = __builtin_amdgcn_mfma_f32_16x16x32_fp8_fp8((long)(((unsigned long long)wv[i].y << 32) | wv[i].x), (long)(((unsigned long long)av[i].y << 32) | av[i].x), acc, 0, 0, 0);
            acc = __builtin_amdgcn_mfma_f32_16x16x32_fp8_fp8((long)(((unsigned long long)wv[i].w << 32) | wv[i].z), (long)(((unsigned long long)av[i].w << 32) | av[i].z), acc, 0, 0, 0); }
        *(LAS f32x4*)(red + w * 256 + fr * 16 + 4 * fq) = acc * (pg8::gate_f4(gg) * (1.0f / (255.0f * YB_SCALE * WDN_SCALE)));
        __syncthreads();
        if (F.tid < 64) { f32x4 sum = *(const LAS f32x4*)(red + F.tid * 4);
#pragma unroll
            for (int k = 1; k < 8; ++k) sum += *(const LAS f32x4*)(red + k * 256 + F.tid * 4);
            *(u32x2*)((bf16_t*)(ws + WS_MIX) + ((size_t)b * TP + PADF + (F.tid >> 2)) * 1024 + c0 + 4 * (F.tid & 3)) = (u32x2){pk2(sum[0], sum[1]), pk2(sum[2], sum[3])}; }
        __syncthreads();
    }
}
DI void meta_gates(const Frame& F, unsigned char* gates, const float* bias) {
    unsigned char* ws = F.ws; LAS float* red = (LAS float*)F.lds;
    const int lane = F.lane, w = F.wave, fr = lane & 15, fq = lane >> 4, cs = w & 3, kb = (w >> 2) * 512;
    for (int s = F.bid; s < NB * 64; s += F.G) {
        const int b = s >> 6, c0 = (s & 63) * 64;
        const size_t row = (size_t)b * TP + PADF + fr;
        const unsigned char* ap = ws + WS_H8 + row * D + kb + 16 * fq;
        const unsigned char* wp = ws + W_MG + (size_t)(c0 + 16 * cs + fr) * D + kb + 16 * fq;
        u32x4 av[8], wv[8];
#pragma unroll
        for (int i = 0; i < 8; ++i) { av[i] = *(const u32x4*)(ap + 64 * i); wv[i] = *(const u32x4*)(wp + 64 * i); }
        f32x4 acc = {0.f, 0.f, 0.f, 0.f};
#pragma unroll
        for (int i = 0; i < 8; ++i) {
            acc = __builtin_amdgcn_mfma_f32_16x16x32_fp8_fp8((long)(((unsigned long long)wv[i].y << 32) | wv[i].x), (long)(((unsigned long long)av[i].y << 32) | av[i].x), acc, 0, 0, 0);
            acc = __builtin_amdgcn_mfma_f32_16x16x32_fp8_fp8((long)(((unsigned long long)wv[i].w << 32) | wv[i].z), (long)(((unsigned long long)av[i].w << 32) | av[i].z), acc, 0, 0, 0); }
        *(LAS f32x4*)(red + w * 256 + fr * 16 + 4 * fq) = acc;
        __syncthreads();
        if (F.tid < 256) { const int r = F.tid >> 4, c4 = F.tid & 15, o = (c4 >> 2) * 256 + r * 16 + 4 * (c4 & 3);
            constexpr float DS = 1.0f / (X8_SCALE * WGU_SCALE);
            f32x4 v = (*(const LAS f32x4*)(red + o) + *(const LAS f32x4*)(red + 1024 + o)) * DS + *(const f32x4*)(bias + c0 + 4 * c4);
#pragma unroll
            for (int j = 0; j < 4; ++j) v[j] = fast_sigmoid(v[j]);
            *(unsigned*)(gates + gate_addr((size_t)b * TP + PADF + r, c0 + 4 * c4)) = pg8::gate_q4(v); }
        __syncthreads();
    }
}
DI void meta_out(const Frame& F, bf16_t* hb) {
    unsigned char* ws = F.ws; LAS float* red = (LAS float*)F.lds;
    const int lane = F.lane, w = F.wave, fr = lane & 15, fq = lane >> 4, kb = w * 128;
    for (int s = F.bid; s < NB * 64; s += F.G) {
        const int b = s >> 6, c0 = (s & 63) * 16;
        const size_t row = (size_t)b * TP + PADF + fr;
        const bf16_t* ap = (const bf16_t*)(ws + WS_MIX) + row * 1024 + kb + 8 * fq;
        const bf16_t* wp = (const bf16_t*)(ws + W_OUT) + (size_t)(c0 + fr) * 1024 + kb + 8 * fq;
        bf16x8 av[4], wv[4];
#pragma unroll
        for (int i = 0; i < 4; ++i) { av[i] = *(const bf16x8*)(ap + 32 * i); wv[i] = *(const bf16x8*)(wp + 32 * i); }
        f32x4 acc = {0.f, 0.f, 0.f, 0.f};
#pragma unroll
        for (int i = 0; i < 4; ++i) acc = __builtin_amdgcn_mfma_f32_16x16x32_bf16(wv[i], av[i], acc, 0, 0, 0);
        *(LAS f32x4*)(red + w * 256 + fr * 16 + 4 * fq) = acc;
        __syncthreads();
        if (F.tid < 64) { f32x4 sum = *(const LAS f32x4*)(red + F.tid * 4);
#pragma unroll
            for (int k = 1; k < 8; ++k) sum += *(const LAS f32x4*)(red + k * 256 + F.tid * 4);
            u32x2* o = (u32x2*)(hb + ((size_t)b * TP + PADF + (F.tid >> 2)) * 1024 + c0 + 4 * (F.tid & 3));
            const f32x4 p = bf16x4_to_f32(*o); sum += p * DN_ALPHA;
            *o = (u32x2){pk2(sum[0], sum[1]), pk2(sum[2], sum[3])}; }
        __syncthreads();
    }
}

DI void ln_stats(const f32x4 (&v)[4], float& mean, float& rstd) {
    float s = 0.f;
#pragma unroll
    for (int j = 0; j < 4; ++j) s += (v[j][0] + v[j][1]) + (v[j][2] + v[j][3]);
    mean = wave_sum(s) * (1.f / D); float s2 = 0.f;
#pragma unroll
    for (int j = 0; j < 4; ++j) { const f32x4 d = v[j] - mean; s2 += (d[0] * d[0] + d[1] * d[1]) + (d[2] * d[2] + d[3] * d[3]); }
    rstd = 1.0f / sqrtf(wave_sum(s2) * (1.f / D) + 1e-5f);
}
DI void row_store_bf16(bf16_t* orow, int lane, const f32x4 (&v)[4]) {
    u32x2* o8 = (u32x2*)orow + lane;
#pragma unroll
    for (int j = 0; j < 4; ++j) o8[64 * j] = (u32x2){pk2(v[j][0], v[j][1]), pk2(v[j][2], v[j][3])};
}
DI void row_load_bf16(const bf16_t* irow, int lane, f32x4 (&v)[4]) {
    const u32x2* i8 = (const u32x2*)irow + lane;
#pragma unroll
    for (int j = 0; j < 4; ++j) { const u32x2 w = i8[64 * j]; v[j] = (f32x4){bflo(w.x), bfhi(w.x), bflo(w.y), bfhi(w.y)}; }
}

DI void phase_ln0(const Frame& F, kargs_t a) {
    const int gw = F.bid * NWAVES + F.wave, NGW = F.G * NWAVES, lane = F.lane;
    bf16_t* hb = (bf16_t*)(F.ws + WS_HB);
    const float* g = a->in[I_LN0G]; const float* bb = a->in[I_LN0B];
    f32x4 gv[4], bv[4];
#pragma unroll
    for (int j = 0; j < 4; ++j) { gv[j] = *((const f32x4*)g + lane + 64 * j); bv[j] = *((const f32x4*)bb + lane + 64 * j); }
    for (int m = gw; m < M; m += NGW) {
        const int b = m / TP, tp = m % TP; f32x4 v[4];
        if (tp < PADF) {
#pragma unroll
            for (int j = 0; j < 4; ++j) v[j] = (f32x4){0.f, 0.f, 0.f, 0.f};
        } else {
            const int pos = tp - PADF; const float* src = pos < NMETA ? a->in[I_META] + (size_t)pos * D : a->in[I_X] + ((size_t)b * SEQ + pos - NMETA) * D;
#pragma unroll
            for (int j = 0; j < 4; ++j) v[j] = *((const f32x4*)src + lane + 64 * j);
            float mean, rstd; ln_stats(v, mean, rstd);
#pragma unroll
            for (int j = 0; j < 4; ++j) v[j] = (v[j] - mean) * rstd * gv[j] + bv[j];
        }
        row_store_bf16(hb + (size_t)m * D, lane, v);
        { unsigned* h8r = (unsigned*)(F.ws + WS_H8 + (size_t)m * D) + lane;
#pragma unroll
          for (int j = 0; j < 4; ++j) h8r[64 * j] = pk4_fp8(v[j][0] * X8_SCALE, v[j][1] * X8_SCALE, v[j][2] * X8_SCALE, v[j][3] * X8_SCALE); }
    }
    float* tabR = (float*)(F.ws + WS_TABR); float* tabM = (float*)(F.ws + WS_TABM);
    const int gt = F.bid * NTHREADS + F.tid, NGT = F.G * NTHREADS;
    for (int i = gt; i < TT * 48; i += NGT) {
        const int pos = i / 48, f = i % 48; const float inv = f < 32 ? a->invR[f] : a->invM[f - 32];
        const float angf = (float)pos * inv; const double ang = (double)angf;
        const double kq = rint(ang * 0.63661977236758134308); double r = fma(-kq, 1.57079632679489655800e+00, ang); r = fma(-kq, 6.12323399573676603587e-17, r);
        const double r2 = r * r;
        const double sn = r * (1.0 + r2 * (-1.0 / 6 + r2 * (1.0 / 120 + r2 * (-1.0 / 5040 + r2 * (1.0 / 362880 + r2 * (-1.0 / 39916800))))));
        const double cs = 1.0 + r2 * (-0.5 + r2 * (1.0 / 24 + r2 * (-1.0 / 720 + r2 * (1.0 / 40320 + r2 * (-1.0 / 3628800 + r2 * (1.0 / 479001600))))));
        const int q = ((int)kq) & 3; double c, s;
        if (q == 0) { c = cs; s = sn; } else if (q == 1) { c = -sn; s = cs; } else if (q == 2) { c = -cs; s = -sn; } else { c = sn; s = -cs; }
        if (f < 32) { tabR[(size_t)pos * 64 + f] = (float)c; tabR[(size_t)pos * 64 + 32 + f] = (float)s; }
        else { tabM[(size_t)pos * 32 + f - 32] = (float)c; tabM[(size_t)pos * 32 + 16 + f - 32] = (float)s; }
    }
}

DI void ln1_row_norm(bf16_t* hb, unsigned char* x8, int m, int lane, const f32x4 (&gv)[4], const f32x4 (&bv)[4], f32x4 (&v)[4], bool& valid) {
    valid = false;
#pragma unroll
    for (int j = 0; j < 4; ++j) v[j] = (f32x4){0.f, 0.f, 0.f, 0.f};
    if (m >= M) return;
    const int tp = m % TP;
    unsigned* x8r = (unsigned*)(x8 + (size_t)m * D) + lane;
    if (tp < PADF) { row_store_bf16(hb + (size_t)m * D, lane, v);
#pragma unroll
        for (int j = 0; j < 4; ++j) x8r[64 * j] = 0u;
        return; }
    valid = true;
    row_load_bf16(hb + (size_t)m * D, lane, v);
    float mean, rstd; ln_stats(v, mean, rstd);
#pragma unroll
    for (int j = 0; j < 4; ++j) v[j] = (v[j] - mean) * rstd * gv[j] + bv[j];
    row_store_bf16(hb + (size_t)m * D, lane, v);
#pragma unroll
    for (int j = 0; j < 4; ++j) x8r[64 * j] = pk4_fp8(v[j][0] * X8_SCALE, v[j][1] * X8_SCALE, v[j][2] * X8_SCALE, v[j][3] * X8_SCALE);
}
DI float butterfly32(float (&p)[NE], int lane) {
#pragma unroll
    for (int i = 0; i < 16; ++i) { const bool up = (lane & 32) != 0; const float send = up ? p[i] : p[i + 16], keep = up ? p[i + 16] : p[i]; p[i] = keep + xor32_f(send, lane); }
#pragma unroll
    for (int i = 0; i < 8; ++i) { const bool up = (lane & 16) != 0; const float send = up ? p[i] : p[i + 8], keep = up ? p[i + 8] : p[i]; p[i] = keep + xor16_f(send, lane); }
#pragma unroll
    for (int i = 0; i < 4; ++i) { const bool up = (lane & 8) != 0; const float send = up ? p[i] : p[i + 4], keep = up ? p[i + 4] : p[i]; p[i] = keep + xor8_f(send); }
#pragma unroll
    for (int i = 0; i < 2; ++i) { const bool up = (lane & 4) != 0; const float send = up ? p[i] : p[i + 2], keep = up ? p[i + 2] : p[i]; p[i] = keep + xor4_f(send); }
    { const bool up = (lane & 2) != 0; const float send = up ? p[0] : p[1], keep = up ? p[1] : p[0]; p[0] = keep + xor2_f(send); }
    return p[0] + xor1_f(p[0]);
}
DI void ln1_route(float logit, int m, int lane, int* topi, float* topw, LAS unsigned* rt) {
    float cand = (lane & 1) ? -3.0e38f : logit; float tv[4]; int ti[4];
#pragma unroll
    for (int r = 0; r < 4; ++r) {
        const float mx = wave_max(cand);
        const int idx = __ffsll((long long)__ballot(cand == mx)) - 1;
        tv[r] = mx; ti[r] = idx >> 1; if (lane == idx) cand = -3.0e38f;
    }
    const float e1 = fast_exp(tv[1] - tv[0]), e2 = fast_exp(tv[2] - tv[0]), e3 = fast_exp(tv[3] - tv[0]); const float inv = 1.0f / (1.0f + e1 + e2 + e3);
    if (lane < 4) {
        const int my_e = lane == 0 ? ti[0] : lane == 1 ? ti[1] : lane == 2 ? ti[2] : ti[3];
        const float my_w = (lane == 0 ? 1.0f : lane == 1 ? e1 : lane == 2 ? e2 : e3) * inv;
        topi[(size_t)m * 4 + lane] = my_e; topw[(size_t)m * 4 + lane] = my_w;
        const unsigned lp = __hip_atomic_fetch_add(rt + my_e, 1u, __ATOMIC_RELAXED, __HIP_MEMORY_SCOPE_WORKGROUP);
        const unsigned slot = __hip_atomic_fetch_add(rt + 64, 1u, __ATOMIC_RELAXED, __HIP_MEMORY_SCOPE_WORKGROUP);
        rt[128 + 2 * slot] = (unsigned)(m * 4 + lane); rt[128 + 2 * slot + 1] = ((unsigned)my_e << 16) | lp;
    }
}
DI void phase_ln1(const Frame& F, kargs_t a, int l) {
    const int gw = F.bid * NWAVES + F.wave, NGW = F.G * NWAVES, lane = F.lane;
    bf16_t* hb = (bf16_t*)(F.ws + WS_HB);
    int* topi = (int*)(F.ws + WS_TOPI); float* topw = (float*)(F.ws + WS_TOPW); int* list = (int*)(F.ws + WS_LIST); unsigned char* x8 = F.ws + WS_X8;
    gu32* ecnt = F.ctl + CW_ECNT + 2048 * l;
    LAS unsigned* rt = (LAS unsigned*)(F.lds + TAB_OFF + 1024);
    if (F.tid < 128) rt[F.tid] = 0u;
    constexpr int WRP = D + 4;
    LAS float* wrt = (LAS float*)F.lds;
    const float* wr = a->in[I_WR] + (size_t)l * D * NE;
    for (int i = F.tid; i < D * NE; i += NTHREADS) { const int k = i >> 5, e = i & 31; wrt[e * WRP + k] = wr[i]; }
    __syncthreads();
    const float* g = a->in[I_LN1G] + l * D; const float* bb = a->in[I_LN1B] + l * D;
    f32x4 gv[4], bv[4];
#pragma unroll
    for (int j = 0; j < 4; ++j) { gv[j] = *((const f32x4*)g + lane + 64 * j); bv[j] = *((const f32x4*)bb + lane + 64 * j); }
    const float brl = a->in[I_BR][l * NE + ((lane >> 1) & 31)];
    for (int m0 = gw; m0 < M; m0 += 2 * NGW) {
        const int m1 = m0 + NGW;
        f32x4 x0[4], x1[4]; bool val0, val1;
        ln1_row_norm(hb, x8, m0, lane, gv, bv, x0, val0);
        ln1_row_norm(hb, x8, m1, lane, gv, bv, x1, val1);
        if (!val0 && !val1) continue;
        float p0[NE], p1[NE];
#pragma unroll
        for (int e = 0; e < NE; ++e) { float s0 = 0.f, s1 = 0.f;
#pragma unroll
            for (int j = 0; j < 4; ++j) { const f32x4 w = *((const LAS f32x4*)(wrt + e * WRP) + lane + 64 * j);
#pragma unroll
                for (int q = 0; q < 4; ++q) { s0 = __builtin_fmaf(x0[j][q], w[q], s0); s1 = __builtin_fmaf(x1[j][q], w[q], s1); } }
            p0[e] = s0; p1[e] = s1; }
        const float l0 = butterfly32(p0, lane) + brl, l1 = butterfly32(p1, lane) + brl;
        if (val0) ln1_route(l0, m0, lane, topi, topw, rt);
        if (val1) ln1_route(l1, m1, lane, topi, topw, rt);
    }
    __syncthreads();
    if (F.tid < NE) { const unsigned c = rt[F.tid]; rt[32 + F.tid] = c ? __hip_atomic_fetch_add(ecnt + 64 * F.tid, c, RLX_AGENT) : 0u; }
    __syncthreads();
    const unsigned nent = rt[64];
    for (unsigned i = F.tid; i < nent; i += NTHREADS) { const unsigned val = rt[128 + 2 * i], w = rt[128 + 2 * i + 1], e = w >> 16, lp = w & 0xffffu;
        list[(size_t)e * M + rt[32 + e] + lp] = (int)val; }
    __syncthreads();
}

DI void phase_ln2(const Frame& F, kargs_t a, int l) {
    const int gw = F.bid * NWAVES + F.wave, NGW = F.G * NWAVES, lane = F.lane;
    bf16_t* hb = (bf16_t*)(F.ws + WS_HB); const unsigned char* ys8 = F.ws + WS_YSLOT; const float* topw = (const float*)(F.ws + WS_TOPW);
    const float* g = a->in[I_LN2G] + l * D; const float* bb = a->in[I_LN2B] + l * D;
    f32x4 gv[4], bv[4];
#pragma unroll
    for (int j = 0; j < 4; ++j) { gv[j] = *((const f32x4*)g + lane + 64 * j); bv[j] = *((const f32x4*)bb + lane + 64 * j); }
    for (int m = gw; m < M; m += NGW) {
        const int b = m / TP, tp = m % TP; f32x4 v[4];
        if (tp < PADF) {
#pragma unroll
            for (int j = 0; j < 4; ++j) v[j] = (f32x4){0.f, 0.f, 0.f, 0.f};
            row_store_bf16(hb + (size_t)m * D, lane, v);
            { unsigned* h8r = (unsigned*)(F.ws + WS_H8 + (size_t)m * D) + lane;
#pragma unroll
              for (int j = 0; j < 4; ++j) h8r[64 * j] = 0u; }
            continue;
        }
        row_load_bf16(hb + (size_t)m * D, lane, v);
        const f32x4 w = *(const f32x4*)(topw + (size_t)m * 4);
#pragma unroll
        for (int j = 0; j < 4; ++j) v[j] = v[j] * DN_ALPHA;
#pragma unroll
        for (int k = 0; k < 4; ++k) { const unsigned* y8 = (const unsigned*)(ys8 + ((size_t)m * 4 + k) * D) + lane; const float wk = w[k] * (1.0f / YS_SCALE);
#pragma unroll
            for (int j = 0; j < 4; ++j) { const unsigned q = y8[64 * j]; const f32x2 lo = __builtin_amdgcn_cvt_pk_f32_fp8((int)q, false), hi2 = __builtin_amdgcn_cvt_pk_f32_fp8((int)q, true);
                v[j] += (f32x4){lo[0], lo[1], hi2[0], hi2[1]} * wk; } }
        float mean, rstd; ln_stats(v, mean, rstd);
#pragma unroll
        for (int j = 0; j < 4; ++j) v[j] = (v[j] - mean) * rstd * gv[j] + bv[j];
        if (l == DEPTH - 1) {
            if (tp >= PADF + NMETA) { float* orow = a->out + ((size_t)b * SEQ + (tp - PADF - NMETA)) * D;
#pragma unroll
                for (int j = 0; j < 4; ++j) *((f32x4*)orow + lane + 64 * j) = v[j]; }
        } else { row_store_bf16(hb + (size_t)m * D, lane, v);
            unsigned* h8r = (unsigned*)(F.ws + WS_H8 + (size_t)m * D) + lane;
#pragma unroll
            for (int j = 0; j < 4; ++j) h8r[64 * j] = pk4_fp8(v[j][0] * X8_SCALE, v[j][1] * X8_SCALE, v[j][2] * X8_SCALE, v[j][3] * X8_SCALE); }
    }
}

DI pg8::MoeTabs moe_tables(const Frame& F, int l) {
    LAS int* ebase = (LAS int*)(F.lds + TAB_OFF); LAS int* ecnt = ebase + 64; LAS unsigned char* tile_e = (LAS unsigned char*)(ebase + 128);
    __syncthreads();
    if (F.tid < NE) ecnt[F.tid] = (int)__hip_atomic_load(F.ctl + CW_ECNT + 2048 * l + 64 * F.tid, RLX_AGENT);
    __syncthreads();
    if (F.tid == 0) { int t = 0;
#pragma nounroll
        for (int e = 0; e < NE; ++e) { ebase[e] = t; t += (ecnt[e] + 255) >> 8; }
        ebase[32] = t; }
    __syncthreads();
    for (int t = F.tid; t < ebase[32]; t += NTHREADS) { int e = 0;
#pragma nounroll
        for (int k = 1; k < NE; ++k) e += (ebase[k] <= t) ? 1 : 0;
        tile_e[t] = (unsigned char)e; }
    __syncthreads();
    pg8::MoeTabs T; T.ebase = ebase; T.ecnt = ecnt; T.tile_e = tile_e; T.list = (const int*)(F.ws + WS_LIST); T.ntiles = ebase[32];
    return T;
}

constexpr int LA_QP = 144, LA_VP = 272;
constexpr int LA_HEAD = 64 * LA_QP * 2 + 64 * LA_VP;
constexpr int LA_BT = 2 * LA_HEAD, LA_TOT = LA_BT + 32768, LA_GA = LA_TOT + 2048, LA_ST = LA_GA + 4096, LA_WL = LA_ST + 2048;
#ifndef LA_SEC
#define LA_SEC 0
#endif
template <bool PHASE_C>
DI void linattn_phase(const Frame& F, kargs_t a, int l) {
    const int tid = F.tid, lane = F.lane, wave = F.wave, r32 = lane & 31, hi = lane >> 5;
    const bf16_t* proj = (const bf16_t*)(F.ws + WS_R1);
    LAS unsigned char* L = F.lds;
    LAS float* bT = (LAS float*)(L + LA_BT); LAS float* tot = (LAS float*)(L + LA_TOT); LAS float* gas = (LAS float*)(L + LA_GA); LAS float* stx = (LAS float*)(L + LA_ST);
    const int NU = NB * NCH * 2, USTEP = F.G >> 1;
    int hp_loaded = -1; float lg0 = 0.f, lg1 = 0.f; LAS float* wl = (LAS float*)(L + LA_WL);
    u32x4 pk[2], pq[2], pv[4]; u32x2 pga2 = (u32x2){0, 0};
#pragma unroll
    for (int i = 0; i < 2; ++i) { pk[i] = (u32x4){0, 0, 0, 0}; pq[i] = (u32x4){0, 0, 0, 0}; }
#pragma unroll
    for (int i = 0; i < 4; ++i) pv[i] = (u32x4){0, 0, 0, 0};
#define LA_LOADS(u_) do { const int hp_ = (F.bid & 1) + 2 * ((u_) / (NB * NCH)), bc_ = (u_) % (NB * NCH), c_ = bc_ % NCH, b_ = bc_ / NCH; const bool gl_ = hp_ >= 2; const int m0_ = b_ * TP + 64 * c_; \
        const int qc_ = (gl_ ? C_GQ : C_RQ) + 128 * (hp_ & 1), kc_ = (gl_ ? C_GK : C_RK) + 128 * (hp_ & 1), vc_ = (gl_ ? C_GV : C_RV) + 256 * (hp_ & 1); \
        _Pragma("unroll") for (int i = 0; i < 2; ++i) { const int task = tid + 512 * i, tok = task >> 4, cg = task & 15; pk[i] = *(const u32x4*)(proj + (size_t)(m0_ + tok) * NPROJ + kc_ + 8 * cg); \
            if (PHASE_C) pq[i] = *(const u32x4*)(proj + (size_t)(m0_ + tok) * NPROJ + qc_ + 8 * cg); } \
        _Pragma("unroll") for (int i = 0; i < 4; ++i) { const int ch = tid + 512 * i, tok = ch >> 5, cc = ch & 31; pv[i] = *(const u32x4*)(proj + (size_t)(m0_ + tok) * NPROJ + vc_ + 8 * cc); } \
        if (gl_ && tid < 256) pga2 = *(const u32x2*)(proj + (size_t)(m0_ + (tid >> 2)) * NPROJ + C_GA + 4 * (tid & 3)); } while (0)
    bf16x8 svn[4][2]; u32x2 gwn[2][4];
#define LA_S_LOADS(u_) do { if (PHASE_C) { const int hp_ = (F.bid & 1) + 2 * ((u_) / (NB * NCH)), bc_ = (u_) % (NB * NCH), c_ = bc_ % NCH, b_ = bc_ / NCH; \
        const int hlw_ = wave >> 2, eh_ = wave & 1; \
        const bf16_t* ST_ = (const bf16_t*)(F.ws + WS_ST) + ((size_t)(b_ * 8 + 2 * hp_ + hlw_) * NCH + c_) * 128 * 64; \
        _Pragma("unroll") for (int s = 0; s < 4; ++s) _Pragma("unroll") for (int mm = 0; mm < 2; ++mm) svn[s][mm] = *(const bf16x8*)(ST_ + (size_t)(32 * (2 * eh_ + mm) + r32) * 64 + 16 * s + 8 * hi); } } while (0)
#define LA_G_LOADS(u_) do { if (PHASE_C) { const int hp_ = (F.bid & 1) + 2 * ((u_) / (NB * NCH)), bc_ = (u_) % (NB * NCH), c_ = bc_ % NCH, b_ = bc_ / NCH; const int m0_ = b_ * TP + 64 * c_; \
        const int hlw_ = wave >> 2, nt_ = (wave >> 1) & 1, eh_ = wave & 1, iq_ = 32 * nt_ + r32; \
        const bf16_t* grow_ = proj + (size_t)(m0_ + iq_) * NPROJ + ((hp_ >= 2 ? C_GG : C_RG) + 256 * (hp_ & 1)) + 128 * hlw_; \
        _Pragma("unroll") for (int mm = 0; mm < 2; ++mm) _Pragma("unroll") for (int r4 = 0; r4 < 4; ++r4) gwn[mm][r4] = *(const u32x2*)(grow_ + 32 * (2 * eh_ + mm) + 8 * r4 + 4 * hi); } } while (0)
    int u = F.bid >> 1;
    if (u < NU) { LA_LOADS(u); LA_S_LOADS(u); LA_G_LOADS(u); }
    for (; u < NU; u += USTEP) {
        const int hp = (F.bid & 1) + 2 * (u / (NB * NCH)), bc = u % (NB * NCH), c = bc % NCH, b = bc / NCH;
        const bool isgla = hp >= 2; const int m0 = b * TP + 64 * c;
        const int gc0 = (isgla ? C_GG : C_RG) + 256 * (hp & 1);
        const int hlw = wave >> 2, h8 = 2 * hp + hlw;
        bf16_t* ST = (bf16_t*)(F.ws + WS_ST) + ((size_t)(b * 8 + h8) * NCH + c) * 128 * 64;
        const int nt = (wave >> 1) & 1, eh = wave & 1, iq = 32 * nt + r32;
        if (hp != hp_loaded) {
            hp_loaded = hp;
            if (isgla) { if (tid < 128) { const int gcol = 128 * (hp & 1) + tid;
#pragma unroll
                    for (int j = 0; j < 16; ++j) wl[j * 128 + tid] = a->in[I_WA2][((size_t)l * 16 + j) * 256 + gcol];
                    wl[16 * 128 + tid] = a->in[I_BA2][l * 256 + gcol]; } }
            else { lg0 = log1pf(-exp2f(-5.0f - (float)(2 * (hp & 1)))); lg1 = log1pf(-exp2f(-5.0f - (float)(2 * (hp & 1) + 1))); }
        }
        __syncthreads();
        for (int srep_ = 0; srep_ < ((LA_SEC & 1) && PHASE_C ? 2 : 1); ++srep_)
        if (isgla) {
            if (tid < 256) *(LAS f32x4*)(gas + (tid >> 2) * 16 + 4 * (tid & 3)) = (f32x4){bflo(pga2.x), bfhi(pga2.x), bflo(pga2.y), bfhi(pga2.y)};
            __syncthreads();
            const int col = tid & 127, qt = tid >> 7; float run = 0.f; float wa[16];
#pragma unroll
            for (int j = 0; j < 16; ++j) wa[j] = wl[j * 128 + col];
            const float ba = wl[16 * 128 + col];
#pragma unroll
            for (int t = 0; t < 16; ++t) { const int tok = 16 * qt + t; float x = ba;
#pragma unroll
                for (int j4 = 0; j4 < 4; ++j4) { const f32x4 gq = *(const LAS f32x4*)(gas + tok * 16 + 4 * j4); x += (gq[0] * wa[4 * j4] + gq[1] * wa[4 * j4 + 1]) + (gq[2] * wa[4 * j4 + 2] + gq[3] * wa[4 * j4 + 3]); }
                const float la = (fminf(x, 0.f) - __logf(1.0f + __expf(-fabsf(x)))) * (1.0f / 16.0f);
                run += la; bT[tok * 128 + col] = run; }
            tot[qt * 128 + col] = run;
            __syncthreads();
        }
        for (int srep_ = 0; srep_ < ((LA_SEC & 2) && PHASE_C ? 2 : 1); ++srep_)
#pragma unroll
        for (int i = 0; i < 2; ++i) {
            const int task = tid + 512 * i, tok = task >> 4, cg = task & 15, hl = cg >> 3, d0 = (8 * cg) & 63;
            float bv[8], bl[8];
            if (isgla) {
#pragma unroll
                for (int j = 0; j < 8; ++j) { const int cc = 8 * cg + j; const float t0 = tot[cc], t1 = tot[128 + cc], t2 = tot[256 + cc], t3 = tot[384 + cc]; const int qq = tok >> 4;
                    bv[j] = bT[tok * 128 + cc] + (qq > 0 ? t0 : 0.f) + (qq > 1 ? t1 : 0.f) + (qq > 2 ? t2 : 0.f); bl[j] = (t0 + t1) + (t2 + t3); }
            } else {
                const float lg = hl ? lg1 : lg0;
#pragma unroll
                for (int j = 0; j < 8; ++j) { bv[j] = (float)(tok + 1) * lg; bl[j] = 64.0f * lg; }
            }
            const u32x4 kw = pk[i];
            float kf[8] = {bflo(kw.x), bfhi(kw.x), bflo(kw.y), bfhi(kw.y), bflo(kw.z), bfhi(kw.z), bflo(kw.w), bfhi(kw.w)};
            LAS unsigned char* hb_ = L + hl * LA_HEAD;
            if (PHASE_C) {
                const u32x4 qw = pq[i];
                float qf_[8] = {bflo(qw.x), bfhi(qw.x), bflo(qw.y), bfhi(qw.y), bflo(qw.z), bfhi(qw.z), bflo(qw.w), bfhi(qw.w)};
                u32x4 qo, ko;
#pragma unroll
                for (int j = 0; j < 4; ++j) { const float e0 = fast_exp(bv[2 * j]), e1 = fast_exp(bv[2 * j + 1]);
                    qo[j] = pk2(qf_[2 * j] * e0, qf_[2 * j + 1] * e1); ko[j] = pk2(kf[2 * j] * __builtin_amdgcn_rcpf(e0), kf[2 * j + 1] * __builtin_amdgcn_rcpf(e1)); }
                *(LAS u32x4*)(hb_ + tok * LA_QP + d0 * 2) = qo; *(LAS u32x4*)(hb_ + 64 * LA_QP + tok * LA_QP + d0 * 2) = ko;
            } else {
                u32x4 ko;
#pragma unroll
                for (int j = 0; j < 4; ++j) ko[j] = pk2(kf[2 * j] * fast_exp(bl[2 * j] - bv[2 * j]), kf[2 * j + 1] * fast_exp(bl[2 * j + 1] - bv[2 * j + 1]));
                *(LAS u32x4*)(hb_ + 64 * LA_QP + tok * LA_QP + d0 * 2) = ko;
                if (tok == 63) { float* dec = (float*)(F.ws + WS_DEC) + ((size_t)(b * 8 + 2 * hp + hl) * NCH + c) * 64 + d0;
#pragma unroll
                    for (int j = 0; j < 8; ++j) dec[j] = fast_exp(bl[j]); }
            }
        }
#pragma unroll
        for (int i = 0; i < 4; ++i) { const int ch = tid + 512 * i, tok = ch >> 5, cc = ch & 31, hl = cc >> 4, e0 = (8 * cc) & 127;
            *(LAS u32x4*)(L + hl * LA_HEAD + 128 * LA_QP + tok * LA_VP + e0 * 2) = pv[i]; }
        { const int un = u + USTEP; if (un < NU) LA_LOADS(un); }
        __syncthreads();
        const LAS unsigned char* Qs = L + hlw * LA_HEAD; const LAS unsigned char* Ks = Qs + 64 * LA_QP; const LAS unsigned char* Vs = Qs + 128 * LA_QP;
        if (!PHASE_C) {
            const int mt = wave & 3; f32x16 acc[2]; acc[0] = f32x16{}; acc[1] = f32x16{};
#pragma unroll
            for (int s = 0; s < 4; ++s) { const bf16x8 av = frag_tr(Vs, LA_VP, 16 * s, 32 * mt, lane);
#pragma unroll
                for (int n2 = 0; n2 < 2; ++n2) acc[n2] = MFMA32(av, frag_tr(Ks, LA_QP, 16 * s, 32 * n2, lane), acc[n2]); }
            { LAS bf16_t* TT = (LAS bf16_t*)(L + LA_BT) + hlw * 8192;
#pragma unroll
              for (int n2 = 0; n2 < 2; ++n2)
#pragma unroll
                  for (int r = 0; r < 16; ++r) TT[(32 * mt + crow(r, hi)) * 64 + 32 * n2 + r32] = (bf16_t)f2bf(acc[n2][r]); }
            __syncthreads();
            { bf16_t* ST0 = (bf16_t*)(F.ws + WS_ST) + ((size_t)(b * 8 + 2 * hp) * NCH + c) * 128 * 64;
#pragma unroll
              for (int i = 0; i < 4; ++i) { const int ch = tid + 512 * i, hl2 = ch >> 10, off = (ch & 1023) * 8;
                  *(u32x4*)(ST0 + (size_t)hl2 * NCH * 8192 + off) = *(const LAS u32x4*)(L + LA_BT + hl2 * 16384 + off * 2); } }
        } else {
            bf16x8 qf[4]; f32x16 o[2]; f32x16 sT[2];
            for (int srep_ = 0; srep_ < ((LA_SEC & 4) ? 2 : 1); ++srep_) {
#pragma unroll
            for (int s = 0; s < 4; ++s) qf[s] = frag_row(Qs + iq * LA_QP + (16 * s + 8 * hi) * 2);
            sT[0] = f32x16{}; sT[1] = f32x16{};
#pragma unroll
            for (int jt = 0; jt < 2; ++jt) {
                if (jt <= nt) {
#pragma unroll
                    for (int s = 0; s < 4; ++s) sT[jt] = MFMA32(frag_row(Ks + (32 * jt + r32) * LA_QP + (16 * s + 8 * hi) * 2), qf[s], sT[jt]);
#pragma unroll
                    for (int r = 0; r < 16; ++r) if (32 * jt + crow(r, hi) > iq) sT[jt][r] = 0.f;
                }
            }
            o[0] = f32x16{}; o[1] = f32x16{};
#pragma unroll
            for (int jt = 0; jt < 2; ++jt)
#pragma unroll
                for (int s2 = 0; s2 < 2; ++s2) { const bf16x8 pf = pack_step(sT[jt], s2);
#pragma unroll
                    for (int mm = 0; mm < 2; ++mm) o[mm] = MFMA32(frag_tr_perm(Vs, LA_VP, 32 * jt + 16 * s2, 32 * (2 * eh + mm), lane), pf, o[mm]); }
#pragma unroll
            for (int s = 0; s < 4; ++s)
#pragma unroll
                for (int mm = 0; mm < 2; ++mm) o[mm] = MFMA32(svn[s][mm], qf[s], o[mm]);
            }
            { const int un = u + USTEP; if (un < NU) LA_S_LOADS(un); }
            float s1 = 0.f, s2 = 0.f;
#pragma unroll
            for (int mm = 0; mm < 2; ++mm)
#pragma unroll
                for (int r = 0; r < 16; ++r) { s1 += o[mm][r]; s2 += o[mm][r] * o[mm][r]; }
            s1 = sum_x32(s1); s2 = sum_x32(s2);
            LAS float* sx = stx + ((hlw * 2 + nt) * 2) * 64;
            if (hi == 0) { sx[eh * 64 + r32 * 2] = s1; sx[eh * 64 + r32 * 2 + 1] = s2; }
            __syncthreads();
            const float t1 = sx[r32 * 2] + sx[64 + r32 * 2], t2 = sx[r32 * 2 + 1] + sx[64 + r32 * 2 + 1];
            float mean = 0.f, rstd;
            if (isgla) rstd = 1.0f / sqrtf(t2 * (1.0f / 128.0f) + 1e-6f);
            else { mean = t1 * (1.0f / 128.0f); rstd = 1.0f / sqrtf(fmaxf(t2 * (1.0f / 128.0f) - mean * mean, 0.f) + 1e-5f); }
            unsigned char* yrow = F.ws + WS_YS + (size_t)(m0 + iq) * 2048 + (isgla ? 1536 : 0) + 256 * (hp & 1) + 128 * hlw;
            for (int srep_ = 0; srep_ < ((LA_SEC & 8) ? 2 : 1); ++srep_)
#pragma unroll
            for (int mm = 0; mm < 2; ++mm)
#pragma unroll
                for (int r4 = 0; r4 < 4; ++r4) { const int e = 32 * (2 * eh + mm) + 8 * r4 + 4 * hi;
                    const u32x2 gw_ = gwn[mm][r4]; const float gf[4] = {bflo(gw_.x), bfhi(gw_.x), bflo(gw_.y), bfhi(gw_.y)}; float y[4];
#pragma unroll
                    for (int j = 0; j < 4; ++j) { const float gsw = gf[j] * fast_sigmoid(gf[j]); y[j] = (o[mm][4 * r4 + j] - mean) * rstd * gsw; }
                    *(unsigned*)(yrow + e) = pk4_fp8(y[0] * YB_SCALE, y[1] * YB_SCALE, y[2] * YB_SCALE, y[3] * YB_SCALE); }
            { const int un = u + USTEP; if (un < NU) LA_G_LOADS(un); }
        }
    }
#undef LA_LOADS
#undef LA_S_LOADS
#undef LA_G_LOADS
    __syncthreads();
}

DI void linattn_scan_unit(const Frame& F, int unit) {
    const int eg = unit & 3, bh = unit >> 2; const int e = 32 * eg + (F.tid >> 4), d = 4 * (F.tid & 15);
    bf16_t* ST = (bf16_t*)(F.ws + WS_ST) + (size_t)bh * NCH * 128 * 64 + (size_t)e * 64 + d; const float* dec = (const float*)(F.ws + WS_DEC) + (size_t)bh * NCH * 64 + d;
    float s[4] = {0.f, 0.f, 0.f, 0.f};
    constexpr int SD = 12; static_assert(NCH % SD == 0, "scan depth");
    for (int c0 = 0; c0 < NCH; c0 += SD) {
        u32x2 kv[SD]; f32x4 dc[SD];
#pragma unroll
        for (int i = 0; i < SD; ++i) { kv[i] = *(const u32x2*)(ST + (size_t)(c0 + i) * 8192); dc[i] = *(const f32x4*)(dec + (size_t)(c0 + i) * 64); }
#pragma unroll
        for (int i = 0; i < SD; ++i) {
            *(u32x2*)(ST + (size_t)(c0 + i) * 8192) = (u32x2){pk2(s[0], s[1]), pk2(s[2], s[3])};
            s[0] = dc[i][0] * s[0] + bflo(kv[i].x); s[1] = dc[i][1] * s[1] + bfhi(kv[i].x); s[2] = dc[i][2] * s[2] + bflo(kv[i].y); s[3] = dc[i][3] * s[3] + bfhi(kv[i].y); }
    }
}

DI float gelu_tanh(float x) { const float z = 0.7978845608028654f * (x + 0.044715f * x * x * x); const float t = 1.0f - 2.0f * __builtin_amdgcn_rcpf(__builtin_amdgcn_exp2f(2.0f * LOG2E * z) + 1.0f); return 0.5f * x * (1.0f + t); }
constexpr int LRU_XP = 144;
constexpr int LRU_G = 64 * LRU_XP, LRU_EX = LRU_G + 32768, LRU_IN = LRU_EX + 4096, LRU_INB = 67 * 128 + 64 * 128, LRU_Y = LRU_IN + 2 * LRU_INB;
template <bool PHASE_C>
DI void lru_phase(const Frame& F, kargs_t a, int l) {
    const int tid = F.tid, lane = F.lane, wave = F.wave, r32 = lane & 31, hi = lane >> 5;
    const bf16_t* proj = (const bf16_t*)(F.ws + WS_R1);
    LAS unsigned char* Xs = F.lds; LAS float* G = (LAS float*)(F.lds + LRU_G); LAS float* ex = (LAS float*)(F.lds + LRU_EX);
    const int d = tid & 63, g = tid >> 6;
    const int NU = NB * NCH * 8;
    int n_loaded = -1;
    bf16x8 bw[4] = {}; float gbias = 0.f, w0 = 0.f, w1 = 0.f, w2 = 0.f, w3 = 0.f, cb = 0.f, sp = 0.f;
    const int mt = wave >> 2, ntile = wave & 3, type = ntile >> 1, dcol = 32 * (ntile & 1) + r32;
    const int crow_ = tid >> 3, ccol = tid & 7;
    u32x4 px0 = (u32x4){0, 0, 0, 0}, px1 = (u32x4){0, 0, 0, 0}, pg = (u32x4){0, 0, 0, 0}; float hpre = 0.f;
#define LRU_LOADS(u_) do { const int n_ = (u_) & 7, bc_ = (u_) >> 3, c_ = bc_ % NCH, b_ = bc_ / NCH; const int m0_ = b_ * TP + 64 * c_; \
        { const int t_ = crow_ - 3; px0 = (64 * c_ + t_ >= 0) ? *(const u32x4*)(proj + (size_t)(m0_ + t_) * NPROJ + C_LX + 64 * n_ + 8 * ccol) : (u32x4){0, 0, 0, 0}; } \
        if (tid < 24) px1 = *(const u32x4*)(proj + (size_t)(m0_ + 61 + crow_) * NPROJ + C_LX + 64 * n_ + 8 * ccol); \
        if (PHASE_C) { pg = *(const u32x4*)(proj + (size_t)(m0_ + crow_) * NPROJ + C_LG + 64 * n_ + 8 * ccol); \
            hpre = ((const float*)(F.ws + WS_LRUH))[((size_t)b_ * NCH + c_) * 512 + 64 * n_ + d]; } } while (0)
#define LRU_PUT(buf_) do { LAS unsigned char* T_ = F.lds + LRU_IN + (buf_) * LRU_INB; *(LAS u32x4*)(T_ + crow_ * 128 + ccol * 16) = px0; if (tid < 24) *(LAS u32x4*)(T_ + (64 + crow_) * 128 + ccol * 16) = px1; \
        if (PHASE_C) *(LAS u32x4*)(T_ + 67 * 128 + crow_ * 128 + ccol * 16) = pg; } while (0)
    int u = F.bid, buf = 0;
    __syncthreads();
    if (u < NU) { LRU_LOADS(u); LRU_PUT(0); }
    float hin = hpre;
    __syncthreads();
    for (; u < NU; u += F.G) {
        const int n = u & 7, bc = u >> 3, c = bc % NCH, b = bc / NCH; const int m0 = b * TP + 64 * c, ch0 = 64 * n, ch = ch0 + d;
        const int un = u + F.G;
        if (un < NU) LRU_LOADS(un);
        if (n != n_loaded) {
            n_loaded = n;
            const float* cw = a->in[I_CONVW] + (size_t)l * 4 * 512 + ch; w0 = cw[0]; w1 = cw[512]; w2 = cw[1024]; w3 = cw[1536]; cb = a->in[I_CONVB][l * 512 + ch];
            const float lam = a->in[I_LAM][l * 512 + ch]; sp = fmaxf(-lam, 0.f) + __logf(1.0f + __expf(-fabsf(lam)));
            const float* W = (type ? a->in[I_WLX] : a->in[I_WLA]) + ((size_t)(l * 8 + n) * 64) * 64 + dcol; gbias = (type ? a->in[I_BLX] : a->in[I_BLA])[l * 512 + ch0 + dcol];
#pragma unroll
            for (int s = 0; s < 4; ++s) { u32x4 p;
#pragma unroll
                for (int j = 0; j < 4; ++j) p[j] = pk2(W[(size_t)(16 * s + 8 * hi + 2 * j) * 64], W[(size_t)(16 * s + 8 * hi + 2 * j + 1) * 64]);
                bw[s] = __builtin_bit_cast(bf16x8, p); }
        }
        const LAS bf16_t* XT = (const LAS bf16_t*)(F.lds + LRU_IN + buf * LRU_INB); const LAS bf16_t* GT = XT + 67 * 64;
        float xv[8], gb[8];
        { float x[11];
#pragma unroll
          for (int i = 0; i < 11; ++i) x[i] = bf2f(XT[(8 * g + i) * 64 + d]);
#pragma unroll
          for (int i = 0; i < 8; ++i) { xv[i] = cb + (w0 * x[i] + w1 * x[i + 1]) + (w2 * x[i + 2] + w3 * x[i + 3]);
              *(LAS bf16_t*)(Xs + (8 * g + i) * LRU_XP + d * 2) = (bf16_t)f2bf(xv[i]); }
          if (PHASE_C) {
#pragma unroll
              for (int i = 0; i < 8; ++i) gb[i] = bf2f(GT[(8 * g + i) * 64 + d]); }
        }
        __syncthreads();
        { f32x16 acc = f32x16{};
#pragma unroll
          for (int s = 0; s < 4; ++s) acc = MFMA32(frag_row(Xs + (32 * mt + r32) * LRU_XP + (16 * s + 8 * hi) * 2), bw[s], acc);
#pragma unroll
          for (int r = 0; r < 16; ++r) G[(type * 64 + 32 * mt + crow(r, hi)) * 64 + dcol] = fast_sigmoid(acc[r] + gbias); }
        __syncthreads();
        float av[8], uv[8]; float Aloc = 1.f, hloc = 0.f;
#pragma unroll
        for (int i = 0; i < 8; ++i) { const int t = 8 * g + i; const float r = G[t * 64 + d], ig = G[(64 + t) * 64 + d];
            const float la = -8.0f * r * sp; float av_ = fast_exp(la); float uv_ = sqrtf(fmaxf(1.0f - av_ * av_, 0.f)) * ig * xv[i];
            if (64 * c + t < PADF) { av_ = 1.f; uv_ = 0.f; }
            av[i] = av_; uv[i] = uv_; Aloc *= av_; hloc = av_ * hloc + uv_; }
        ex[(g * 64 + d) * 2] = Aloc; ex[(g * 64 + d) * 2 + 1] = hloc;
        if (un < NU) LRU_PUT(buf ^ 1);
        __syncthreads();
        float h = PHASE_C ? hin : 0.f; float Ap = 1.f;
#pragma unroll
        for (int gg = 0; gg < 8; ++gg) if (gg < g) { const float A_ = ex[(gg * 64 + d) * 2], H_ = ex[(gg * 64 + d) * 2 + 1]; h = A_ * h + H_; Ap *= A_; }
        if (!PHASE_C) { if (g == 7) { ((float*)(F.ws + WS_LRUA))[((size_t)b * NCH + c) * 512 + ch] = Ap * Aloc; ((float*)(F.ws + WS_LRUH))[((size_t)b * NCH + c) * 512 + ch] = Aloc * h + hloc; } }
        else {
            LAS unsigned char* YT = F.lds + LRU_Y;
#pragma unroll
            for (int i = 0; i < 8; ++i) { const int t = 8 * g + i; h = av[i] * h + uv[i]; YT[t * 64 + d] = (unsigned char)(pk4_fp8(h * gelu_tanh(gb[i]) * YB_SCALE, 0.f, 0.f, 0.f) & 0xffu); }
            __syncthreads();
            *(u32x2*)(F.ws + WS_YS + (size_t)(m0 + crow_) * 2048 + 1024 + ch0 + 8 * ccol) = *(const LAS u32x2*)(F.lds + LRU_Y + crow_ * 64 + ccol * 8);
        }
        hin = hpre; buf ^= 1;
    }
#undef LRU_LOADS
#undef LRU_PUT
    __syncthreads();
}
DI void lru_scan_unit(const Frame& F, int b) {
    float* LA = (float*)(F.ws + WS_LRUA) + (size_t)b * NCH * 512 + F.tid; float* LH = (float*)(F.ws + WS_LRUH) + (size_t)b * NCH * 512 + F.tid;
    float h = 0.f;
    constexpr int SD = 12;
    for (int c0 = 0; c0 < NCH; c0 += SD) { float A_[SD], H_[SD];
#pragma unroll
        for (int i = 0; i < SD; ++i) { A_[i] = LA[(size_t)(c0 + i) * 512]; H_[i] = LH[(size_t)(c0 + i) * 512]; }
#pragma unroll
        for (int i = 0; i < SD; ++i) { LH[(size_t)(c0 + i) * 512] = h; h = A_[i] * h + H_[i]; } }
}

constexpr int AT_KP = 208, AT_VP = 144;
constexpr int AT_KB = 64 * AT_KP, AT_VB = 64 * AT_VP, AT_VOFF = 2 * AT_KB;
DI void attn_unit(const Frame& F, int b, int hd, int qb) {
    const int tid = F.tid, lane = F.lane, wave = F.wave, r32 = lane & 31, hi = lane >> 5;
    const bf16_t* proj = (const bf16_t*)(F.ws + WS_R1); const bf16_t* qg = (const bf16_t*)(F.ws + WS_Q); const bf16_t* kvg = (const bf16_t*)(F.ws + WS_KV);
    LAS unsigned char* L = F.lds;
    const int tq = 256 * qb + 32 * wave + r32; const size_t mq = (size_t)b * TP + tq;
    bf16x8 qf[6];
#pragma unroll
    for (int s = 0; s < 6; ++s) qf[s] = *(const bf16x8*)(qg + mq * 768 + hd * 96 + 16 * s + 8 * hi);
    const bf16_t* src[3]; int dst[3];
#pragma unroll
    for (int i = 0; i < 3; ++i) { const int id = tid + 512 * i;
        if (id < 768) { const int key = id / 12, cc = id % 12; src[i] = cc < 8 ? kvg + (size_t)key * 1024 + hd * 64 + 8 * cc : proj + (size_t)key * NPROJ + C_KR + 8 * (cc - 8); dst[i] = key * AT_KP + cc * 16; }
        else { const int v = id - 768, key = v >> 3, cc = v & 7; src[i] = kvg + (size_t)key * 1024 + 512 + hd * 64 + 8 * cc; dst[i] = AT_VOFF + key * AT_VP + cc * 16; } }
    const bool third = tid < 256;
    const bool rope0 = (tid < 768) && ((tid % 12) >= 8), rope1 = (tid + 512 < 768) && (((tid + 512) % 12) >= 8);
#define AT_GL(i, kt, isrope) (*(const u32x4*)(src[i] + ((size_t)b * TP + 64 * (kt)) * ((isrope) ? (size_t)NPROJ : (size_t)1024)))
    const int kt0 = 3, kt1 = 4 * qb + 3;
    __syncthreads();
    u32x4 st0 = AT_GL(0, kt0, rope0), st1 = AT_GL(1, kt0, rope1), st2 = third ? AT_GL(2, kt0, false) : (u32x4){0, 0, 0, 0};
    *(LAS u32x4*)(L + dst[0]) = st0; *(LAS u32x4*)(L + dst[1]) = st1; if (third) *(LAS u32x4*)(L + dst[2]) = st2;
    __syncthreads();
    f32x16 o[2]; o[0] = f32x16{}; o[1] = f32x16{};
    constexpr float ATT_THR = 8.0f;
    float mref = 0.f, lrun = 0.f; f32x16 negm = f32x16{};
    for (int kt = kt0; kt <= kt1; ++kt) {
        const int cur = (kt - kt0) & 1; const bool more = kt < kt1;
        if (more) { st0 = AT_GL(0, kt + 1, rope0); st1 = AT_GL(1, kt + 1, rope1); if (third) st2 = AT_GL(2, kt + 1, false); }
        const LAS unsigned char* Kb = L + cur * AT_KB; const LAS unsigned char* Vb = L + AT_VOFF + cur * AT_VB;
        f32x16 p[2];
#pragma unroll
        for (int sub = 0; sub < 2; ++sub) { p[sub] = MFMA32(frag_row(Kb + (32 * sub + r32) * AT_KP + (8 * hi) * 2), qf[0], negm);
#pragma unroll
            for (int s = 1; s < 6; ++s) p[sub] = MFMA32(frag_row(Kb + (32 * sub + r32) * AT_KP + (16 * s + 8 * hi) * 2), qf[s], p[sub]); }
        if (kt == kt0 || kt >= 4 * qb) {
#pragma unroll
            for (int sub = 0; sub < 2; ++sub)
#pragma unroll
                for (int r = 0; r < 16; ++r) { const int key = 64 * kt + 32 * sub + crow(r, hi); if (key > tq || key < PADF) p[sub][r] = -1.0e30f; }
        }
        float mx = fmaxf(p[0][0], p[1][0]);
#pragma unroll
        for (int r = 1; r < 16; ++r) mx = fmaxf(fmaxf(mx, p[0][r]), p[1][r]);
        mx = max_x32(mx);
        if (kt == kt0 || __any(mx > ATT_THR)) {
            const float delta = (kt == kt0) ? mx : fmaxf(mx, 0.f);
            const float fac = (kt == kt0) ? 0.f : __builtin_amdgcn_exp2f(-delta);
            mref += delta; lrun *= fac;
#pragma unroll
            for (int dv = 0; dv < 2; ++dv) o[dv] = o[dv] * fac;
#pragma unroll
            for (int sub = 0; sub < 2; ++sub)
#pragma unroll
                for (int r = 0; r < 16; ++r) p[sub][r] -= delta;
#pragma unroll
            for (int r = 0; r < 16; ++r) negm[r] = -mref;
        }
        float ps = 0.f;
#pragma unroll
        for (int sub = 0; sub < 2; ++sub)
#pragma unroll
            for (int r = 0; r < 16; ++r) { p[sub][r] = __builtin_amdgcn_exp2f(p[sub][r]); ps += p[sub][r]; }
        lrun += ps;
#pragma unroll
        for (int sub = 0; sub < 2; ++sub)
#pragma unroll
            for (int s2 = 0; s2 < 2; ++s2) { const bf16x8 pf = pack_step(p[sub], s2);
#pragma unroll
                for (int dv = 0; dv < 2; ++dv) o[dv] = MFMA32(frag_tr_perm(Vb, AT_VP, 32 * sub + 16 * s2, 32 * dv, lane), pf, o[dv]); }
        if (more) { const int nb = cur ^ 1;
            const int d0 = dst[0] + (dst[0] >= AT_VOFF ? nb * AT_VB : nb * AT_KB), d1 = dst[1] + (dst[1] >= AT_VOFF ? nb * AT_VB : nb * AT_KB), d2 = dst[2] + (dst[2] >= AT_VOFF ? nb * AT_VB : nb * AT_KB);
            *(LAS u32x4*)(L + d0) = st0; *(LAS u32x4*)(L + d1) = st1; if (third) *(LAS u32x4*)(L + d2) = st2; }
        __syncthreads();
    }
    lrun = sum_x32(lrun);
    const float inv = 1.0f / lrun;
    unsigned char* yrow = F.ws + WS_YS + mq * 2048 + 512 + hd * 64;
#pragma unroll
    for (int dv = 0; dv < 2; ++dv)
#pragma unroll
        for (int r4 = 0; r4 < 4; ++r4) { const int e = 32 * dv + 8 * r4 + 4 * hi;
            const float iv = inv * YB_SCALE; *(unsigned*)(yrow + e) = pk4_fp8(o[dv][4 * r4] * iv, o[dv][4 * r4 + 1] * iv, o[dv][4 * r4 + 2] * iv, o[dv][4 * r4 + 3] * iv); }
}
#ifdef CONV_TWICE
#define CONV_AGAIN(l_) { asm volatile("" ::: "memory"); phase_convert(F, get_args(), l_); }
#else
#define CONV_AGAIN(l_)
#endif
#ifndef MK_PER_PHASE
#define MK_PER_PHASE 0
#endif
constexpr int NPH_L = 12, NPHASES = 1 + DEPTH * NPH_L;
constexpr int ATT_UNITS = (TP / 256) * NB * 8;

DI int lane_id_volatile() { int r; asm volatile("v_mbcnt_lo_u32_b32 %0, -1, 0\n\tv_mbcnt_hi_u32_b32 %0, -1, %0" : "=v"(r)); return r; }
__global__ void __launch_bounds__(NTHREADS, 2) trunk_fwd(KArgs args) {
    extern __shared__ __attribute__((aligned(16))) unsigned char lds_raw[];
    Frame F;
    F.lds = (LAS unsigned char*)lds_raw; F.ws = nullptr; F.ctl = nullptr;
    const int wave0 = __builtin_amdgcn_readfirstlane((int)threadIdx.x >> 6);
#define MYTID() (wave0 * 64 + lane_id_volatile())
    F.tid = MYTID(); F.lane = F.tid & 63; F.wave = wave0; F.G = gridDim.x; F.bid = blockIdx.x;
    volatile LAS unsigned* MISC = (volatile LAS unsigned*)(F.lds + MISC_OFF);
    if (F.tid < 64) MISC[F.tid] = 0u;
    __syncthreads();
    XcdBarrier bar; bar.bar = (unsigned*)(args.ws + WS_CTL) + CW_BAR; bar.x = 0; bar.st = nullptr;
    const int lo = args.ph_lo, hi = args.ph_hi;
    if (hi - lo > 1) bar = xcd_barrier_post((unsigned*)(args.ws + WS_CTL) + CW_BAR, MISC + 8, F.tid);
#ifndef PH_MASK
#define PH_MASK 0xFFFFFFFFu
#endif
#define EN(kk) (((PH_MASK) >> (kk)) & 1u)
#define IN(k) (lo <= (k) && (k) < hi)
#define SEAM(k) do { if (IN(k) && IN((k) + 1)) xcd_barrier(bar, MYTID()); } while (0)
#define PHASE_BEGIN kargs_t A = get_args(); unsigned char* ws = A->ws; F.ws = ws; F.ctl = (gu32*)(ws + WS_CTL); \
    { int t_ = MYTID(); asm volatile("" : "+v"(t_)); F.tid = t_; F.lane = t_ & 63; F.wave = __builtin_amdgcn_readfirstlane(t_ >> 6); int b_ = blockIdx.x, g_ = gridDim.x; asm volatile("" : "+s"(b_), "+s"(g_)); F.bid = b_; F.G = g_; } \
    bf16_t* hb = (bf16_t*)(ws + WS_HB); bf16_t* proj = (bf16_t*)(ws + WS_R1); \
    const float* tabR = (const float*)(ws + WS_TABR); const float* tabM = (const float*)(ws + WS_TABM); float* ssq = (float*)(ws + WS_SSQ); \
    (void)hb; (void)proj; (void)tabR; (void)tabM; (void)ssq;

    if (EN(12) && IN(0)) { PHASE_BEGIN phase_convert(F, A, 0); CONV_AGAIN(0) phase_ln0(F, A); }
    SEAM(0);
#define PH0(l, P, QSEL) \
        if (EN(0) && IN(P + 0)) { }
#define PH1(l, P, QSEL) \
        if (EN(1) && IN(P + 1)) { PHASE_BEGIN \
            pg8::Gemm g{hb, (const bf16_t*)(ws + W_IN), D, D, D, 0, 0}; pg8::StaticOrder S; S.init(M, NPROJ, F.G, F.bid); \
            pg8::EpiProj E{proj, tabR, tabM, ssq}; \
            pg8::gemm_phase<pg8::EpiProj, pg8::StaticOrder, true>(F.lds, F.tid, g, S, E); \
        }
#define PH2(l, P, QSEL) \
        if (EN(2) && IN(P + 2)) { PHASE_BEGIN \
            if (EN(13)) { pg8::Gemm g{proj + C_CQ, (const bf16_t*)(ws + W_UQ), NPROJ, 256, 256, 0, 0}; pg8::StaticOrder S; S.init(M, 768, F.G, F.bid); \
              pg8::EpiQ E{(bf16_t*)(ws + WS_Q), tabM, ssq}; \
              pg8::gemm_phase<pg8::EpiQ, pg8::StaticOrder, true>(F.lds, F.tid, g, S, E); } \
            if (EN(14)) { pg8::Gemm g{proj + C_CKV, (const bf16_t*)(ws + W_UKV), NPROJ, 128, 128, 0, 0}; pg8::StaticOrder S; S.init(M, 1024, F.G, (F.bid + 140) % F.G); \
              pg8::EpiKV E{(bf16_t*)(ws + WS_KV), ssq}; \
              pg8::gemm_phase<pg8::EpiKV, pg8::StaticOrder, true>(F.lds, F.tid, g, S, E); } \
            { Frame F2 = F; F2.bid = (F.bid + 156) % F.G; if (EN(15)) linattn_phase<false>(F2, A, l); if constexpr (REP(15)) linattn_phase<false>(F2, A, l); } \
            { Frame F2 = F; F2.bid = (F.bid + 220) % F.G; if (EN(16)) lru_phase<false>(F2, A, l); if constexpr (REP(16)) lru_phase<false>(F2, A, l); } \
        }
#define PH3(l, P, QSEL) \
        if (EN(3) && IN(P + 3)) { PHASE_BEGIN \
            if (QSEL == 0) for (int u = F.bid; u < 128 + NB; u += F.G) { if (u < 128) linattn_scan_unit(F, u); else lru_scan_unit(F, u - 128); } \
            for (;;) { \
                __syncthreads(); \
                if (F.tid == 0) MISC[0] = __hip_atomic_fetch_add(F.ctl + CW_QUEUE + 64 * (l + 2 * QSEL), 1u, RLX_AGENT); \
                __syncthreads(); \
                const int u = (int)MISC[0]; \
                if (u >= ATT_UNITS) break; \
                const int qb = (TP / 256 - 1) - u / 32, bh = u % 32; \
                attn_unit(F, bh >> 3, bh & 7, qb); \
            } \
        }
#define PH4(l, P, QSEL) \
        if (EN(4) && IN(P + 4)) { PHASE_BEGIN \
            linattn_phase<true>(F, A, l); if constexpr (REP(17)) linattn_phase<true>(F, A, l); \
            { Frame F2 = F; F2.bid = (F.bid + 128) % F.G; lru_phase<true>(F2, A, l); if constexpr (REP(18)) lru_phase<true>(F2, A, l); } \
        }
#define PH5(l, P, QSEL) \
        if (EN(5) && IN(P + 5)) { PHASE_BEGIN \
            pg8::Gemm g{ws + WS_H8, ws + W_MG, D, D, D, 0, 0}; pg8::TokenOrder S; S.init(M, 4096, F.G, F.bid); \
            pg8::EpiGate E{(unsigned char*)proj, A->in[I_BMERGE] + (size_t)l * 4096}; \
            meta_gates(F, (unsigned char*)proj, A->in[I_BMERGE] + (size_t)l * 4096); \
            pg8::gemm_phase<pg8::EpiGate, pg8::TokenOrder, true, true>(F.lds, F.tid, g, S, E); \
        }
#define PH6(l, P, QSEL) \
        if (EN(6) && IN(P + 6)) { PHASE_BEGIN \
            pg8::Gemm g{ws + WS_YS, ws + W_BR, 2048, 512, 512, 512, (long)D * 512}; pg8::BatchedOrder<4, pg8::TokenOrder> S; S.init(M, D, F.G, F.bid); \
            pg8::EpiBranch E{(bf16_t*)(ws + WS_MIX), (const unsigned char*)proj}; \
            meta_branch(F, (const unsigned char*)proj); \
            pg8::gemm_phase<pg8::EpiBranch, pg8::BatchedOrder<4, pg8::TokenOrder>, true, true>(F.lds, F.tid, g, S, E); \
        }
#define PH7(l, P, QSEL) \
        if (EN(7) && IN(P + 7)) { PHASE_BEGIN \
            pg8::Gemm g{(const bf16_t*)(ws + WS_MIX), (const bf16_t*)(ws + W_OUT), D, D, D, 0, 0}; pg8::TokenOrder S; S.init(M, D, F.G, F.bid); \
            pg8::EpiOut E{hb}; \
            meta_out(F, hb); \
            pg8::gemm_phase<pg8::EpiOut, pg8::TokenOrder, true>(F.lds, F.tid, g, S, E); \
        }
#define PH8(l, P, QSEL) \
        if (EN(8) && IN(P + 8)) { PHASE_BEGIN phase_ln1(F, A, l); }
#define PH9(l, P, QSEL) \
        if (EN(9) && IN(P + 9)) { PHASE_BEGIN \
            const pg8::MoeTabs T = moe_tables(F, l); \
            pg8::Gemm g{ws + WS_X8, ws + W_GU, D, D, D, 0, (long)2048 * D}; pg8::MoeOrder<8, true> S{T, F.G, F.bid}; \
            pg8::EpiSwiglu E{ws + WS_R1, A->in[I_BEG] + (size_t)l * NE * DE, A->in[I_BEU] + (size_t)l * NE * DE}; \
            pg8::gemm_phase<pg8::EpiSwiglu, pg8::MoeOrder<8, true>, true, true>(F.lds, F.tid, g, S, E); \
        }
#define PH10(l, P, QSEL) \
        if (EN(10) && IN(P + 10)) { PHASE_BEGIN \
            const pg8::MoeTabs T = moe_tables(F, l); \
            pg8::Gemm g{ws + WS_R1, ws + W_DN, DE, DE, DE, 0, (long)D * DE}; pg8::MoeOrder<4, false> S{T, F.G, F.bid}; \
            pg8::EpiDown E{ws + WS_YSLOT, A->in[I_BED] + (size_t)l * NE * D, T}; \
            pg8::gemm_phase<pg8::EpiDown, pg8::MoeOrder<4, false>, true, true>(F.lds, F.tid, g, S, E); \
        }
#define PH11(l, P, QSEL) \
        if (EN(11) && IN(P + 11)) { PHASE_BEGIN if (l + 1 < DEPTH) { phase_convert(F, A, l + 1); CONV_AGAIN(l + 1) } phase_ln2(F, A, l); }
#ifndef REP_MASK
#define REP_MASK 0u
#endif
#define REP(k) (((REP_MASK) >> (k)) & 1u)
#define LAYER_BODY(l) { constexpr int P = 1 + (l) * NPH_L; \
    PH0(l, P, 0) if constexpr (REP(0)) { PH0(l, P, 1) } \
    PH1(l, P, 0) if constexpr (REP(1)) { PH1(l, P, 1) } \
    SEAM(P + 1); \
    PH2(l, P, 0) if constexpr (REP(2)) { PH2(l, P, 1) } \
    SEAM(P + 2); \
    PH3(l, P, 0) if constexpr (REP(3)) { PH3(l, P, 1) } \
    SEAM(P + 3); \
    PH4(l, P, 0) if constexpr (REP(4)) { PH4(l, P, 1) } \
    SEAM(P + 4); \
    PH5(l, P, 0) if constexpr (REP(5)) { PH5(l, P, 1) } \
    SEAM(P + 5); \
    PH6(l, P, 0) if constexpr (REP(6)) { PH6(l, P, 1) } \
    SEAM(P + 6); \
    PH7(l, P, 0) if constexpr (REP(7)) { PH7(l, P, 1) } \
    SEAM(P + 7); \
    PH8(l, P, 0) if constexpr (REP(8)) { PH8(l, P, 1) } \
    SEAM(P + 8); \
    PH9(l, P, 0) if constexpr (REP(9)) { PH9(l, P, 1) } \
    SEAM(P + 9); \
    PH10(l, P, 0) if constexpr (REP(10)) { PH10(l, P, 1) } \
    SEAM(P + 10); \
    PH11(l, P, 0) if constexpr (REP(11)) { PH11(l, P, 1) } \
    SEAM(P + 11); \
}
    { constexpr int l = 0; LAYER_BODY(l) }
    { constexpr int l = 1; LAYER_BODY(l) }
#undef LAYER_BODY
#undef IN
#undef SEAM
}

extern "C" void kernel_launch(void* const* d_in, const int* in_sizes, int n_in, void* d_out, int out_size, void* d_ws, size_t ws_size, hipStream_t stream) {
    static int grid = 0;
    if (grid == 0) {
        if (n_in != 34 || ws_size < WS_END) { fprintf(stderr, "kernel_launch: expected 34 inputs and >= %zu bytes of workspace; got %d, %zu\n", (size_t)WS_END, n_in, ws_size); grid = -1; return; }
        int dev = 0, cus = 0;
        if (hipGetDevice(&dev) != hipSuccess || hipDeviceGetAttribute(&cus, hipDeviceAttributeMultiprocessorCount, dev) != hipSuccess) { grid = -1; return; }
        if (hipFuncSetAttribute((const void*)trunk_fwd, hipFuncAttributeMaxDynamicSharedMemorySize, LDS_BYTES) != hipSuccess) { fprintf(stderr, "kernel_launch: hipFuncSetAttribute failed\n"); grid = -1; return; }
        int per_cu = 0;
        if (hipOccupancyMaxActiveBlocksPerMultiprocessor(&per_cu, (const void*)trunk_fwd, NTHREADS, LDS_BYTES) != hipSuccess || per_cu < 1) fprintf(stderr, "kernel_launch: occupancy query reports %d\n", per_cu);
        (void)hipGetLastError();
        grid = cus >= 256 ? 256 : (cus & ~7);
        if (grid < 8) { fprintf(stderr, "kernel_launch: %d CUs: too few\n", cus); grid = -1; return; }
    }
    if (grid < 0) return;
    (void)hipMemsetAsync((char*)d_ws + WS_CTL, 0, CTL_ZERO_BYTES, stream);
    KArgs a{};
    for (int i = 0; i < 34; ++i) a.in[i] = (const float*)d_in[i];
    a.out = (float*)d_out; a.ws = (unsigned char*)d_ws;
    for (int i = 0; i < 32; ++i) a.invR[i] = (float)pow(10000.0, -(double)(2 * i) / 64.0);
    for (int i = 0; i < 16; ++i) a.invM[i] = (float)pow(10000.0, -(double)(2 * i) / 32.0);
#if MK_PER_PHASE
    for (int p = 0; p < NPHASES; ++p) { a.ph_lo = p; a.ph_hi = p + 1; hipLaunchKernelGGL(trunk_fwd, dim3(grid), dim3(NTHREADS), LDS_BYTES, stream, a); }
#else
    a.ph_lo = 0; a.ph_hi = NPHASES;
    hipLaunchKernelGGL(trunk_fwd, dim3(grid), dim3(NTHREADS), LDS_BYTES, stream, a);
#endif
}
```
